# Optimizing an MI355X kernel written in HIP

```python
import jax, jax.numpy as jnp
from jax import lax
import numpy as np

D_MODEL = 1024
BATCH = 16
SEQ = 2048
DEPTH = 2
DEC_BATCH = 128
DEC_SEQ = 8
PAST_LEN = 16384
PAGE_SIZE = 128

N_META = 16
N_A_LAYERS = DEPTH // 2
N_B_LAYERS = DEPTH - N_A_LAYERS
EPS = 1e-5
SSM_EXPAND = 2
D_INNER = SSM_EXPAND * D_MODEL
SSM_HEAD_DIM = 64
SSM_HEADS = D_INNER // SSM_HEAD_DIM
SSM_GROUPS = 4
D_STATE = 128
D_CONV = 4
CONV_DIM = D_INNER + 2 * SSM_GROUPS * D_STATE
D_IN_PROJ = D_INNER + CONV_DIM + SSM_HEADS
CHUNK = 128
DT_MIN = 0.001
DT_MAX = 0.1
HEAD_DIM = 64
N_HEADS = D_MODEL // HEAD_DIM
N_KV_HEADS = 4
Q_PER_KV = N_HEADS // N_KV_HEADS
WINDOW = 128
ATTN_BLOCK = WINDOW
ROT_DIM = HEAD_DIM // 4
ROPE_THETA = 500000.0
D_FF = ((8 * D_MODEL + 3 * 256 - 1) // (3 * 256)) * 256

kernel_name = "yoco_mamba2_swa_sink_step"


def _rmsnorm(x, g):
    xf = x.astype(jnp.float32)
    r = lax.rsqrt(jnp.mean(xf * xf, axis=-1, keepdims=True) + EPS)
    return (xf * r).astype(x.dtype) * g


def _gated_group_rmsnorm(y, z, g):
    b, l, _ = y.shape
    u = (y * jax.nn.silu(z)).astype(jnp.float32).reshape(b, l, SSM_GROUPS, D_INNER // SSM_GROUPS)
    u = u * lax.rsqrt(jnp.mean(u * u, axis=-1, keepdims=True) + EPS)
    return u.reshape(b, l, D_INNER).astype(y.dtype) * g


def _segsum(a):
    t = a.shape[-1]
    cs = jnp.cumsum(a, axis=-1)
    diff = cs[..., :, None] - cs[..., None, :]
    return jnp.where(jnp.tril(jnp.ones((t, t), dtype=bool)), diff, -jnp.inf)


def _pad_front(t, n):
    return jnp.pad(t, ((0, 0), (n, 0)) + ((0, 0),) * (t.ndim - 2))


def _ssd_chunked(xdt, a, bm, cm, h0):
    b, l = xdt.shape[:2]
    nc = l // CHUNK
    r = SSM_HEADS // SSM_GROUPS
    x = xdt.reshape(b, nc, CHUNK, SSM_GROUPS, r, SSM_HEAD_DIM)
    a = a.reshape(b, nc, CHUNK, SSM_GROUPS, r).transpose(0, 3, 4, 1, 2)
    bm = bm.reshape(b, nc, CHUNK, SSM_GROUPS, D_STATE)
    cm = cm.reshape(b, nc, CHUNK, SSM_GROUPS, D_STATE)
    a_cs = jnp.cumsum(a, axis=-1)
    decay_in = jnp.exp(_segsum(a))
    cb = jnp.einsum('bclgn,bcsgn->bgcls', cm, bm)
    y_diag = jnp.einsum('bgrcls,bcsgrp->bclgrp', cb[:, :, None] * decay_in, x)
    decay_to_end = jnp.exp(a_cs[..., -1:] - a_cs)
    chunk_states = jnp.einsum('bcsgn,bgrcs,bcsgrp->bcgrpn', bm, decay_to_end, x)
    h0 = h0.reshape(b, SSM_GROUPS, r, SSM_HEAD_DIM, D_STATE)
    all_states = jnp.concatenate([h0[:, None], chunk_states], axis=1)
    chunk_tot = jnp.pad(a_cs[..., -1], ((0, 0), (0, 0), (0, 0), (1, 0)))
    decay_chunk = jnp.exp(_segsum(chunk_tot))
    states = jnp.einsum('bgrzc,bcgrpn->bzgrpn', decay_chunk, all_states)
    y_off = jnp.einsum('bclgn,bcgrpn,bgrcl->bclgrp', cm, states[:, :-1], jnp.exp(a_cs))
    y = (y_diag + y_off).reshape(b, l, SSM_HEADS, SSM_HEAD_DIM)
    return y, states[:, -1].reshape(b, SSM_HEADS, SSM_HEAD_DIM, D_STATE)


def _mamba2_mixer(u, conv_prev, h0, w_in, conv_w, conv_b, dt_bias, a_log, d_skip, gate_g, w_out):
    b, l, _ = u.shape
    zxbcdt = u @ w_in
    z = zxbcdt[..., :D_INNER]
    xbc = zxbcdt[..., D_INNER:D_INNER + CONV_DIM]
    dt_raw = zxbcdt[..., D_INNER + CONV_DIM:]
    xpad = jnp.concatenate([conv_prev.astype(xbc.dtype), xbc], axis=1)
    conv = xpad[:, :l] * conv_w[0]
    for k in range(1, D_CONV):
        conv = conv + xpad[:, k:k + l] * conv_w[k]
    xbc = jax.nn.silu(conv + conv_b)
    new_conv = xpad[:, l:]
    gn = SSM_GROUPS * D_STATE
    xs = xbc[..., :D_INNER].reshape(b, l, SSM_HEADS, SSM_HEAD_DIM).astype(jnp.float32)
    bm = xbc[..., D_INNER:D_INNER + gn].reshape(b, l, SSM_GROUPS, D_STATE).astype(jnp.float32)
    cm = xbc[..., D_INNER + gn:].reshape(b, l, SSM_GROUPS, D_STATE).astype(jnp.float32)
    dt = jax.nn.softplus(dt_raw.astype(jnp.float32) + dt_bias.astype(jnp.float32))
    a = dt * (-jnp.exp(a_log.astype(jnp.float32)))
    pad = (-l) % CHUNK
    y, h_new = _ssd_chunked(_pad_front(xs * dt[..., None], pad), _pad_front(a, pad),
                            _pad_front(bm, pad), _pad_front(cm, pad), h0.astype(jnp.float32))
    y = y[:, pad:] + xs * d_skip.astype(jnp.float32)[:, None]
    y = y.reshape(b, l, D_INNER).astype(u.dtype)
    out = _gated_group_rmsnorm(y, z, gate_g) @ w_out
    return out, new_conv, h_new.astype(h0.dtype)


def _rope_partial(x, pos):
    inv = jnp.power(jnp.float32(ROPE_THETA), -jnp.arange(0, ROT_DIM, 2, dtype=jnp.float32) / ROT_DIM)
    ang = pos.astype(jnp.float32)[:, None] * inv[None, :]
    cos = jnp.cos(ang)[None, :, None, :]
    sin = jnp.sin(ang)[None, :, None, :]
    xr = x[..., :ROT_DIM].astype(jnp.float32)
    x1, x2 = xr[..., :ROT_DIM // 2], xr[..., ROT_DIM // 2:]
    rot = jnp.concatenate([x1 * cos - x2 * sin, x2 * cos + x1 * sin], axis=-1).astype(x.dtype)
    return jnp.concatenate([rot, x[..., ROT_DIM:]], axis=-1)


def _sliding_sink_attention(q, k_all, v_all, pos0, sinks):
    b, l = q.shape[:2]
    nb = -(-l // ATTN_BLOCK)
    lp = nb * ATTN_BLOCK
    qb = jnp.pad(q, ((0, 0), (0, lp - l), (0, 0), (0, 0), (0, 0))).reshape(
        b, nb, ATTN_BLOCK, N_KV_HEADS, Q_PER_KV, HEAD_DIM)

    def band(t):
        t = jnp.pad(t, ((0, 0), (0, lp - l), (0, 0), (0, 0))).reshape(b, nb + 1, ATTN_BLOCK, N_KV_HEADS, HEAD_DIM)
        return jnp.concatenate([t[:, :-1], t[:, 1:]], axis=2)

    kb, vb = band(k_all), band(v_all)
    qpos = pos0 + jnp.arange(lp).reshape(nb, ATTN_BLOCK)
    kpos = pos0 - WINDOW + jnp.arange((nb + 1) * ATTN_BLOCK).reshape(nb + 1, ATTN_BLOCK)
    kpos = jnp.concatenate([kpos[:-1], kpos[1:]], axis=1)
    dist = qpos[:, :, None] - kpos[:, None, :]
    mask = (dist >= 0) & (dist < WINDOW) & (kpos[:, None, :] >= 0)
    s = jnp.einsum('bnqkgd,bnskd->bnkgqs', qb.astype(jnp.float32), kb.astype(jnp.float32)) * (HEAD_DIM ** -0.5)
    s = jnp.where(mask[None, :, None, None], s, -jnp.inf)
    sink = sinks.astype(jnp.float32).reshape(N_KV_HEADS, Q_PER_KV)[None, None, :, :, None, None]
    m = jnp.maximum(jnp.max(s, axis=-1, keepdims=True), sink)
    p = jnp.exp(s - m)
    p = p / (jnp.sum(p, axis=-1, keepdims=True) + jnp.exp(sink - m))
    o = jnp.einsum('bnkgqs,bnskd->bnqkgd', p, vb.astype(jnp.float32))
    return o.reshape(b, lp, N_HEADS * HEAD_DIM)[:, :l].astype(q.dtype)


def _trunk(h, pos0, conv_prev, ssm_prev, k_buf, v_buf, p):
    b, l, _ = h.shape
    pos = pos0 + jnp.arange(l)
    new_conv, new_ssm = [], []
    k_all = v_all = None
    for layer in range(DEPTH):
        if layer < N_A_LAYERS:
            i = layer
            mix, c, s = _mamba2_mixer(_rmsnorm(h, p['ssm_norm_g'][i]), conv_prev[i], ssm_prev[i],
                                      p['ssm_w_in'][i], p['ssm_conv_w'][i], p['ssm_conv_b'][i],
                                      p['ssm_dt_bias'][i], p['ssm_A_log'][i], p['ssm_D'][i],
                                      p['ssm_gate_norm_g'][i], p['ssm_w_out'][i])
            new_conv.append(c)
            new_ssm.append(s)
        else:
            i = layer - N_A_LAYERS
            if i == 0:
                kv_in = _rmsnorm(h, p['kv_norm_g'])
                k_new = _rope_partial((kv_in @ p['w_k']).reshape(b, l, N_KV_HEADS, HEAD_DIM), pos)
                v_new = (kv_in @ p['w_v']).reshape(b, l, N_KV_HEADS, HEAD_DIM)
                k_all = jnp.concatenate([k_buf.astype(k_new.dtype), k_new], axis=1)
                v_all = jnp.concatenate([v_buf.astype(v_new.dtype), v_new], axis=1)
            hn = _rmsnorm(h, p['attn_norm_g'][i])
            q = _rope_partial((hn @ p['w_q'][i]).reshape(b, l, N_HEADS, HEAD_DIM), pos)
            q = q.reshape(b, l, N_KV_HEADS, Q_PER_KV, HEAD_DIM)
            mix = _sliding_sink_attention(q, k_all, v_all, pos0, p['attn_sinks'][i]) @ p['w_o'][i]
        h = h + mix
        hn = _rmsnorm(h, p['ffn_norm_g'][layer])
        h = h + (jax.nn.silu(hn @ p['ffn_w_gate'][layer]) * (hn @ p['ffn_w_up'][layer])) @ p['ffn_w_down'][layer]
    y = _rmsnorm(h, p['final_norm_g'])
    return y, jnp.stack(new_conv), jnp.stack(new_ssm), k_all[:, -WINDOW:], v_all[:, -WINDOW:]


def setup_inputs(seed: int = 0) -> dict:
    key = jax.random.key(seed)
    ks = jax.random.split(key, 32)
    f32 = jnp.float32
    nrm = lambda k, shape, scale: jax.random.normal(k, shape, f32) * scale
    dt0 = jnp.exp(jax.random.uniform(ks[10], (N_A_LAYERS, SSM_HEADS), f32) * (np.log(DT_MAX) - np.log(DT_MIN)) + np.log(DT_MIN))
    return {
        'x_prompt': nrm(ks[0], (BATCH, SEQ, D_MODEL), 1.0),
        'x_sample': nrm(ks[1], (DEC_BATCH, DEC_SEQ, D_MODEL), 1.0),
        'state_ssm': nrm(ks[2], (N_A_LAYERS, DEC_BATCH, SSM_HEADS, SSM_HEAD_DIM, D_STATE), 0.1),
        'state_conv': nrm(ks[3], (N_A_LAYERS, DEC_BATCH, D_CONV - 1, CONV_DIM), 1.0),
        'state_k': nrm(ks[4], (DEC_BATCH, WINDOW, N_KV_HEADS, HEAD_DIM), 1.0),
        'state_v': nrm(ks[5], (DEC_BATCH, WINDOW, N_KV_HEADS, HEAD_DIM), 1.0),
        'meta_tokens': nrm(ks[6], (N_META, D_MODEL), 1.0),
        'ssm_norm_g': 1.0 + nrm(ks[7], (N_A_LAYERS, D_MODEL), 0.01),
        'ssm_w_in': nrm(ks[8], (N_A_LAYERS, D_MODEL, D_IN_PROJ), D_MODEL ** -0.5),
        'ssm_conv_w': nrm(ks[9], (N_A_LAYERS, D_CONV, CONV_DIM), D_CONV ** -0.5),
        'ssm_conv_b': nrm(ks[11], (N_A_LAYERS, CONV_DIM), 0.01),
        'ssm_dt_bias': dt0 + jnp.log(-jnp.expm1(-dt0)),
        'ssm_A_log': jnp.log(jax.random.uniform(ks[12], (N_A_LAYERS, SSM_HEADS), f32, 1.0, 16.0)),
        'ssm_D': 1.0 + nrm(ks[13], (N_A_LAYERS, SSM_HEADS), 0.1),
        'ssm_gate_norm_g': 1.0 + nrm(ks[14], (N_A_LAYERS, D_INNER), 0.01),
        'ssm_w_out': nrm(ks[15], (N_A_LAYERS, D_INNER, D_MODEL), D_INNER ** -0.5),
        'kv_norm_g': 1.0 + nrm(ks[16], (D_MODEL,), 0.01),
        'w_k': nrm(ks[17], (D_MODEL, N_KV_HEADS * HEAD_DIM), D_MODEL ** -0.5),
        'w_v': nrm(ks[18], (D_MODEL, N_KV_HEADS * HEAD_DIM), D_MODEL ** -0.5),
        'attn_norm_g': 1.0 + nrm(ks[19], (N_B_LAYERS, D_MODEL), 0.01),
        'w_q': nrm(ks[20], (N_B_LAYERS, D_MODEL, N_HEADS * HEAD_DIM), D_MODEL ** -0.5),
        'attn_sinks': nrm(ks[21], (N_B_LAYERS, N_HEADS), 0.5),
        'w_o': nrm(ks[22], (N_B_LAYERS, N_HEADS * HEAD_DIM, D_MODEL), (N_HEADS * HEAD_DIM) ** -0.5),
        'ffn_norm_g': 1.0 + nrm(ks[23], (DEPTH, D_MODEL), 0.01),
        'ffn_w_gate': nrm(ks[24], (DEPTH, D_MODEL, D_FF), D_MODEL ** -0.5),
        'ffn_w_up': nrm(ks[25], (DEPTH, D_MODEL, D_FF), D_MODEL ** -0.5),
        'ffn_w_down': nrm(ks[26], (DEPTH, D_FF, D_MODEL), D_FF ** -0.5),
        'final_norm_g': 1.0 + nrm(ks[27], (D_MODEL,), 0.01),
    }


def reference(x_prompt, x_sample, state_ssm, state_conv, state_k, state_v, meta_tokens,
              ssm_norm_g, ssm_w_in, ssm_conv_w, ssm_conv_b, ssm_dt_bias, ssm_A_log, ssm_D,
              ssm_gate_norm_g, ssm_w_out, kv_norm_g, w_k, w_v, attn_norm_g, w_q, attn_sinks, w_o,
              ffn_norm_g, ffn_w_gate, ffn_w_up, ffn_w_down, final_norm_g):
    p = dict(ssm_norm_g=ssm_norm_g, ssm_w_in=ssm_w_in, ssm_conv_w=ssm_conv_w, ssm_conv_b=ssm_conv_b,
             ssm_dt_bias=ssm_dt_bias, ssm_A_log=ssm_A_log, ssm_D=ssm_D, ssm_gate_norm_g=ssm_gate_norm_g,
             ssm_w_out=ssm_w_out, kv_norm_g=kv_norm_g, w_k=w_k, w_v=w_v, attn_norm_g=attn_norm_g,
             w_q=w_q, attn_sinks=attn_sinks, w_o=w_o, ffn_norm_g=ffn_norm_g, ffn_w_gate=ffn_w_gate,
             ffn_w_up=ffn_w_up, ffn_w_down=ffn_w_down, final_norm_g=final_norm_g)
    dt = x_prompt.dtype
    b = x_prompt.shape[0]
    h_p = jnp.concatenate([jnp.broadcast_to(meta_tokens.astype(dt)[None], (b, N_META, D_MODEL)), x_prompt], axis=1)
    y_p, conv_p, ssm_p, k_p, v_p = _trunk(
        h_p, 0,
        jnp.zeros((N_A_LAYERS, b, D_CONV - 1, CONV_DIM), dt),
        jnp.zeros((N_A_LAYERS, b, SSM_HEADS, SSM_HEAD_DIM, D_STATE), dt),
        jnp.zeros((b, WINDOW, N_KV_HEADS, HEAD_DIM), dt),
        jnp.zeros((b, WINDOW, N_KV_HEADS, HEAD_DIM), dt), p)
    y_prompt = y_p[:, N_META:]
    y_sample, conv_s, ssm_s, k_s, v_s = _trunk(x_sample, PAST_LEN, state_conv, state_ssm, state_k, state_v, p)
    return (y_prompt, y_sample, ssm_p, conv_p, k_p, v_p, ssm_s, conv_s, k_s, v_s)
```

```cpp
#include <hip/hip_runtime.h>
#include <hip/hip_cooperative_groups.h>
#include <cstdio>
#include <cstdint>
namespace cg = cooperative_groups;

#ifndef MK_MULTI
#define MK_MULTI 1
#endif

#define LAS __attribute__((address_space(3)))
typedef unsigned short bf16_t;
typedef short bf16x8 __attribute__((ext_vector_type(8)));
typedef float f32x4 __attribute__((ext_vector_type(4)));
typedef float f32x2 __attribute__((ext_vector_type(2)));
typedef unsigned u32x4 __attribute__((ext_vector_type(4)));
typedef unsigned u32x2 __attribute__((ext_vector_type(2)));

constexpr int DM = 1024, NBATCH = 16, LP = 2064, DECB = 128, DECS = 8;
constexpr int TP = NBATCH * LP;
constexpr int TS = DECB * DECS;
constexpr int T = TP + TS;
constexpr int DI = 2048, CONVD = 3072, NH = 32, DFF = 2816;
constexpr int ZXW = 5120;
constexpr int NIN = 5376;
constexpr int NKVQ = 1536;
constexpr float EPS = 1e-5f;

constexpr size_t O_YP = 0, O_YS = 33554432, O_SSMP = 34603008, O_CONVP = 38797312, O_KP = 38944768, O_VP = 39469056,
                 O_SSMS = 39993344, O_CONVS = 73547776, O_KS = 74727424, O_VS = 78921728;

constexpr size_t MiB = 1u << 20;
constexpr size_t WS_SS = 0;
constexpr size_t WS_ROPE = 1 * MiB;
constexpr size_t WS_DT = 2 * MiB;
constexpr size_t WS_WIN = 8 * MiB, WS_WOUT = 19 * MiB, WS_WGU0 = 23 * MiB, WS_WGU1 = 34 * MiB, WS_WD0 = 45 * MiB, WS_WD1 = 51 * MiB,
                 WS_WKVQ = 57 * MiB, WS_WO = 60 * MiB;
constexpr size_t WS_HB = 64 * MiB;
constexpr size_t WS_BIG = 132 * MiB;
constexpr size_t WS_Q = WS_BIG, WS_K = WS_BIG + 67 * MiB, WS_V = WS_BIG + 84 * MiB, WS_O = WS_BIG + 101 * MiB;
constexpr size_t WS_END = WS_BIG + (size_t)T * ZXW * 2;

constexpr int LDS_BYTES = 135168;

__device__ __forceinline__ unsigned cvt_pk_bf16(float lo, float hi) { unsigned r; asm volatile("v_cvt_pk_bf16_f32 %0, %1, %2" : "=v"(r) : "v"(lo), "v"(hi)); return r; }
__device__ __forceinline__ float bf_lo(unsigned w) { return __uint_as_float(w << 16); }
__device__ __forceinline__ float bf_hi(unsigned w) { return __uint_as_float(w & 0xffff0000u); }
__device__ __forceinline__ float bf1(unsigned short h) { return __uint_as_float(((unsigned)h) << 16); }
__device__ __forceinline__ float silu_f(float x) { return x * __builtin_amdgcn_rcpf(1.0f + __expf(-x)); }
__device__ __forceinline__ float wave_sum(float v) {
#pragma unroll
    for (int o = 1; o < 64; o <<= 1) v += __shfl_xor(v, o);
    return v;
}
__device__ __forceinline__ float rs_row(const float* ss, int row) { return rsqrtf(ss[row] * (1.0f / 1024.0f) + EPS); }

namespace pg8 {
constexpr int BM = 256, BK = 64, HALF = 128, HTB = HALF * BK * 2, STAGE_BYTES = 8 * HTB, NXCD = 8, WGM = 8;
__host__ __device__ __forceinline__ int lds_byte(int r, int c) { const int st = (r >> 4) * 2 + (c >> 5), rr = r & 15, cc = c & 31, ob = rr * 64 + cc * 2; return st * 1024 + (ob ^ (((ob >> 9) & 1) << 5)); }
__host__ __device__ __forceinline__ void stage_rc(int b, int& R, int& C) { const int st = b / 1024, sb = b % 1024, swz = sb ^ (((sb >> 9) & 1) << 5); R = (st >> 1) * 16 + swz / 64; C = (st & 1) * 32 + (swz % 64) / 2; }
__host__ __device__ __forceinline__ int perm32(int rho) { const int n = rho >> 4, i = rho & 15; return 8 * (i >> 2) + 4 * n + (i & 3); }
struct Unit { int pm, pn; };
struct Gemm { const bf16_t* A; const bf16_t* Bt; int M, N, K, lda; };
struct StaticOrder {
    int nM, nN, nwg, G, c;
    __device__ __forceinline__ void init(int M, int N, int G_, int c_) { nM = M / BM; nN = N / BM; nwg = nM * nN; G = G_; c = c_; }
    __device__ __forceinline__ bool next(int i, Unit& u) const {
        const long L = (long)i * G + c; if (L >= nwg) return false;
        int wgid = (int)L; { const int q = nwg / NXCD, r = nwg % NXCD, xcd = wgid % NXCD, off = wgid / NXCD; wgid = (xcd < r ? xcd * (q + 1) : r * (q + 1) + (xcd - r) * q) + off; }
        const int nig = WGM * nN, gid = wgid / nig, fm = gid * WGM, gsz = (nM - fm) < WGM ? (nM - fm) : WGM;
        u.pm = fm + ((wgid % nig) % gsz); u.pn = (wgid % nig) / gsz; return true;
    }
};
template <class Epi>
__device__ __forceinline__ void gemm_phase(LAS unsigned char* lds, const Gemm g, const StaticOrder& S, const Epi& E) {
    const int tid = threadIdx.x, wid = __builtin_amdgcn_readfirstlane(tid >> 6), lane = tid & 63, wr = wid >> 2, wc = wid & 3, fr = lane & 15, fq = lane >> 4;
    const int K = g.K, nt = K / BK, lda = g.lda;
    unsigned voffA[2], voffB[2];
#pragma unroll
    for (int i = 0; i < 2; ++i) { int R, C; stage_rc(tid * 16 + i * 8192, R, C); const int Rb = (R & ~31) + perm32(R & 31);
        voffA[i] = (unsigned)(R * lda + C) * 2u; voffB[i] = (unsigned)(Rb * K + C) * 2u; }
    const size_t kstep = (size_t)(BK * 2);
    const size_t hstepA = (size_t)HALF * lda * 2, tstepA = 2 * hstepA;
    const size_t hstepB = (size_t)HALF * K * 2, tstepB = 2 * hstepB;
    const unsigned ldsw = (unsigned)wid * 1024u;
    const int aoff = lds_byte(wr * 64 + fr, fq * 8), boff = lds_byte(wc * 32 + fr, fq * 8);
#define PG8_SA(b, h) (((b) * 2 + (h)) * HTB)
#define PG8_SB(b, h) ((4 + (b) * 2 + (h)) * HTB)
#define PG8_STAGE(bufoff, gbase, voff) do { _Pragma("unroll") for (int _i = 0; _i < 2; ++_i) \
        __builtin_amdgcn_global_load_lds((const unsigned*)((const char*)(gbase) + (voff)[_i]), (LAS unsigned*)(lds + (bufoff) + ldsw + _i * 8192), 16, 0, 0); } while (0)
#define PG8_LDA(dst, b, h) do { _Pragma("unroll") for (int m = 0; m < 4; ++m) _Pragma("unroll") for (int k = 0; k < 2; ++k) dst[m][k] = *(const LAS bf16x8*)(lds + PG8_SA(b, h) + aoff + m * 2048 + k * 1024); } while (0)
#define PG8_LDB(dst, b, h) do { _Pragma("unroll") for (int n = 0; n < 2; ++n) _Pragma("unroll") for (int k = 0; k < 2; ++k) dst[n][k] = *(const LAS bf16x8*)(lds + PG8_SB(b, h) + boff + n * 2048 + k * 1024); } while (0)
#define PG8_MMA(ai, bj, At, Bt) do { __builtin_amdgcn_s_setprio(1); _Pragma("unroll") for (int m = 0; m < 4; ++m) _Pragma("unroll") for (int n = 0; n < 2; ++n) _Pragma("unroll") for (int k = 0; k < 2; ++k) \
        acc[ai][bj][m][n] = __builtin_amdgcn_mfma_f32_16x16x32_bf16(Bt[n][k], At[m][k], acc[ai][bj][m][n], 0, 0, 0); __builtin_amdgcn_s_setprio(0); } while (0)
#define PG8_WAIT_V(n) asm volatile("s_waitcnt vmcnt(" #n ")" ::: "memory")
#define PG8_WAIT_L(n) asm volatile("s_waitcnt lgkmcnt(" #n ")" ::: "memory")
#define PG8_BAR __builtin_amdgcn_s_barrier()
#define PG8_SCHED __builtin_amdgcn_sched_barrier(0)
    Unit cur, nxt; int ui = 0;
    if (!S.next(0, cur)) return;
    f32x4 acc[2][2][4][2];
#pragma unroll
    for (int a = 0; a < 2; ++a)
#pragma unroll
        for (int b = 0; b < 2; ++b)
#pragma unroll
            for (int m = 0; m < 4; ++m)
#pragma unroll
                for (int n = 0; n < 2; ++n) acc[a][b][m][n] = (f32x4){0.f, 0.f, 0.f, 0.f};
    bf16x8 At[4][2], B0[2][2], B1[2][2];
    const char* cA = (const char*)g.A + (size_t)cur.pm * tstepA; const char* cB = (const char*)g.Bt + (size_t)cur.pn * tstepB;
    PG8_STAGE(PG8_SB(0, 0), cB, voffB); PG8_STAGE(PG8_SA(0, 0), cA, voffA); PG8_STAGE(PG8_SB(0, 1), cB + hstepB, voffB); PG8_STAGE(PG8_SA(0, 1), cA + hstepA, voffA);
    if (wr == 1) PG8_BAR;
    PG8_WAIT_V(4); PG8_BAR;
    PG8_STAGE(PG8_SB(1, 0), cB + kstep, voffB); PG8_STAGE(PG8_SA(1, 0), cA + kstep, voffA); PG8_STAGE(PG8_SB(1, 1), cB + hstepB + kstep, voffB);
    PG8_WAIT_V(6); PG8_BAR;
    for (;;) {
        const bool has_next = S.next(ui + 1, nxt);
        const char* nA = has_next ? (const char*)g.A + (size_t)nxt.pm * tstepA : cA; const char* nB = has_next ? (const char*)g.Bt + (size_t)nxt.pn * tstepB : cB;
        for (int t = 0; t < nt; t += 2) {
            const bool last = (t == nt - 2);
            const char* a1 = cA + (size_t)(t + 1) * kstep;
            const char* a2 = last ? nA : cA + (size_t)(t + 2) * kstep; const char* b2 = last ? nB : cB + (size_t)(t + 2) * kstep;
            const char* a3 = a2 + kstep; const char* b3 = b2 + kstep;
            PG8_LDB(B0, 0, 0); PG8_SCHED; PG8_LDA(At, 0, 0); PG8_STAGE(PG8_SA(1, 1), a1 + hstepA, voffA);
            PG8_WAIT_L(8); PG8_BAR; PG8_WAIT_L(0); PG8_MMA(0, 0, At, B0); PG8_BAR; PG8_SCHED;
            PG8_LDB(B1, 0, 1); PG8_STAGE(PG8_SB(0, 0), b2, voffB);
            PG8_BAR; PG8_WAIT_L(0); PG8_MMA(0, 1, At, B1); PG8_BAR;
            PG8_LDA(At, 0, 1); PG8_STAGE(PG8_SA(0, 0), a2, voffA);
            PG8_BAR; PG8_WAIT_L(0); PG8_MMA(1, 0, At, B0); PG8_BAR; PG8_SCHED;
            PG8_STAGE(PG8_SB(0, 1), b2 + hstepB, voffB);
            PG8_WAIT_V(6); PG8_BAR; PG8_MMA(1, 1, At, B1); PG8_BAR;
            PG8_LDB(B0, 1, 0); PG8_SCHED; PG8_LDA(At, 1, 0); PG8_STAGE(PG8_SA(0, 1), a2 + hstepA, voffA);
            PG8_WAIT_L(8); PG8_BAR; PG8_WAIT_L(0); PG8_MMA(0, 0, At, B0); PG8_BAR; PG8_SCHED;
            PG8_LDB(B1, 1, 1); PG8_STAGE(PG8_SB(1, 0), b3, voffB);
            PG8_BAR; PG8_WAIT_L(0); PG8_MMA(0, 1, At, B1); PG8_BAR;
            PG8_LDA(At, 1, 1); PG8_STAGE(PG8_SA(1, 0), a3, voffA);
            PG8_BAR; PG8_WAIT_L(0); PG8_MMA(1, 0, At, B0); PG8_BAR; PG8_SCHED;
            PG8_STAGE(PG8_SB(1, 1), b3 + hstepB, voffB);
            PG8_WAIT_V(6); PG8_BAR; PG8_MMA(1, 1, At, B1); PG8_BAR;
        }
        E(acc, cur, wr, wc, fr, fq);
        if (!has_next) break;
#pragma unroll
        for (int a = 0; a < 2; ++a)
#pragma unroll
            for (int b = 0; b < 2; ++b)
#pragma unroll
                for (int m = 0; m < 4; ++m)
#pragma unroll
                    for (int n = 0; n < 2; ++n) acc[a][b][m][n] = (f32x4){0.f, 0.f, 0.f, 0.f};
        cur = nxt; cA = nA; cB = nB; ++ui;
    }
    PG8_WAIT_V(0);
    if (wr == 0) PG8_BAR;
    PG8_BAR;
#undef PG8_SA
#undef PG8_SB
#undef PG8_STAGE
#undef PG8_LDA
#undef PG8_LDB
#undef PG8_MMA
#undef PG8_WAIT_V
#undef PG8_WAIT_L
#undef PG8_BAR
#undef PG8_SCHED
}
}
using pg8::Unit;

__device__ __forceinline__ u32x4 pack8(const f32x4 v0, const f32x4 v1) {
    u32x4 w; w.x = cvt_pk_bf16(v0[0], v0[1]); w.y = cvt_pk_bf16(v0[2], v0[3]); w.z = cvt_pk_bf16(v1[0], v1[1]); w.w = cvt_pk_bf16(v1[2], v1[3]); return w;
}
struct EpiInProj {
    bf16_t* zx; float* dtraw; const float* ss;
    __device__ __forceinline__ void operator()(const f32x4 (&acc)[2][2][4][2], const Unit& u, int wr, int wc, int fr, int fq) const {
        const int row0 = u.pm * 256 + wr * 64 + fr;
#pragma unroll
        for (int ai = 0; ai < 2; ++ai)
#pragma unroll
            for (int m = 0; m < 4; ++m) {
                const int row = row0 + ai * 128 + m * 16; const float r = rs_row(ss, row);
                if (u.pn < 20) {
#pragma unroll
                    for (int bj = 0; bj < 2; ++bj) { const int col = u.pn * 256 + bj * 128 + wc * 32 + 8 * fq;
                        *(u32x4*)(zx + (size_t)row * ZXW + col) = pack8(acc[ai][bj][m][0] * r, acc[ai][bj][m][1] * r); }
                } else if (wc == 0) {
                    float* d = dtraw + (size_t)row * 32 + 8 * fq;
                    *(f32x4*)d = acc[ai][0][m][0] * r; *(f32x4*)(d + 4) = acc[ai][0][m][1] * r;
                }
            }
    }
};
template <bool FINAL> struct EpiResid {
    bf16_t* hb; float* ssn; float* out;
    __device__ __forceinline__ void operator()(const f32x4 (&acc)[2][2][4][2], const Unit& u, int wr, int wc, int fr, int fq) const {
        const int row0 = u.pm * 256 + wr * 64 + fr;
#pragma unroll
        for (int ai = 0; ai < 2; ++ai)
#pragma unroll
            for (int m = 0; m < 4; ++m) {
                const int row = row0 + ai * 128 + m * 16; float s = 0.f;
                float* yrow = nullptr;
                if (FINAL) { if (row < TP) { const int b = row / LP, t = row - b * LP; if (t >= 16) yrow = out + O_YP + ((size_t)(b * 2048 + t - 16)) * DM; } else yrow = out + O_YS + (size_t)(row - TP) * DM; }
#pragma unroll
                for (int bj = 0; bj < 2; ++bj) { const int col = u.pn * 256 + bj * 128 + wc * 32 + 8 * fq;
                    bf16_t* p = hb + (size_t)row * DM + col; const u32x4 o = *(const u32x4*)p;
                    f32x4 v0 = acc[ai][bj][m][0], v1 = acc[ai][bj][m][1];
                    v0[0] += bf_lo(o.x); v0[1] += bf_hi(o.x); v0[2] += bf_lo(o.y); v0[3] += bf_hi(o.y);
                    v1[0] += bf_lo(o.z); v1[1] += bf_hi(o.z); v1[2] += bf_lo(o.w); v1[3] += bf_hi(o.w);
                    s += (v0[0] * v0[0] + v0[1] * v0[1]) + (v0[2] * v0[2] + v0[3] * v0[3]) + (v1[0] * v1[0] + v1[1] * v1[1]) + (v1[2] * v1[2] + v1[3] * v1[3]);
                    if (FINAL) { if (yrow) { *(f32x4*)(yrow + col) = v0; *(f32x4*)(yrow + col + 4) = v1; } }
                    else *(u32x4*)p = pack8(v0, v1); }
                s += __shfl_xor(s, 16); s += __shfl_xor(s, 32);
                if (fq == 0) atomicAdd(ssn + row, s);
            }
    }
};
struct EpiSwiglu {
    bf16_t* act; const float* ss;
    __device__ __forceinline__ void operator()(const f32x4 (&acc)[2][2][4][2], const Unit& u, int wr, int wc, int fr, int fq) const {
        const int row0 = u.pm * 256 + wr * 64 + fr, col = u.pn * 128 + wc * 32 + 8 * fq;
#pragma unroll
        for (int ai = 0; ai < 2; ++ai)
#pragma unroll
            for (int m = 0; m < 4; ++m) {
                const int row = row0 + ai * 128 + m * 16; const float r = rs_row(ss, row);
                f32x4 o[2];
#pragma unroll
                for (int n = 0; n < 2; ++n)
#pragma unroll
                    for (int j = 0; j < 4; ++j) { const float g = acc[ai][0][m][n][j] * r, uu = acc[ai][1][m][n][j] * r; o[n][j] = silu_f(g) * uu; }
                *(u32x4*)(act + (size_t)row * DFF + col) = pack8(o[0], o[1]);
            }
    }
};
struct EpiKVQ {
    bf16_t *kb, *vb, *qb; const float* ss; const float* rope; float* out;
    __device__ __forceinline__ void operator()(const f32x4 (&acc)[2][2][4][2], const Unit& u, int wr, int wc, int fr, int fq) const {
        const int row0 = u.pm * 256 + wr * 64 + fr;
        const bool do_rope = (u.pn != 1) && ((wc & 1) == 0);
#pragma unroll
        for (int ai = 0; ai < 2; ++ai)
#pragma unroll
            for (int m = 0; m < 4; ++m) {
                const int row = row0 + ai * 128 + m * 16; const float r = rs_row(ss, row);
                int b, t, pidx; long kvrow;
                if (row < TP) { b = row / LP; t = row - b * LP; pidx = t; kvrow = (t >= LP - 128) ? (long)b * 128 + (t - (LP - 128)) : -1; }
                else { const int ms = row - TP; b = ms >> 3; t = ms & 7; pidx = LP + t; kvrow = (long)b * 128 + 120 + t; }
                f32x4 cs0 = {1.f, 1.f, 1.f, 1.f}, cs1 = cs0, sn0 = {0.f, 0.f, 0.f, 0.f}, sn1 = sn0;
                if (do_rope && fq < 2) { const float* rp = rope + (size_t)pidx * 16; cs0 = *(const f32x4*)rp; cs1 = *(const f32x4*)(rp + 4); sn0 = *(const f32x4*)(rp + 8); sn1 = *(const f32x4*)(rp + 12);
                    if (fq == 0) { sn0 = -sn0; sn1 = -sn1; } }
#pragma unroll
                for (int bj = 0; bj < 2; ++bj) {
                    const int colt = bj * 128 + wc * 32 + 8 * fq;
                    f32x4 v0 = acc[ai][bj][m][0] * r, v1 = acc[ai][bj][m][1] * r;
                    if (do_rope) {
                        f32x4 p0, p1;
#pragma unroll
                        for (int j = 0; j < 4; ++j) { p0[j] = __shfl_xor(v0[j], 16); p1[j] = __shfl_xor(v1[j], 16); }
                        v0 = v0 * cs0 + p0 * sn0; v1 = v1 * cs1 + p1 * sn1;
                    }
                    const u32x4 w = pack8(v0, v1);
                    if (u.pn == 0) { *(u32x4*)(kb + (size_t)row * 256 + colt) = w;
                        if (kvrow >= 0) { float* d = out + (row < TP ? O_KP : O_KS) + (size_t)kvrow * 256 + colt; *(f32x4*)d = v0; *(f32x4*)(d + 4) = v1; } }
                    else if (u.pn == 1) { *(u32x4*)(vb + (size_t)row * 256 + colt) = w;
                        if (kvrow >= 0) { float* d = out + (row < TP ? O_VP : O_VS) + (size_t)kvrow * 256 + colt; *(f32x4*)d = v0; *(f32x4*)(d + 4) = v1; } }
                    else *(u32x4*)(qb + (size_t)row * DM + (u.pn - 2) * 256 + colt) = w;
                }
            }
    }
};

struct Args { const float* in[28]; float* out; unsigned char* ws; int lo, hi; };
enum { I_XP = 0, I_XS, I_SSSM, I_SCONV, I_SK, I_SV, I_META, I_SSMG, I_WIN, I_CONVW, I_CONVB, I_DTB, I_ALOG, I_DSKIP, I_GATEG, I_WOUT, I_KVG, I_WK, I_WV,
       I_ATTNG, I_WQ, I_SINKS, I_WOP, I_FFNG, I_WGATE, I_WUP, I_WDOWN, I_FING };

__device__ __forceinline__ void p0_item(const float* W, int ld, int col0, const float* g, float sc, bf16_t* WT, int K, int drow0, int k0, LAS float* scr, int lane) {
#pragma unroll 8
    for (int i = 0; i < 32; ++i) { const int kk = 2 * i + (lane >> 5); float v = 0.f;
        if (W) v = W[(size_t)(k0 + kk) * ld + col0 + (lane & 31)] * (g ? g[k0 + kk] : 1.0f) * sc;
        scr[kk * 33 + (lane & 31)] = v; }
    asm volatile("s_waitcnt lgkmcnt(0)" ::: "memory");
    const int c = lane & 7;
#pragma unroll
    for (int j = 0; j < 4; ++j) { const int n = (lane >> 3) + 8 * j; const LAS float* s = scr + (8 * c) * 33 + n;
        u32x4 o; o.x = cvt_pk_bf16(s[0], s[33]); o.y = cvt_pk_bf16(s[66], s[99]); o.z = cvt_pk_bf16(s[132], s[165]); o.w = cvt_pk_bf16(s[198], s[231]);
        *(u32x4*)(WT + (size_t)(drow0 + n) * K + k0 + 8 * c) = o; }
    asm volatile("s_waitcnt lgkmcnt(0)" ::: "memory");
}
__device__ __forceinline__ const float* src_row(const Args& a, int m) {
    if (m < TP) { const int b = m / LP, t = m - b * LP; return t < 16 ? a.in[I_META] + (size_t)t * DM : a.in[I_XP] + ((size_t)b * 2048 + (t - 16)) * DM; }
    return a.in[I_XS] + (size_t)(m - TP) * DM;
}
__device__ __forceinline__ void p0_prologue(const Args& a, LAS unsigned char* lds) {
    const int tid = threadIdx.x, lane = tid & 63, wave = __builtin_amdgcn_readfirstlane(tid >> 6);
    const int gw = blockIdx.x * 8 + wave, NGW = gridDim.x * 8;
    unsigned char* ws = a.ws;
    LAS float* scr = (LAS float*)(lds + wave * 8704);
    constexpr int N0 = (NIN / 32) * 16, N1 = 32 * 32, N2 = 176 * 16, N3 = N2, N4 = 32 * 44, N5 = N4, N6 = 48 * 16, N7 = 32 * 16;
    constexpr int NITEMS = N0 + N1 + N2 + N3 + N4 + N5 + N6 + N7;
    for (int it = gw; it < NITEMS; it += NGW) {
        int r = it;
        if (r < N0) { const int nb = r / 16, kb = r % 16; const bool real = nb * 32 < 5152;
            p0_item(real ? a.in[I_WIN] : nullptr, 5152, nb * 32, a.in[I_SSMG], 1.f, (bf16_t*)(ws + WS_WIN), 1024, nb * 32, kb * 64, scr, lane); continue; } r -= N0;
        if (r < N1) { const int nb = r / 32, kb = r % 32;
            p0_item(a.in[I_WOUT], 1024, nb * 32, a.in[I_GATEG], 1.f, (bf16_t*)(ws + WS_WOUT), 2048, nb * 32, kb * 64, scr, lane); continue; } r -= N1;
        if (r < N2 + N3) { const int layer = r >= N2; if (layer) r -= N2; const int nb = r / 16, kb = r % 16, tile = nb >> 3, w = nb & 7;
            const float* src = (w < 4 ? a.in[I_WGATE] : a.in[I_WUP]) + (size_t)layer * 1024 * DFF;
            p0_item(src, DFF, tile * 128 + (w & 3) * 32, a.in[I_FFNG] + layer * 1024, 1.f, (bf16_t*)(ws + (layer ? WS_WGU1 : WS_WGU0)), 1024, nb * 32, kb * 64, scr, lane); continue; } r -= N2 + N3;
        if (r < N4 + N5) { const int layer = r >= N4; if (layer) r -= N4; const int nb = r / 44, kb = r % 44;
            p0_item(a.in[I_WDOWN] + (size_t)layer * DFF * 1024, 1024, nb * 32, nullptr, 1.f, (bf16_t*)(ws + (layer ? WS_WD1 : WS_WD0)), DFF, nb * 32, kb * 64, scr, lane); continue; } r -= N4 + N5;
        if (r < N6) { const int nb = r / 16, kb = r % 16;
            if (nb < 8) p0_item(a.in[I_WK], 256, nb * 32, a.in[I_KVG], 1.f, (bf16_t*)(ws + WS_WKVQ), 1024, nb * 32, kb * 64, scr, lane);
            else if (nb < 16) p0_item(a.in[I_WV], 256, (nb - 8) * 32, a.in[I_KVG], 1.f, (bf16_t*)(ws + WS_WKVQ), 1024, nb * 32, kb * 64, scr, lane);
            else p0_item(a.in[I_WQ], 1024, (nb - 16) * 32, a.in[I_ATTNG], 0.125f, (bf16_t*)(ws + WS_WKVQ), 1024, nb * 32, kb * 64, scr, lane);
            continue; } r -= N6;
        { const int nb = r / 16, kb = r % 16; p0_item(a.in[I_WOP], 1024, nb * 32, nullptr, 1.f, (bf16_t*)(ws + WS_WO), 1024, nb * 32, kb * 64, scr, lane); }
    }
    float* ss = (float*)(ws + WS_SS);
    bf16_t* hb = (bf16_t*)(ws + WS_HB);
    for (int m = gw; m < T; m += NGW) {
        const f32x4* xr = (const f32x4*)src_row(a, m) + lane; f32x4 v[4]; float s = 0.f;
#pragma unroll
        for (int j = 0; j < 4; ++j) { v[j] = xr[64 * j]; s += (v[j][0] * v[j][0] + v[j][1] * v[j][1]) + (v[j][2] * v[j][2] + v[j][3] * v[j][3]); }
        s = wave_sum(s);
        u32x2* o = (u32x2*)(hb + (size_t)m * DM) + lane;
#pragma unroll
        for (int j = 0; j < 4; ++j) { u32x2 w; w.x = cvt_pk_bf16(v[j][0], v[j][1]); w.y = cvt_pk_bf16(v[j][2], v[j][3]); o[64 * j] = w; }
        if (lane == 0) { ss[m] = s; ss[T + m] = 0.f; ss[2 * T + m] = 0.f; ss[3 * T + m] = 0.f; ss[4 * T + m] = 0.f; }
    }
    float* rope = (float*)(ws + WS_ROPE);
    for (int e = blockIdx.x * 512 + tid; e < 2072 * 8; e += gridDim.x * 512) {
        const int pi = e >> 3, i = e & 7; const double pos = (double)(pi < LP ? pi : 16384 + pi - LP);
        const double inv = i == 0 ? 1.0 : i == 1 ? 0.19392274474868576 : i == 2 ? 0.03760603093086393 : i == 3 ? 0.007292664737217109 : i == 4 ? 0.001414213562373095
                         : i == 5 ? 0.0002742481756762073 : i == 6 ? 5.318295896944988e-05 : 1.031338537721246e-05;
        const double rev = pos * inv * 0.15915494309189535; const float fr = (float)(rev - __builtin_rint(rev));
        rope[pi * 16 + i] = __builtin_amdgcn_cosf(fr); rope[pi * 16 + 8 + i] = __builtin_amdgcn_sinf(fr);
    }
}

constexpr int L_CM = 0, L_BM = 8704, L_BT = 17408, L_XW = 27648, L_XD = 37888, L_XT = 48128, L_DTB = 58368;
__device__ __forceinline__ void ssd_phase(const Args& a, LAS unsigned char* lds) {
    const int tid = threadIdx.x, lane = tid & 63, wave = __builtin_amdgcn_readfirstlane(tid >> 6), fr = lane & 15, fq = lane >> 4;
    bf16_t* zx = (bf16_t*)(a.ws + WS_BIG);
    const float* dtraw = (const float*)(a.ws + WS_DT);
    const int NUNITS = 256 + 2048;
    for (int unit = blockIdx.x; unit < NUNITS; unit += gridDim.x) {
        const bool samp = unit >= 256; int b, g, hp;
        if (!samp) { b = unit >> 4; g = (unit >> 2) & 3; hp = unit & 3; } else { const int u2 = unit - 256; b = u2 >> 4; g = (u2 >> 2) & 3; hp = u2 & 3; }
        const int row0 = samp ? TP + b * 8 : b * LP, L = samp ? 8 : LP, nch = samp ? 1 : 65, h0 = g * 8 + hp * 2;
        const bool convthr = tid < 384; const int pr = convthr ? tid % 192 : 0, th = convthr ? tid / 192 : 0;
        int col;
        if (pr < 64) col = h0 * 64 + 2 * pr; else if (pr < 128) col = 2048 + g * 128 + 2 * (pr - 64); else col = 2560 + g * 128 + 2 * (pr - 128);
        float cw[4][2], cb[2];
#pragma unroll
        for (int k = 0; k < 4; ++k) { cw[k][0] = a.in[I_CONVW][k * CONVD + col]; cw[k][1] = a.in[I_CONVW][k * CONVD + col + 1]; }
        cb[0] = a.in[I_CONVB][col]; cb[1] = a.in[I_CONVB][col + 1];
        const bool wr_conv = (pr < 64) || (hp == 0);
        float* ncv = a.out + (samp ? O_CONVS : O_CONVP) + (size_t)b * 3 * CONVD + col;
        const int dth = wave - 6;
        const float dtbias = (wave >= 6) ? a.in[I_DTB][h0 + dth] : 0.f, negA = (wave >= 6) ? -__expf(a.in[I_ALOG][h0 + dth]) : 0.f;
        const int hh = wave >> 2, pq = wave & 3, h = h0 + hh, prow = hh * 64 + pq * 16 + fr;
        const float dskip = a.in[I_DSKIP][h];
        f32x4 st[8];
        if (samp) { const float* sp = a.in[I_SSSM] + ((size_t)(b * NH + h) * 64 + pq * 16 + fr) * 128 + 4 * fq;
#pragma unroll
            for (int nt = 0; nt < 8; ++nt) st[nt] = *(const f32x4*)(sp + 16 * nt); }
        else {
#pragma unroll
            for (int nt = 0; nt < 8; ++nt) st[nt] = (f32x4){0.f, 0.f, 0.f, 0.f}; }
        unsigned raw[19];
#define SSD_FETCH(c) do { int th_o = th, col_o = col; asm volatile("" : "+v"(th_o), "+v"(col_o)); _Pragma("unroll") for (int j = 0; j < 19; ++j) { const int tg = 32 * (c) + 16 * th_o - 3 + j; \
            const bool ok = convthr && tg >= 0 && tg < L; const int tgc = ok ? tg : 0; \
            const unsigned v = *(const unsigned*)(zx + (size_t)(row0 + tgc) * ZXW + 2048 + col_o); raw[j] = ok ? v : 0u; } \
            if (samp && (c) == 0 && convthr && th == 0) { _Pragma("unroll") for (int j = 0; j < 3; ++j) { const float* sc = a.in[I_SCONV] + ((size_t)b * 3 + j) * CONVD + col; raw[j] = cvt_pk_bf16(sc[0], sc[1]); } } } while (0)
#define SSD_DT(c) do { if (wave >= 6) { const int tg = 32 * (c) + lane; float dt = 0.f; \
            if (lane < 32 && tg < L) { const float x = dtraw[(size_t)(row0 + tg) * 32 + h0 + dth] + dtbias; dt = fmaxf(x, 0.f) + __logf(1.0f + __expf(-fabsf(x))); } \
            float cs = dt * negA; \
            _Pragma("unroll") for (int o = 1; o < 32; o <<= 1) { const float up = __shfl_up(cs, o); if ((lane & 31) >= o) cs += up; } \
            const float cl = __shfl(cs, 31); \
            if (lane < 32) { LAS float* d = (LAS float*)(lds + L_DTB) + (((c) & 1) * 2 + dth) * 96; d[lane] = cs; d[32 + lane] = dt; d[64 + lane] = __expf(cl - cs); } } } while (0)
        __syncthreads();
        SSD_FETCH(0); SSD_DT(0);
        __syncthreads();
        for (int c = 0; c < nch; ++c) {
            if (convthr) {
                const LAS float* dtb = (const LAS float*)(lds + L_DTB) + ((c & 1) * 2 + (pr >> 5)) * 96;
#pragma unroll
                for (int hf = 0; hf < 2; ++hf) {
                    unsigned pk[3][2][4];
                    float prev[3][2];
#pragma unroll
                    for (int i8 = 0; i8 < 8; ++i8) {
                        const int i = 8 * hf + i8, tl = 16 * th + i, tg = 32 * c + tl; const bool valid = tg < L;
                        float v0 = cb[0], v1 = cb[1];
#pragma unroll
                        for (int k = 0; k < 4; ++k) { v0 += cw[k][0] * bf_lo(raw[i + k]); v1 += cw[k][1] * bf_hi(raw[i + k]); }
                        v0 = valid ? silu_f(v0) : 0.f; v1 = valid ? silu_f(v1) : 0.f;
                        if (wr_conv && tg >= L - 3 && tg < L) { float* d = ncv + (size_t)(tg - (L - 3)) * CONVD; d[0] = bf_lo(raw[i + 3]); d[1] = bf_hi(raw[i + 3]); }
                        if (pr < 64) {
                            const float dt = dtb[32 + tl], w = dtb[64 + tl];
                            const float c0[3] = {v0, v0 * dt, v0 * dt * w}, c1[3] = {v1, v1 * dt, v1 * dt * w};
#pragma unroll
                            for (int q = 0; q < 3; ++q) { if (i8 & 1) { pk[q][0][i8 >> 1] = cvt_pk_bf16(prev[q][0], c0[q]); pk[q][1][i8 >> 1] = cvt_pk_bf16(prev[q][1], c1[q]); } else { prev[q][0] = c0[q]; prev[q][1] = c1[q]; } }
                        } else if (pr < 128) {
                            *(LAS unsigned*)(lds + L_BM + tl * 272 + 4 * (pr - 64)) = cvt_pk_bf16(v0, v1);
                            if (i8 & 1) { pk[0][0][i8 >> 1] = cvt_pk_bf16(prev[0][0], v0); pk[0][1][i8 >> 1] = cvt_pk_bf16(prev[0][1], v1); } else { prev[0][0] = v0; prev[0][1] = v1; }
                        } else {
                            *(LAS unsigned*)(lds + L_CM + tl * 272 + 4 * (pr - 128)) = cvt_pk_bf16(v0, v1);
                        }
                    }
                    if (pr < 64) {
                        const int off[3] = {L_XT, L_XD, L_XW};
#pragma unroll
                        for (int q = 0; q < 3; ++q)
#pragma unroll
                            for (int e = 0; e < 2; ++e) *(LAS u32x4*)(lds + off[q] + (2 * pr + e) * 80 + 32 * th + 16 * hf) = (u32x4){pk[q][e][0], pk[q][e][1], pk[q][e][2], pk[q][e][3]};
                    } else if (pr < 128) {
#pragma unroll
                        for (int e = 0; e < 2; ++e) *(LAS u32x4*)(lds + L_BT + (2 * (pr - 64) + e) * 80 + 32 * th + 16 * hf) = (u32x4){pk[0][e][0], pk[0][e][1], pk[0][e][2], pk[0][e][3]};
                    }
                    __builtin_amdgcn_sched_barrier(0);
                }
            }
            __builtin_amdgcn_sched_barrier(0);
            if (c + 1 < nch) { SSD_FETCH(c + 1); SSD_DT(c + 1); }
            __syncthreads();
            __builtin_amdgcn_sched_barrier(0);
            {
                const LAS float* dcs = (const LAS float*)(lds + L_DTB) + ((c & 1) * 2 + hh) * 96;
                int fq_o = fq, zc_o = h * 64 + pq * 16 + fr; asm volatile("" : "+v"(fq_o), "+v"(zc_o));
                unsigned short zv[2][4];
#pragma unroll
                for (int tt = 0; tt < 2; ++tt)
#pragma unroll
                    for (int j = 0; j < 4; ++j) { const int tg = 32 * c + 16 * tt + 4 * fq_o + j; const int tgc = tg < L ? tg : 0; zv[tt][j] = *(zx + (size_t)(row0 + tgc) * ZXW + zc_o); }
                f32x4 g00 = {0.f, 0.f, 0.f, 0.f}, g01 = g00, g11 = g00;
#pragma unroll
                for (int sl = 0; sl < 4; ++sl) {
                    const bf16x8 b0 = *(const LAS bf16x8*)(lds + L_BM + fr * 272 + sl * 64 + fq * 16), b1 = *(const LAS bf16x8*)(lds + L_BM + (16 + fr) * 272 + sl * 64 + fq * 16);
                    const bf16x8 c0 = *(const LAS bf16x8*)(lds + L_CM + fr * 272 + sl * 64 + fq * 16), c1 = *(const LAS bf16x8*)(lds + L_CM + (16 + fr) * 272 + sl * 64 + fq * 16);
                    g00 = __builtin_amdgcn_mfma_f32_16x16x32_bf16(b0, c0, g00, 0, 0, 0);
                    g01 = __builtin_amdgcn_mfma_f32_16x16x32_bf16(b0, c1, g01, 0, 0, 0);
                    g11 = __builtin_amdgcn_mfma_f32_16x16x32_bf16(b1, c1, g11, 0, 0, 0);
                }
                __builtin_amdgcn_sched_barrier(0);
                f32x4 yo[2] = {{0.f, 0.f, 0.f, 0.f}, {0.f, 0.f, 0.f, 0.f}};
#pragma unroll
                for (int sl = 0; sl < 4; ++sl) {
                    u32x4 sb; sb.x = cvt_pk_bf16(st[2 * sl][0], st[2 * sl][1]); sb.y = cvt_pk_bf16(st[2 * sl][2], st[2 * sl][3]); sb.z = cvt_pk_bf16(st[2 * sl + 1][0], st[2 * sl + 1][1]); sb.w = cvt_pk_bf16(st[2 * sl + 1][2], st[2 * sl + 1][3]);
                    const bf16x8 sbv = __builtin_bit_cast(bf16x8, sb);
#pragma unroll
                    for (int tt = 0; tt < 2; ++tt) {
                        const LAS unsigned char* cp = lds + L_CM + (16 * tt + fr) * 272 + sl * 64 + fq * 8;
                        const u32x2 lo = *(const LAS u32x2*)cp, hi = *(const LAS u32x2*)(cp + 32);
                        const bf16x8 av = __builtin_bit_cast(bf16x8, ((u32x4){lo.x, lo.y, hi.x, hi.y}));
                        yo[tt] = __builtin_amdgcn_mfma_f32_16x16x32_bf16(av, sbv, yo[tt], 0, 0, 0);
                    }
                }
                __builtin_amdgcn_sched_barrier(0);
                const f32x4 cslo = *(const LAS f32x4*)(dcs + 4 * fq), cshi = *(const LAS f32x4*)(dcs + 16 + 4 * fq);
                const float cst0 = dcs[fr], cst1 = dcs[16 + fr];
                float m0[4], m1a[4], m1b[4];
#pragma unroll
                for (int j = 0; j < 4; ++j) {
                    const int s = 4 * fq + j;
                    m0[j] = (s <= fr) ? g00[j] * __expf(cst0 - cslo[j]) : 0.f;
                    m1a[j] = g01[j] * __expf(cst1 - cslo[j]);
                    m1b[j] = (s <= fr) ? g11[j] * __expf(cst1 - cshi[j]) : 0.f;
                }
                const LAS unsigned char* xdp = lds + L_XD + prow * 80 + fq * 8;
                const u32x2 xl = *(const LAS u32x2*)xdp, xh = *(const LAS u32x2*)(xdp + 32);
                const bf16x8 xdv = __builtin_bit_cast(bf16x8, ((u32x4){xl.x, xl.y, xh.x, xh.y}));
                const bf16x8 md0 = __builtin_bit_cast(bf16x8, ((u32x4){cvt_pk_bf16(m0[0], m0[1]), cvt_pk_bf16(m0[2], m0[3]), 0u, 0u}));
                const bf16x8 md1 = __builtin_bit_cast(bf16x8, ((u32x4){cvt_pk_bf16(m1a[0], m1a[1]), cvt_pk_bf16(m1a[2], m1a[3]), cvt_pk_bf16(m1b[0], m1b[1]), cvt_pk_bf16(m1b[2], m1b[3])}));
                f32x4 yd[2];
                yd[0] = __builtin_amdgcn_mfma_f32_16x16x32_bf16(md0, xdv, ((f32x4){0.f, 0.f, 0.f, 0.f}), 0, 0, 0);
                yd[1] = __builtin_amdgcn_mfma_f32_16x16x32_bf16(md1, xdv, ((f32x4){0.f, 0.f, 0.f, 0.f}), 0, 0, 0);
                __builtin_amdgcn_sched_barrier(0);
#pragma unroll
                for (int tt = 0; tt < 2; ++tt) {
                    const f32x4 cst = *(const LAS f32x4*)(dcs + 16 * tt + 4 * fq);
                    const u32x2 xw2 = *(const LAS u32x2*)(lds + L_XT + prow * 80 + (16 * tt + 4 * fq) * 2);
                    const float xs[4] = {bf_lo(xw2.x), bf_hi(xw2.x), bf_lo(xw2.y), bf_hi(xw2.y)};
#pragma unroll
                    for (int j = 0; j < 4; ++j) {
                        const float y = __expf(cst[j]) * yo[tt][j] + yd[tt][j] + dskip * xs[j];
                        const int tg = 32 * c + 16 * tt + 4 * fq_o + j;
                        if (tg < L) { const float z = bf1(zv[tt][j]); *(zx + (size_t)(row0 + tg) * ZXW + zc_o) = (bf16_t)(cvt_pk_bf16(y * silu_f(z), 0.f) & 0xffffu); }
                    }
                }
                __builtin_amdgcn_sched_barrier(0);
                const float dch = __expf(dcs[31]);
                const bf16x8 xwv = *(const LAS bf16x8*)(lds + L_XW + prow * 80 + fq * 16);
#pragma unroll
                for (int nt = 0; nt < 8; ++nt) {
                    const bf16x8 btv = *(const LAS bf16x8*)(lds + L_BT + (16 * nt + fr) * 80 + fq * 16);
                    st[nt] = __builtin_amdgcn_mfma_f32_16x16x32_bf16(btv, xwv, st[nt] * dch, 0, 0, 0);
                }
            }
            __syncthreads();
        }
        { float* sp = a.out + (samp ? O_SSMS : O_SSMP) + ((size_t)(b * NH + h) * 64 + pq * 16 + fr) * 128 + 4 * fq;
#pragma unroll
            for (int nt = 0; nt < 8; ++nt) *(f32x4*)(sp + 16 * nt) = st[nt]; }
#undef SSD_FETCH
#undef SSD_DT
    }
}

__device__ __forceinline__ void gatenorm_phase(const Args& a) {
    const int lane = threadIdx.x & 63, wave = threadIdx.x >> 6; const int gw = blockIdx.x * 8 + wave, NGW = gridDim.x * 8;
    bf16_t* zx = (bf16_t*)(a.ws + WS_BIG);
    for (int m = gw; m < T; m += NGW) {
        u32x4* p = (u32x4*)(zx + (size_t)m * ZXW) + lane; u32x4 v[4];
#pragma unroll
        for (int i = 0; i < 4; ++i) v[i] = p[64 * i];
#pragma unroll
        for (int i = 0; i < 4; ++i) {
            float f[8] = {bf_lo(v[i].x), bf_hi(v[i].x), bf_lo(v[i].y), bf_hi(v[i].y), bf_lo(v[i].z), bf_hi(v[i].z), bf_lo(v[i].w), bf_hi(v[i].w)};
            float s = 0.f;
#pragma unroll
            for (int e = 0; e < 8; ++e) s += f[e] * f[e];
            s = wave_sum(s); const float r = rsqrtf(s * (1.0f / 512.0f) + EPS);
            u32x4 o; o.x = cvt_pk_bf16(f[0] * r, f[1] * r); o.y = cvt_pk_bf16(f[2] * r, f[3] * r); o.z = cvt_pk_bf16(f[4] * r, f[5] * r); o.w = cvt_pk_bf16(f[6] * r, f[7] * r);
            p[64 * i] = o;
        }
    }
}

constexpr int A_KS = 0, A_VT = 39168;
__device__ __forceinline__ void attn_phase(const Args& a, LAS unsigned char* lds) {
    const int tid = threadIdx.x, lane = tid & 63, wave = __builtin_amdgcn_readfirstlane(tid >> 6), fr = lane & 15, fq = lane >> 4;
    const bf16_t* qb = (const bf16_t*)(a.ws + WS_Q); const bf16_t* kb = (const bf16_t*)(a.ws + WS_K); const bf16_t* vb = (const bf16_t*)(a.ws + WS_V);
    bf16_t* ob = (bf16_t*)(a.ws + WS_O);
    const int NPU = NBATCH * 17 * 4, NUNITS = NPU + DECB * 4;
    for (int unit = blockIdx.x; unit < NUNITS; unit += gridDim.x) {
        const bool samp = unit >= NPU; int b, nblk, g;
        if (!samp) { b = unit / 68; const int r = unit - b * 68; nblk = r >> 2; g = r & 3; } else { const int u2 = unit - NPU; b = u2 >> 2; g = u2 & 3; nblk = 0; }
        const int q0 = samp ? 16384 : 128 * nblk;
        const int seqrow = samp ? TP + b * 8 : b * LP;
        const int nrows = samp ? 8 : (LP - 128 * nblk < 128 ? LP - 128 * nblk : 128);
        __syncthreads();
        for (int idx = tid; idx < 272 * 8; idx += 512) {
            const int kl = idx >> 3, ch = idx & 7; const int kpos = q0 - 144 + kl;
            u32x4 kw = {0u, 0u, 0u, 0u}, vw = kw;
            if (!samp) { if (kpos >= 0 && kpos < LP) { const size_t r = (size_t)(seqrow + kpos) * 256 + g * 64 + 8 * ch; kw = *(const u32x4*)(kb + r); vw = *(const u32x4*)(vb + r); } }
            else if (kpos >= 16384) { if (kpos < 16384 + 8) { const size_t r = (size_t)(seqrow + kpos - 16384) * 256 + g * 64 + 8 * ch; kw = *(const u32x4*)(kb + r); vw = *(const u32x4*)(vb + r); } }
            else if (kpos >= 16256) { const int w = kpos - 16256; const size_t r = ((size_t)(b * 128 + w) * 4 + g) * 64 + 8 * ch;
                const f32x4 k0 = *(const f32x4*)(a.in[I_SK] + r), k1 = *(const f32x4*)(a.in[I_SK] + r + 4), v0 = *(const f32x4*)(a.in[I_SV] + r), v1 = *(const f32x4*)(a.in[I_SV] + r + 4);
                kw = pack8(k0, k1); vw = pack8(v0, v1);
                if (w >= 8) { const size_t d = ((size_t)(b * 128 + w - 8) * 4 + g) * 64 + 8 * ch; float* ko = a.out + O_KS + d; float* vo = a.out + O_VS + d;
                    *(f32x4*)ko = k0; *(f32x4*)(ko + 4) = k1; *(f32x4*)vo = v0; *(f32x4*)(vo + 4) = v1; } }
            *(LAS u32x4*)(lds + A_KS + kl * 144 + ch * 16) = kw;
            const unsigned vv[4] = {vw.x, vw.y, vw.z, vw.w};
#pragma unroll
            for (int e = 0; e < 4; ++e) { *(LAS unsigned short*)(lds + A_VT + (8 * ch + 2 * e) * 560 + kl * 2) = (unsigned short)(vv[e] & 0xffffu); *(LAS unsigned short*)(lds + A_VT + (8 * ch + 2 * e + 1) * 560 + kl * 2) = (unsigned short)(vv[e] >> 16); }
        }
        __syncthreads();
        const int qt = wave;
        if (16 * qt < nrows) {
            const bool qvalid = 16 * qt + fr < nrows;
            const size_t qrow = (size_t)(seqrow + (samp ? 0 : 128 * nblk) + 16 * qt + fr);
            const int qpos = q0 + 16 * qt + fr;
            for (int hq = 0; hq < 4; ++hq) {
                const int head = 4 * g + hq;
                bf16x8 qf[2];
#pragma unroll
                for (int sl = 0; sl < 2; ++sl) { u32x4 w = {0u, 0u, 0u, 0u}; if (qvalid) w = *(const u32x4*)(qb + qrow * DM + head * 64 + 32 * sl + 8 * fq); qf[sl] = __builtin_bit_cast(bf16x8, w); }
                f32x4 s[10];
#pragma unroll
                for (int kt = 0; kt < 10; ++kt) {
                    s[kt] = (f32x4){0.f, 0.f, 0.f, 0.f};
#pragma unroll
                    for (int sl = 0; sl < 2; ++sl) { const bf16x8 kf = *(const LAS bf16x8*)(lds + A_KS + (16 * qt + 16 * kt + fr) * 144 + sl * 64 + fq * 16);
                        s[kt] = __builtin_amdgcn_mfma_f32_16x16x32_bf16(kf, qf[sl], s[kt], 0, 0, 0); }
                }
                const float sink = a.in[I_SINKS][head];
                float mx = sink;
#pragma unroll
                for (int kt = 0; kt < 10; ++kt)
#pragma unroll
                    for (int j = 0; j < 4; ++j) { const int dist = 144 + fr - (16 * kt + 4 * fq + j); const int kpos = qpos - dist;
                        const bool ok = dist >= 0 && dist < 128 && kpos >= 0; s[kt][j] = ok ? s[kt][j] : -1e30f; mx = fmaxf(mx, s[kt][j]); }
                mx = fmaxf(mx, __shfl_xor(mx, 16)); mx = fmaxf(mx, __shfl_xor(mx, 32));
                float l = 0.f;
#pragma unroll
                for (int kt = 0; kt < 10; ++kt)
#pragma unroll
                    for (int j = 0; j < 4; ++j) { const float p = __expf(s[kt][j] - mx); s[kt][j] = p; l += p; }
                l += __shfl_xor(l, 16); l += __shfl_xor(l, 32);
                l += __expf(sink - mx);
                const float rl = 1.0f / l;
                f32x4 o[4] = {{0.f, 0.f, 0.f, 0.f}, {0.f, 0.f, 0.f, 0.f}, {0.f, 0.f, 0.f, 0.f}, {0.f, 0.f, 0.f, 0.f}};
#pragma unroll
                for (int ks = 0; ks < 5; ++ks) {
                    const bf16x8 pv = __builtin_bit_cast(bf16x8, ((u32x4){cvt_pk_bf16(s[2 * ks][0], s[2 * ks][1]), cvt_pk_bf16(s[2 * ks][2], s[2 * ks][3]), cvt_pk_bf16(s[2 * ks + 1][0], s[2 * ks + 1][1]), cvt_pk_bf16(s[2 * ks + 1][2], s[2 * ks + 1][3])}));
#pragma unroll
                    for (int dt = 0; dt < 4; ++dt) {
                        const LAS unsigned char* vp = lds + A_VT + (16 * dt + fr) * 560 + (16 * qt + 32 * ks + 4 * fq) * 2;
                        const u32x2 lo = *(const LAS u32x2*)vp, hi = *(const LAS u32x2*)(vp + 32);
                        const bf16x8 vf = __builtin_bit_cast(bf16x8, ((u32x4){lo.x, lo.y, hi.x, hi.y}));
                        o[dt] = __builtin_amdgcn_mfma_f32_16x16x32_bf16(vf, pv, o[dt], 0, 0, 0);
                    }
                }
                if (qvalid) {
#pragma unroll
                    for (int dt = 0; dt < 4; ++dt) { u32x2 w; w.x = cvt_pk_bf16(o[dt][0] * rl, o[dt][1] * rl); w.y = cvt_pk_bf16(o[dt][2] * rl, o[dt][3] * rl);
                        *(u32x2*)(ob + qrow * DM + head * 64 + 16 * dt + 4 * fq) = w; }
                }
            }
        }
    }
}

__device__ __forceinline__ void final_phase(const Args& a) {
    const int lane = threadIdx.x & 63, wave = threadIdx.x >> 6; const int gw = blockIdx.x * 8 + wave, NGW = gridDim.x * 8;
    const float* ss4 = (const float*)(a.ws + WS_SS) + 4 * (size_t)T;
    const f32x4* gp = (const f32x4*)a.in[I_FING] + lane;
    f32x4 gv[4];
#pragma unroll
    for (int j = 0; j < 4; ++j) gv[j] = gp[64 * j];
    for (int m = gw; m < T; m += NGW) {
        float* yrow;
        if (m < TP) { const int b = m / LP, t = m - b * LP; if (t < 16) continue; yrow = a.out + O_YP + ((size_t)(b * 2048 + t - 16)) * DM; } else yrow = a.out + O_YS + (size_t)(m - TP) * DM;
        const float r = rs_row(ss4, m);
        f32x4* p = (f32x4*)yrow + lane;
#pragma unroll
        for (int j = 0; j < 4; ++j) p[64 * j] = p[64 * j] * r * gv[j];
    }
}

constexpr int NPHASE = 13;
__global__ void __launch_bounds__(512) yoco_fwd(Args a) {
    extern __shared__ __attribute__((aligned(16))) unsigned char lds_raw[];
    LAS unsigned char* lds = (LAS unsigned char*)lds_raw;
    cg::grid_group grid = cg::this_grid();
    unsigned char* ws = a.ws;
    float* ss = (float*)(ws + WS_SS);
    bf16_t* hb = (bf16_t*)(ws + WS_HB);
    bf16_t* big = (bf16_t*)(ws + WS_BIG);
    const int lo = a.lo, hi = a.hi, G = gridDim.x;
#define IN(k) (lo <= (k) && (k) < hi)
#define SEAM(k) do { if ((k) + 1 < hi) grid.sync(); } while (0)
    if (IN(0)) { p0_prologue(a, lds); SEAM(0); }
    if (IN(1)) { pg8::Gemm g{hb, (const bf16_t*)(ws + WS_WIN), T, NIN, 1024, 1024}; pg8::StaticOrder S; S.init(T, NIN, G, blockIdx.x);
        EpiInProj E{big, (float*)(ws + WS_DT), ss}; pg8::gemm_phase(lds, g, S, E); SEAM(1); }
    if (IN(2)) { ssd_phase(a, lds); SEAM(2); }
    if (IN(3)) { gatenorm_phase(a); SEAM(3); }
    if (IN(4)) { pg8::Gemm g{big, (const bf16_t*)(ws + WS_WOUT), T, 1024, 2048, ZXW}; pg8::StaticOrder S; S.init(T, 1024, G, blockIdx.x);
        EpiResid<false> E{hb, ss + T, nullptr}; pg8::gemm_phase(lds, g, S, E); SEAM(4); }
    if (IN(5)) { pg8::Gemm g{hb, (const bf16_t*)(ws + WS_WGU0), T, 2 * DFF, 1024, 1024}; pg8::StaticOrder S; S.init(T, 2 * DFF, G, blockIdx.x);
        EpiSwiglu E{big, ss + T}; pg8::gemm_phase(lds, g, S, E); SEAM(5); }
    if (IN(6)) { pg8::Gemm g{big, (const bf16_t*)(ws + WS_WD0), T, 1024, DFF, DFF}; pg8::StaticOrder S; S.init(T, 1024, G, blockIdx.x);
        EpiResid<false> E{hb, ss + 2 * T, nullptr}; pg8::gemm_phase(lds, g, S, E); SEAM(6); }
    if (IN(7)) { pg8::Gemm g{hb, (const bf16_t*)(ws + WS_WKVQ), T, NKVQ, 1024, 1024}; pg8::StaticOrder S; S.init(T, NKVQ, G, blockIdx.x);
        EpiKVQ E{(bf16_t*)(ws + WS_K), (bf16_t*)(ws + WS_V), (bf16_t*)(ws + WS_Q), ss + 2 * T, (const float*)(ws + WS_ROPE), a.out}; pg8::gemm_phase(lds, g, S, E); SEAM(7); }
    if (IN(8)) { attn_phase(a, lds); SEAM(8); }
    if (IN(9)) { pg8::Gemm g{(const bf16_t*)(ws + WS_O), (const bf16_t*)(ws + WS_WO), T, 1024, 1024, 1024}; pg8::StaticOrder S; S.init(T, 1024, G, blockIdx.x);
        EpiResid<false> E{hb, ss + 3 * T, nullptr}; pg8::gemm_phase(lds, g, S, E); SEAM(9); }
    if (IN(10)) { pg8::Gemm g{hb, (const bf16_t*)(ws + WS_WGU1), T, 2 * DFF, 1024, 1024}; pg8::StaticOrder S; S.init(T, 2 * DFF, G, blockIdx.x);
        EpiSwiglu E{big, ss + 3 * T}; pg8::gemm_phase(lds, g, S, E); SEAM(10); }
    if (IN(11)) { pg8::Gemm g{big, (const bf16_t*)(ws + WS_WD1), T, 1024, DFF, DFF}; pg8::StaticOrder S; S.init(T, 1024, G, blockIdx.x);
        EpiResid<true> E{hb, ss + 4 * T, a.out}; pg8::gemm_phase(lds, g, S, E); SEAM(11); }
    if (IN(12)) { final_phase(a); }
#undef IN
#undef SEAM
}

extern "C" void kernel_launch(void* const* d_in, const int* in_sizes, int n_in, void* d_out, int out_size, void* d_ws, size_t ws_size, hipStream_t stream) {
    static int grid = 0;
    if (grid == 0) {
        if (n_in != 28 || ws_size < WS_END) { fprintf(stderr, "kernel_launch: unexpected n_in %d / ws %zu (need %zu)\n", n_in, ws_size, (size_t)WS_END); grid = -1; return; }
        int dev = 0, cus = 0, per_cu = 0;
        hipGetDevice(&dev); hipDeviceGetAttribute(&cus, hipDeviceAttributeMultiprocessorCount, dev);
        hipFuncSetAttribute((const void*)yoco_fwd, hipFuncAttributeMaxDynamicSharedMemorySize, LDS_BYTES);
        hipOccupancyMaxActiveBlocksPerMultiprocessor(&per_cu, (const void*)yoco_fwd, 512, LDS_BYTES);
        if (per_cu < 1) { fprintf(stderr, "kernel_launch: occupancy query says %d blocks/CU\n", per_cu); per_cu = 1; }
        (void)hipGetLastError();
        grid = cus * per_cu;
    }
    if (grid < 0) return;
    Args a{};
    for (int i = 0; i < 28; ++i) a.in[i] = (const float*)d_in[i];
    a.out = (float*)d_out; a.ws = (unsigned char*)d_ws;
#if MK_MULTI
    for (int ph = 0; ph < NPHASE; ++ph) { a.lo = ph; a.hi = ph + 1; hipLaunchKernelGGL(yoco_fwd, dim3(grid), dim3(512), LDS_BYTES, stream, a); }
#else
    a.lo = 0; a.hi = NPHASE;
    void* args[] = {&a};
    hipError_t e = hipLaunchCooperativeKernel((const void*)yoco_fwd, dim3(grid), dim3(512), args, LDS_BYTES, stream);
    if (e != hipSuccess) fprintf(stderr, "cooperative launch failed: %s (grid %d)\n", hipGetErrorString(e), grid);
#endif
}
```

```cpp
#include <hip/hip_runtime.h>
#include <hip/hip_cooperative_groups.h>
#include <cstdio>
#include <cstdint>
namespace cg = cooperative_groups;

#ifndef MK_MULTI
#define MK_MULTI 0
#endif

#define LAS __attribute__((address_space(3)))
typedef unsigned short bf16_t;
typedef short bf16x8 __attribute__((ext_vector_type(8)));
typedef float f32x4 __attribute__((ext_vector_type(4)));
typedef float f32x2 __attribute__((ext_vector_type(2)));
typedef unsigned u32x4 __attribute__((ext_vector_type(4)));
typedef unsigned u32x2 __attribute__((ext_vector_type(2)));

constexpr int DM = 1024, NBATCH = 16, LP = 2064, DECB = 128, DECS = 8;
constexpr int TP = NBATCH * LP;
constexpr int TS = DECB * DECS;
constexpr int T = TP + TS;
constexpr int DI = 2048, CONVD = 3072, NH = 32, DFF = 2816;
constexpr int ZXW = 5120;
constexpr int NIN = 5376;
constexpr int NKVQ = 1536;
constexpr float EPS = 1e-5f;

constexpr size_t O_YP = 0, O_YS = 33554432, O_SSMP = 34603008, O_CONVP = 38797312, O_KP = 38944768, O_VP = 39469056,
                 O_SSMS = 39993344, O_CONVS = 73547776, O_KS = 74727424, O_VS = 78921728;

constexpr size_t MiB = 1u << 20;
constexpr size_t WS_SS = 0;
constexpr size_t WS_ROPE = 1 * MiB;
constexpr size_t WS_DT = 2 * MiB;
constexpr size_t WS_WIN = 8 * MiB, WS_WOUT = 19 * MiB, WS_WGU0 = 23 * MiB, WS_WGU1 = 34 * MiB, WS_WD0 = 45 * MiB, WS_WD1 = 51 * MiB,
                 WS_WKVQ = 57 * MiB, WS_WO = 60 * MiB;
constexpr size_t WS_HB = 64 * MiB;
constexpr size_t WS_BIG = 132 * MiB;
constexpr size_t WS_Q = WS_BIG, WS_K = WS_BIG + 67 * MiB, WS_V = WS_BIG + 84 * MiB, WS_O = WS_BIG + 101 * MiB;
constexpr size_t WS_END = WS_BIG + (size_t)T * ZXW * 2;

constexpr int LDS_BYTES = 135168;

__device__ __forceinline__ unsigned cvt_pk_bf16(float lo, float hi) { unsigned r; asm volatile("v_cvt_pk_bf16_f32 %0, %1, %2" : "=v"(r) : "v"(lo), "v"(hi)); return r; }
__device__ __forceinline__ float bf_lo(unsigned w) { return __uint_as_float(w << 16); }
__device__ __forceinline__ float bf_hi(unsigned w) { return __uint_as_float(w & 0xffff0000u); }
__device__ __forceinline__ float bf1(unsigned short h) { return __uint_as_float(((unsigned)h) << 16); }
__device__ __forceinline__ float silu_f(float x) { return x * __builtin_amdgcn_rcpf(1.0f + __expf(-x)); }
__device__ __forceinline__ float wave_sum(float v) {
#pragma unroll
    for (int o = 1; o < 64; o <<= 1) v += __shfl_xor(v, o);
    return v;
}
__device__ __forceinline__ float rs_row(const float* ss, int row) { return rsqrtf(ss[row] * (1.0f / 1024.0f) + EPS); }

namespace pg8 {
constexpr int BM = 256, BK = 64, HALF = 128, HTB = HALF * BK * 2, STAGE_BYTES = 8 * HTB, NXCD = 8, WGM = 8;
__host__ __device__ __forceinline__ int lds_byte(int r, int c) { const int st = (r >> 4) * 2 + (c >> 5), rr = r & 15, cc = c & 31, ob = rr * 64 + cc * 2; return st * 1024 + (ob ^ (((ob >> 9) & 1) << 5)); }
__host__ __device__ __forceinline__ void stage_rc(int b, int& R, int& C) { const int st = b / 1024, sb = b % 1024, swz = sb ^ (((sb >> 9) & 1) << 5); R = (st >> 1) * 16 + swz / 64; C = (st & 1) * 32 + (swz % 64) / 2; }
__host__ __device__ __forceinline__ int perm32(int rho) { const int n = rho >> 4, i = rho & 15; return 8 * (i >> 2) + 4 * n + (i & 3); }
struct Unit { int pm, pn; };
struct Gemm { const bf16_t* A; const bf16_t* Bt; int M, N, K, lda; };
struct StaticOrder {
    int nM, nN, nwg, G, c;
    __device__ __forceinline__ void init(int M, int N, int G_, int c_) { nM = M / BM; nN = N / BM; nwg = nM * nN; G = G_; c = c_; }
    __device__ __forceinline__ bool next(int i, Unit& u) const {
        const long L = (long)i * G + c; if (L >= nwg) return false;
        int wgid = (int)L; { const int q = nwg / NXCD, r = nwg % NXCD, xcd = wgid % NXCD, off = wgid / NXCD; wgid = (xcd < r ? xcd * (q + 1) : r * (q + 1) + (xcd - r) * q) + off; }
        const int nig = WGM * nN, gid = wgid / nig, fm = gid * WGM, gsz = (nM - fm) < WGM ? (nM - fm) : WGM;
        u.pm = fm + ((wgid % nig) % gsz); u.pn = (wgid % nig) / gsz; return true;
    }
};
template <class Epi>
__device__ __forceinline__ void gemm_phase(LAS unsigned char* lds, const Gemm g, const StaticOrder& S, const Epi& E) {
    const int tid = threadIdx.x, wid = __builtin_amdgcn_readfirstlane(tid >> 6), lane = tid & 63, wr = wid >> 2, wc = wid & 3, fr = lane & 15, fq = lane >> 4;
    const int K = g.K, nt = K / BK, lda = g.lda;
    unsigned voffA[2], voffB[2];
#pragma unroll
    for (int i = 0; i < 2; ++i) { int R, C; stage_rc(tid * 16 + i * 8192, R, C); const int Rb = (R & ~31) + perm32(R & 31);
        voffA[i] = (unsigned)(R * lda + C) * 2u; voffB[i] = (unsigned)(Rb * K + C) * 2u; }
    const size_t kstep = (size_t)(BK * 2);
    const size_t hstepA = (size_t)HALF * lda * 2, tstepA = 2 * hstepA;
    const size_t hstepB = (size_t)HALF * K * 2, tstepB = 2 * hstepB;
    const unsigned ldsw = (unsigned)wid * 1024u;
    const int aoff = lds_byte(wr * 64 + fr, fq * 8), boff = lds_byte(wc * 32 + fr, fq * 8);
#define PG8_SA(b, h) (((b) * 2 + (h)) * HTB)
#define PG8_SB(b, h) ((4 + (b) * 2 + (h)) * HTB)
#define PG8_STAGE(bufoff, gbase, voff) do { _Pragma("unroll") for (int _i = 0; _i < 2; ++_i) \
        __builtin_amdgcn_global_load_lds((const unsigned*)((const char*)(gbase) + (voff)[_i]), (LAS unsigned*)(lds + (bufoff) + ldsw + _i * 8192), 16, 0, 0); } while (0)
#define PG8_LDA(dst, b, h) do { _Pragma("unroll") for (int m = 0; m < 4; ++m) _Pragma("unroll") for (int k = 0; k < 2; ++k) dst[m][k] = *(const LAS bf16x8*)(lds + PG8_SA(b, h) + aoff + m * 2048 + k * 1024); } while (0)
#define PG8_LDB(dst, b, h) do { _Pragma("unroll") for (int n = 0; n < 2; ++n) _Pragma("unroll") for (int k = 0; k < 2; ++k) dst[n][k] = *(const LAS bf16x8*)(lds + PG8_SB(b, h) + boff + n * 2048 + k * 1024); } while (0)
#define PG8_MMA(ai, bj, At, Bt) do { __builtin_amdgcn_s_setprio(1); _Pragma("unroll") for (int m = 0; m < 4; ++m) _Pragma("unroll") for (int n = 0; n < 2; ++n) _Pragma("unroll") for (int k = 0; k < 2; ++k) \
        acc[ai][bj][m][n] = __builtin_amdgcn_mfma_f32_16x16x32_bf16(Bt[n][k], At[m][k], acc[ai][bj][m][n], 0, 0, 0); __builtin_amdgcn_s_setprio(0); } while (0)
#define PG8_WAIT_V(n) asm volatile("s_waitcnt vmcnt(" #n ")" ::: "memory")
#define PG8_WAIT_L(n) asm volatile("s_waitcnt lgkmcnt(" #n ")" ::: "memory")
#define PG8_BAR __builtin_amdgcn_s_barrier()
#define PG8_SCHED __builtin_amdgcn_sched_barrier(0)
    Unit cur, nxt; int ui = 0;
    if (!S.next(0, cur)) return;
    f32x4 acc[2][2][4][2];
#pragma unroll
    for (int a = 0; a < 2; ++a)
#pragma unroll
        for (int b = 0; b < 2; ++b)
#pragma unroll
            for (int m = 0; m < 4; ++m)
#pragma unroll
                for (int n = 0; n < 2; ++n) acc[a][b][m][n] = (f32x4){0.f, 0.f, 0.f, 0.f};
    bf16x8 At[4][2], B0[2][2], B1[2][2];
    const char* cA = (const char*)g.A + (size_t)cur.pm * tstepA; const char* cB = (const char*)g.Bt + (size_t)cur.pn * tstepB;
    PG8_STAGE(PG8_SB(0, 0), cB, voffB); PG8_STAGE(PG8_SA(0, 0), cA, voffA); PG8_STAGE(PG8_SB(0, 1), cB + hstepB, voffB); PG8_STAGE(PG8_SA(0, 1), cA + hstepA, voffA);
    if (wr == 1) PG8_BAR;
    PG8_WAIT_V(4); PG8_BAR;
    PG8_STAGE(PG8_SB(1, 0), cB + kstep, voffB); PG8_STAGE(PG8_SA(1, 0), cA + kstep, voffA); PG8_STAGE(PG8_SB(1, 1), cB + hstepB + kstep, voffB);
    PG8_WAIT_V(6); PG8_BAR;
    for (;;) {
        const bool has_next = S.next(ui + 1, nxt);
        const char* nA = has_next ? (const char*)g.A + (size_t)nxt.pm * tstepA : cA; const char* nB = has_next ? (const char*)g.Bt + (size_t)nxt.pn * tstepB : cB;
        for (int t = 0; t < nt; t += 2) {
            const bool last = (t == nt - 2);
            const char* a1 = cA + (size_t)(t + 1) * kstep;
            const char* a2 = last ? nA : cA + (size_t)(t + 2) * kstep; const char* b2 = last ? nB : cB + (size_t)(t + 2) * kstep;
            const char* a3 = a2 + kstep; const char* b3 = b2 + kstep;
            PG8_LDB(B0, 0, 0); PG8_SCHED; PG8_LDA(At, 0, 0); PG8_STAGE(PG8_SA(1, 1), a1 + hstepA, voffA);
            PG8_WAIT_L(8); PG8_BAR; PG8_WAIT_L(0); PG8_MMA(0, 0, At, B0); PG8_BAR; PG8_SCHED;
            PG8_LDB(B1, 0, 1); PG8_STAGE(PG8_SB(0, 0), b2, voffB);
            PG8_BAR; PG8_WAIT_L(0); PG8_MMA(0, 1, At, B1); PG8_BAR;
            PG8_LDA(At, 0, 1); PG8_STAGE(PG8_SA(0, 0), a2, voffA);
            PG8_BAR; PG8_WAIT_L(0); PG8_MMA(1, 0, At, B0); PG8_BAR; PG8_SCHED;
            PG8_STAGE(PG8_SB(0, 1), b2 + hstepB, voffB);
            PG8_WAIT_V(6); PG8_BAR; PG8_MMA(1, 1, At, B1); PG8_BAR;
            PG8_LDB(B0, 1, 0); PG8_SCHED; PG8_LDA(At, 1, 0); PG8_STAGE(PG8_SA(0, 1), a2 + hstepA, voffA);
            PG8_WAIT_L(8); PG8_BAR; PG8_WAIT_L(0); PG8_MMA(0, 0, At, B0); PG8_BAR; PG8_SCHED;
            PG8_LDB(B1, 1, 1); PG8_STAGE(PG8_SB(1, 0), b3, voffB);
            PG8_BAR; PG8_WAIT_L(0); PG8_MMA(0, 1, At, B1); PG8_BAR;
            PG8_LDA(At, 1, 1); PG8_STAGE(PG8_SA(1, 0), a3, voffA);
            PG8_BAR; PG8_WAIT_L(0); PG8_MMA(1, 0, At, B0); PG8_BAR; PG8_SCHED;
            PG8_STAGE(PG8_SB(1, 1), b3 + hstepB, voffB);
            PG8_WAIT_V(6); PG8_BAR; PG8_MMA(1, 1, At, B1); PG8_BAR;
        }
        E(acc, cur, wr, wc, fr, fq);
        if (!has_next) break;
#pragma unroll
        for (int a = 0; a < 2; ++a)
#pragma unroll
            for (int b = 0; b < 2; ++b)
#pragma unroll
                for (int m = 0; m < 4; ++m)
#pragma unroll
                    for (int n = 0; n < 2; ++n) acc[a][b][m][n] = (f32x4){0.f, 0.f, 0.f, 0.f};
        cur = nxt; cA = nA; cB = nB; ++ui;
    }
    PG8_WAIT_V(0);
    if (wr == 0) PG8_BAR;
    PG8_BAR;
#undef PG8_SA
#undef PG8_SB
#undef PG8_STAGE
#undef PG8_LDA
#undef PG8_LDB
#undef PG8_MMA
#undef PG8_WAIT_V
#undef PG8_WAIT_L
#undef PG8_BAR
#undef PG8_SCHED
}
}
using pg8::Unit;

__device__ __forceinline__ u32x4 pack8(const f32x4 v0, const f32x4 v1) {
    u32x4 w; w.x = cvt_pk_bf16(v0[0], v0[1]); w.y = cvt_pk_bf16(v0[2], v0[3]); w.z = cvt_pk_bf16(v1[0], v1[1]); w.w = cvt_pk_bf16(v1[2], v1[3]); return w;
}
struct EpiInProj {
    bf16_t* zx; float* dtraw; const float* ss;
    __device__ __forceinline__ void operator()(const f32x4 (&acc)[2][2][4][2], const Unit& u, int wr, int wc, int fr, int fq) const {
        const int row0 = u.pm * 256 + wr * 64 + fr;
#pragma unroll
        for (int ai = 0; ai < 2; ++ai)
#pragma unroll
            for (int m = 0; m < 4; ++m) {
                const int row = row0 + ai * 128 + m * 16; const float r = rs_row(ss, row);
                if (u.pn < 20) {
#pragma unroll
                    for (int bj = 0; bj < 2; ++bj) { const int col = u.pn * 256 + bj * 128 + wc * 32 + 8 * fq;
                        *(u32x4*)(zx + (size_t)row * ZXW + col) = pack8(acc[ai][bj][m][0] * r, acc[ai][bj][m][1] * r); }
                } else if (wc == 0) {
                    float* d = dtraw + (size_t)row * 32 + 8 * fq;
                    *(f32x4*)d = acc[ai][0][m][0] * r; *(f32x4*)(d + 4) = acc[ai][0][m][1] * r;
                }
            }
    }
};
template <bool FINAL> struct EpiResid {
    bf16_t* hb; float* ssn; float* out;
    __device__ __forceinline__ void operator()(const f32x4 (&acc)[2][2][4][2], const Unit& u, int wr, int wc, int fr, int fq) const {
        const int row0 = u.pm * 256 + wr * 64 + fr;
#pragma unroll
        for (int ai = 0; ai < 2; ++ai)
#pragma unroll
            for (int m = 0; m < 4; ++m) {
                const int row = row0 + ai * 128 + m * 16; float s = 0.f;
                float* yrow = nullptr;
                if (FINAL) { if (row < TP) { const int b = row / LP, t = row - b * LP; if (t >= 16) yrow = out + O_YP + ((size_t)(b * 2048 + t - 16)) * DM; } else yrow = out + O_YS + (size_t)(row - TP) * DM; }
#pragma unroll
                for (int bj = 0; bj < 2; ++bj) { const int col = u.pn * 256 + bj * 128 + wc * 32 + 8 * fq;
                    bf16_t* p = hb + (size_t)row * DM + col; const u32x4 o = *(const u32x4*)p;
                    f32x4 v0 = acc[ai][bj][m][0], v1 = acc[ai][bj][m][1];
                    v0[0] += bf_lo(o.x); v0[1] += bf_hi(o.x); v0[2] += bf_lo(o.y); v0[3] += bf_hi(o.y);
                    v1[0] += bf_lo(o.z); v1[1] += bf_hi(o.z); v1[2] += bf_lo(o.w); v1[3] += bf_hi(o.w);
                    s += (v0[0] * v0[0] + v0[1] * v0[1]) + (v0[2] * v0[2] + v0[3] * v0[3]) + (v1[0] * v1[0] + v1[1] * v1[1]) + (v1[2] * v1[2] + v1[3] * v1[3]);
                    if (FINAL) { if (yrow) { *(f32x4*)(yrow + col) = v0; *(f32x4*)(yrow + col + 4) = v1; } }
                    else *(u32x4*)p = pack8(v0, v1); }
                s += __shfl_xor(s, 16); s += __shfl_xor(s, 32);
                if (fq == 0) atomicAdd(ssn + row, s);
            }
    }
};
struct EpiSwiglu {
    bf16_t* act; const float* ss;
    __device__ __forceinline__ void operator()(const f32x4 (&acc)[2][2][4][2], const Unit& u, int wr, int wc, int fr, int fq) const {
        const int row0 = u.pm * 256 + wr * 64 + fr, col = u.pn * 128 + wc * 32 + 8 * fq;
#pragma unroll
        for (int ai = 0; ai < 2; ++ai)
#pragma unroll
            for (int m = 0; m < 4; ++m) {
                const int row = row0 + ai * 128 + m * 16; const float r = rs_row(ss, row);
                f32x4 o[2];
#pragma unroll
                for (int n = 0; n < 2; ++n)
#pragma unroll
                    for (int j = 0; j < 4; ++j) { const float g = acc[ai][0][m][n][j] * r, uu = acc[ai][1][m][n][j] * r; o[n][j] = silu_f(g) * uu; }
                *(u32x4*)(act + (size_t)row * DFF + col) = pack8(o[0], o[1]);
            }
    }
};
struct EpiKVQ {
    bf16_t *kb, *vb, *qb; const float* ss; const float* rope; float* out;
    __device__ __forceinline__ void operator()(const f32x4 (&acc)[2][2][4][2], const Unit& u, int wr, int wc, int fr, int fq) const {
        const int row0 = u.pm * 256 + wr * 64 + fr;
        const bool do_rope = (u.pn != 1) && ((wc & 1) == 0);
#pragma unroll
        for (int ai = 0; ai < 2; ++ai)
#pragma unroll
            for (int m = 0; m < 4; ++m) {
                const int row = row0 + ai * 128 + m * 16; const float r = rs_row(ss, row);
                int b, t, pidx; long kvrow;
                if (row < TP) { b = row / LP; t = row - b * LP; pidx = t; kvrow = (t >= LP - 128) ? (long)b * 128 + (t - (LP - 128)) : -1; }
                else { const int ms = row - TP; b = ms >> 3; t = ms & 7; pidx = LP + t; kvrow = (long)b * 128 + 120 + t; }
                f32x4 cs0 = {1.f, 1.f, 1.f, 1.f}, cs1 = cs0, sn0 = {0.f, 0.f, 0.f, 0.f}, sn1 = sn0;
                if (do_rope && fq < 2) { const float* rp = rope + (size_t)pidx * 16; cs0 = *(const f32x4*)rp; cs1 = *(const f32x4*)(rp + 4); sn0 = *(const f32x4*)(rp + 8); sn1 = *(const f32x4*)(rp + 12);
                    if (fq == 0) { sn0 = -sn0; sn1 = -sn1; } }
#pragma unroll
                for (int bj = 0; bj < 2; ++bj) {
                    const int colt = bj * 128 + wc * 32 + 8 * fq;
                    f32x4 v0 = acc[ai][bj][m][0] * r, v1 = acc[ai][bj][m][1] * r;
                    if (do_rope) {
                        f32x4 p0, p1;
#pragma unroll
                        for (int j = 0; j < 4; ++j) { p0[j] = __shfl_xor(v0[j], 16); p1[j] = __shfl_xor(v1[j], 16); }
                        v0 = v0 * cs0 + p0 * sn0; v1 = v1 * cs1 + p1 * sn1;
                    }
                    const u32x4 w = pack8(v0, v1);
                    if (u.pn == 0) { *(u32x4*)(kb + (size_t)row * 256 + colt) = w;
                        if (kvrow >= 0) { float* d = out + (row < TP ? O_KP : O_KS) + (size_t)kvrow * 256 + colt; *(f32x4*)d = v0; *(f32x4*)(d + 4) = v1; } }
                    else if (u.pn == 1) { *(u32x4*)(vb + (size_t)row * 256 + colt) = w;
                        if (kvrow >= 0) { float* d = out + (row < TP ? O_VP : O_VS) + (size_t)kvrow * 256 + colt; *(f32x4*)d = v0; *(f32x4*)(d + 4) = v1; } }
                    else *(u32x4*)(qb + (size_t)row * DM + (u.pn - 2) * 256 + colt) = w;
                }
            }
    }
};

struct Args { const float* in[28]; float* out; unsigned char* ws; int lo, hi; };
enum { I_XP = 0, I_XS, I_SSSM, I_SCONV, I_SK, I_SV, I_META, I_SSMG, I_WIN, I_CONVW, I_CONVB, I_DTB, I_ALOG, I_DSKIP, I_GATEG, I_WOUT, I_KVG, I_WK, I_WV,
       I_ATTNG, I_WQ, I_SINKS, I_WOP, I_FFNG, I_WGATE, I_WUP, I_WDOWN, I_FING };

__device__ __forceinline__ void p0_item(const float* W, int ld, int col0, const float* g, float sc, bf16_t* WT, int K, int drow0, int k0, LAS float* scr, int lane) {
#pragma unroll 8
    for (int i = 0; i < 32; ++i) { const int kk = 2 * i + (lane >> 5); float v = 0.f;
        if (W) v = W[(size_t)(k0 + kk) * ld + col0 + (lane & 31)] * (g ? g[k0 + kk] : 1.0f) * sc;
        scr[kk * 33 + (lane & 31)] = v; }
    asm volatile("s_waitcnt lgkmcnt(0)" ::: "memory");
    const int c = lane & 7;
#pragma unroll
    for (int j = 0; j < 4; ++j) { const int n = (lane >> 3) + 8 * j; const LAS float* s = scr + (8 * c) * 33 + n;
        u32x4 o; o.x = cvt_pk_bf16(s[0], s[33]); o.y = cvt_pk_bf16(s[66], s[99]); o.z = cvt_pk_bf16(s[132], s[165]); o.w = cvt_pk_bf16(s[198], s[231]);
        *(u32x4*)(WT + (size_t)(drow0 + n) * K + k0 + 8 * c) = o; }
    asm volatile("s_waitcnt lgkmcnt(0)" ::: "memory");
}
__device__ __forceinline__ const float* src_row(const Args& a, int m) {
    if (m < TP) { const int b = m / LP, t = m - b * LP; return t < 16 ? a.in[I_META] + (size_t)t * DM : a.in[I_XP] + ((size_t)b * 2048 + (t - 16)) * DM; }
    return a.in[I_XS] + (size_t)(m - TP) * DM;
}
__device__ __forceinline__ void p0_prologue(const Args& a, LAS unsigned char* lds) {
    const int tid = threadIdx.x, lane = tid & 63, wave = __builtin_amdgcn_readfirstlane(tid >> 6);
    const int gw = blockIdx.x * 8 + wave, NGW = gridDim.x * 8;
    unsigned char* ws = a.ws;
    LAS float* scr = (LAS float*)(lds + wave * 8704);
    constexpr int N0 = (NIN / 32) * 16, N1 = 32 * 32, N2 = 176 * 16, N3 = N2, N4 = 32 * 44, N5 = N4, N6 = 48 * 16, N7 = 32 * 16;
    constexpr int NITEMS = N0 + N1 + N2 + N3 + N4 + N5 + N6 + N7;
    for (int it = gw; it < NITEMS; it += NGW) {
        int r = it;
        if (r < N0) { const int nb = r / 16, kb = r % 16; const bool real = nb * 32 < 5152;
            p0_item(real ? a.in[I_WIN] : nullptr, 5152, nb * 32, a.in[I_SSMG], 1.f, (bf16_t*)(ws + WS_WIN), 1024, nb * 32, kb * 64, scr, lane); continue; } r -= N0;
        if (r < N1) { const int nb = r / 32, kb = r % 32;
            p0_item(a.in[I_WOUT], 1024, nb * 32, a.in[I_GATEG], 1.f, (bf16_t*)(ws + WS_WOUT), 2048, nb * 32, kb * 64, scr, lane); continue; } r -= N1;
        if (r < N2 + N3) { const int layer = r >= N2; if (layer) r -= N2; const int nb = r / 16, kb = r % 16, tile = nb >> 3, w = nb & 7;
            const float* src = (w < 4 ? a.in[I_WGATE] : a.in[I_WUP]) + (size_t)layer * 1024 * DFF;
            p0_item(src, DFF, tile * 128 + (w & 3) * 32, a.in[I_FFNG] + layer * 1024, 1.f, (bf16_t*)(ws + (layer ? WS_WGU1 : WS_WGU0)), 1024, nb * 32, kb * 64, scr, lane); continue; } r -= N2 + N3;
        if (r < N4 + N5) { const int layer = r >= N4; if (layer) r -= N4; const int nb = r / 44, kb = r % 44;
            p0_item(a.in[I_WDOWN] + (size_t)layer * DFF * 1024, 1024, nb * 32, nullptr, 1.f, (bf16_t*)(ws + (layer ? WS_WD1 : WS_WD0)), DFF, nb * 32, kb * 64, scr, lane); continue; } r -= N4 + N5;
        if (r < N6) { const int nb = r / 16, kb = r % 16;
            if (nb < 8) p0_item(a.in[I_WK], 256, nb * 32, a.in[I_KVG], 1.f, (bf16_t*)(ws + WS_WKVQ), 1024, nb * 32, kb * 64, scr, lane);
            else if (nb < 16) p0_item(a.in[I_WV], 256, (nb - 8) * 32, a.in[I_KVG], 1.f, (bf16_t*)(ws + WS_WKVQ), 1024, nb * 32, kb * 64, scr, lane);
            else p0_item(a.in[I_WQ], 1024, (nb - 16) * 32, a.in[I_ATTNG], 0.125f, (bf16_t*)(ws + WS_WKVQ), 1024, nb * 32, kb * 64, scr, lane);
            continue; } r -= N6;
        { const int nb = r / 16, kb = r % 16; p0_item(a.in[I_WOP], 1024, nb * 32, nullptr, 1.f, (bf16_t*)(ws + WS_WO), 1024, nb * 32, kb * 64, scr, lane); }
    }
    float* ss = (float*)(ws + WS_SS);
    bf16_t* hb = (bf16_t*)(ws + WS_HB);
    for (int m = gw; m < T; m += NGW) {
        const f32x4* xr = (const f32x4*)src_row(a, m) + lane; f32x4 v[4]; float s = 0.f;
#pragma unroll
        for (int j = 0; j < 4; ++j) { v[j] = xr[64 * j]; s += (v[j][0] * v[j][0] + v[j][1] * v[j][1]) + (v[j][2] * v[j][2] + v[j][3] * v[j][3]); }
        s = wave_sum(s);
        u32x2* o = (u32x2*)(hb + (size_t)m * DM) + lane;
#pragma unroll
        for (int j = 0; j < 4; ++j) { u32x2 w; w.x = cvt_pk_bf16(v[j][0], v[j][1]); w.y = cvt_pk_bf16(v[j][2], v[j][3]); o[64 * j] = w; }
        if (lane == 0) { ss[m] = s; ss[T + m] = 0.f; ss[2 * T + m] = 0.f; ss[3 * T + m] = 0.f; ss[4 * T + m] = 0.f; }
    }
    float* rope = (float*)(ws + WS_ROPE);
    for (int e = blockIdx.x * 512 + tid; e < 2072 * 8; e += gridDim.x * 512) {
        const int pi = e >> 3, i = e & 7; const double pos = (double)(pi < LP ? pi : 16384 + pi - LP);
        const double inv = i == 0 ? 1.0 : i == 1 ? 0.19392274474868576 : i == 2 ? 0.03760603093086393 : i == 3 ? 0.007292664737217109 : i == 4 ? 0.001414213562373095
                         : i == 5 ? 0.0002742481756762073 : i == 6 ? 5.318295896944988e-05 : 1.031338537721246e-05;
        const double rev = pos * inv * 0.15915494309189535; const float fr = (float)(rev - __builtin_rint(rev));
        rope[pi * 16 + i] = __builtin_amdgcn_cosf(fr); rope[pi * 16 + 8 + i] = __builtin_amdgcn_sinf(fr);
    }
}

constexpr int L_CM = 0, L_BM = 8704, L_BT = 17408, L_XW = 27648, L_XD = 37888, L_XT = 48128, L_DTB = 58368;
__device__ __forceinline__ void ssd_phase(const Args& a, LAS unsigned char* lds) {
    const int tid = threadIdx.x, lane = tid & 63, wave = __builtin_amdgcn_readfirstlane(tid >> 6), fr = lane & 15, fq = lane >> 4;
    bf16_t* zx = (bf16_t*)(a.ws + WS_BIG);
    const float* dtraw = (const float*)(a.ws + WS_DT);
    const int NUNITS = 256 + 2048;
    for (int unit = blockIdx.x; unit < NUNITS; unit += gridDim.x) {
        const bool samp = unit >= 256; int b, g, hp;
        if (!samp) { b = unit >> 4; g = (unit >> 2) & 3; hp = unit & 3; } else { const int u2 = unit - 256; b = u2 >> 4; g = (u2 >> 2) & 3; hp = u2 & 3; }
        const int row0 = samp ? TP + b * 8 : b * LP, L = samp ? 8 : LP, nch = samp ? 1 : 65, h0 = g * 8 + hp * 2;
        const bool convthr = tid < 384; const int pr = convthr ? tid % 192 : 0, th = convthr ? tid / 192 : 0;
        int col;
        if (pr < 64) col = h0 * 64 + 2 * pr; else if (pr < 128) col = 2048 + g * 128 + 2 * (pr - 64); else col = 2560 + g * 128 + 2 * (pr - 128);
        float cw[4][2], cb[2];
#pragma unroll
        for (int k = 0; k < 4; ++k) { cw[k][0] = a.in[I_CONVW][k * CONVD + col]; cw[k][1] = a.in[I_CONVW][k * CONVD + col + 1]; }
        cb[0] = a.in[I_CONVB][col]; cb[1] = a.in[I_CONVB][col + 1];
        const bool wr_conv = (pr < 64) || (hp == 0);
        float* ncv = a.out + (samp ? O_CONVS : O_CONVP) + (size_t)b * 3 * CONVD + col;
        const int dth = wave - 6;
        const float dtbias = (wave >= 6) ? a.in[I_DTB][h0 + dth] : 0.f, negA = (wave >= 6) ? -__expf(a.in[I_ALOG][h0 + dth]) : 0.f;
        const int hh = wave >> 2, pq = wave & 3, h = h0 + hh, prow = hh * 64 + pq * 16 + fr;
        const float dskip = a.in[I_DSKIP][h];
        f32x4 st[8];
        if (samp) { const float* sp = a.in[I_SSSM] + ((size_t)(b * NH + h) * 64 + pq * 16 + fr) * 128 + 4 * fq;
#pragma unroll
            for (int nt = 0; nt < 8; ++nt) st[nt] = *(const f32x4*)(sp + 16 * nt); }
        else {
#pragma unroll
            for (int nt = 0; nt < 8; ++nt) st[nt] = (f32x4){0.f, 0.f, 0.f, 0.f}; }
        unsigned raw[19];
#define SSD_FETCH(c) do { int th_o = th, col_o = col; asm volatile("" : "+v"(th_o), "+v"(col_o)); _Pragma("unroll") for (int j = 0; j < 19; ++j) { const int tg = 32 * (c) + 16 * th_o - 3 + j; \
            const bool ok = convthr && tg >= 0 && tg < L; const int tgc = ok ? tg : 0; \
            const unsigned v = *(const unsigned*)(zx + (size_t)(row0 + tgc) * ZXW + 2048 + col_o); raw[j] = ok ? v : 0u; } \
            if (samp && (c) == 0 && convthr && th == 0) { _Pragma("unroll") for (int j = 0; j < 3; ++j) { const float* sc = a.in[I_SCONV] + ((size_t)b * 3 + j) * CONVD + col; raw[j] = cvt_pk_bf16(sc[0], sc[1]); } } } while (0)
#define SSD_DT(c) do { if (wave >= 6) { const int tg = 32 * (c) + lane; float dt = 0.f; \
            if (lane < 32 && tg < L) { const float x = dtraw[(size_t)(row0 + tg) * 32 + h0 + dth] + dtbias; dt = fmaxf(x, 0.f) + __logf(1.0f + __expf(-fabsf(x))); } \
            float cs = dt * negA; \
            _Pragma("unroll") for (int o = 1; o < 32; o <<= 1) { const float up = __shfl_up(cs, o); if ((lane & 31) >= o) cs += up; } \
            const float cl = __shfl(cs, 31); \
            if (lane < 32) { LAS float* d = (LAS float*)(lds + L_DTB) + (((c) & 1) * 2 + dth) * 96; d[lane] = cs; d[32 + lane] = dt; d[64 + lane] = __expf(cl - cs); } } } while (0)
        __syncthreads();
        SSD_FETCH(0); SSD_DT(0);
        __syncthreads();
        for (int c = 0; c < nch; ++c) {
            if (convthr) {
                const LAS float* dtb = (const LAS float*)(lds + L_DTB) + ((c & 1) * 2 + (pr >> 5)) * 96;
#pragma unroll
                for (int hf = 0; hf < 2; ++hf) {
                    unsigned pk[3][2][4];
                    float prev[3][2];
#pragma unroll
                    for (int i8 = 0; i8 < 8; ++i8) {
                        const int i = 8 * hf + i8, tl = 16 * th + i, tg = 32 * c + tl; const bool valid = tg < L;
                        float v0 = cb[0], v1 = cb[1];
#pragma unroll
                        for (int k = 0; k < 4; ++k) { v0 += cw[k][0] * bf_lo(raw[i + k]); v1 += cw[k][1] * bf_hi(raw[i + k]); }
                        v0 = valid ? silu_f(v0) : 0.f; v1 = valid ? silu_f(v1) : 0.f;
                        if (wr_conv && tg >= L - 3 && tg < L) { float* d = ncv + (size_t)(tg - (L - 3)) * CONVD; d[0] = bf_lo(raw[i + 3]); d[1] = bf_hi(raw[i + 3]); }
                        if (pr < 64) {
                            const float dt = dtb[32 + tl], w = dtb[64 + tl];
                            const float c0[3] = {v0, v0 * dt, v0 * dt * w}, c1[3] = {v1, v1 * dt, v1 * dt * w};
#pragma unroll
                            for (int q = 0; q < 3; ++q) { if (i8 & 1) { pk[q][0][i8 >> 1] = cvt_pk_bf16(prev[q][0], c0[q]); pk[q][1][i8 >> 1] = cvt_pk_bf16(prev[q][1], c1[q]); } else { prev[q][0] = c0[q]; prev[q][1] = c1[q]; } }
                        } else if (pr < 128) {
                            *(LAS unsigned*)(lds + L_BM + tl * 272 + 4 * (pr - 64)) = cvt_pk_bf16(v0, v1);
                            if (i8 & 1) { pk[0][0][i8 >> 1] = cvt_pk_bf16(prev[0][0], v0); pk[0][1][i8 >> 1] = cvt_pk_bf16(prev[0][1], v1); } else { prev[0][0] = v0; prev[0][1] = v1; }
                        } else {
                            *(LAS unsigned*)(lds + L_CM + tl * 272 + 4 * (pr - 128)) = cvt_pk_bf16(v0, v1);
                        }
                    }
                    if (pr < 64) {
                        const int off[3] = {L_XT, L_XD, L_XW};
#pragma unroll
                        for (int q = 0; q < 3; ++q)
#pragma unroll
                            for (int e = 0; e < 2; ++e) *(LAS u32x4*)(lds + off[q] + (2 * pr + e) * 80 + 32 * th + 16 * hf) = (u32x4){pk[q][e][0], pk[q][e][1], pk[q][e][2], pk[q][e][3]};
                    } else if (pr < 128) {
#pragma unroll
                        for (int e = 0; e < 2; ++e) *(LAS u32x4*)(lds + L_BT + (2 * (pr - 64) + e) * 80 + 32 * th + 16 * hf) = (u32x4){pk[0][e][0], pk[0][e][1], pk[0][e][2], pk[0][e][3]};
                    }
                    __builtin_amdgcn_sched_barrier(0);
                }
            }
            __builtin_amdgcn_sched_barrier(0);
            if (c + 1 < nch) { SSD_FETCH(c + 1); SSD_DT(c + 1); }
            __syncthreads();
            __builtin_amdgcn_sched_barrier(0);
            {
                const LAS float* dcs = (const LAS float*)(lds + L_DTB) + ((c & 1) * 2 + hh) * 96;
                int fq_o = fq, zc_o = h * 64 + pq * 16 + fr; asm volatile("" : "+v"(fq_o), "+v"(zc_o));
                unsigned short zv[2][4];
#pragma unroll
                for (int tt = 0; tt < 2; ++tt)
#pragma unroll
                    for (int j = 0; j < 4; ++j) { const int tg = 32 * c + 16 * tt + 4 * fq_o + j; const int tgc = tg < L ? tg : 0; zv[tt][j] = *(zx + (size_t)(row0 + tgc) * ZXW + zc_o); }
                f32x4 g00 = {0.f, 0.f, 0.f, 0.f}, g01 = g00, g11 = g00;
#pragma unroll
                for (int sl = 0; sl < 4; ++sl) {
                    const bf16x8 b0 = *(const LAS bf16x8*)(lds + L_BM + fr * 272 + sl * 64 + fq * 16), b1 = *(const LAS bf16x8*)(lds + L_BM + (16 + fr) * 272 + sl * 64 + fq * 16);
                    const bf16x8 c0 = *(const LAS bf16x8*)(lds + L_CM + fr * 272 + sl * 64 + fq * 16), c1 = *(const LAS bf16x8*)(lds + L_CM + (16 + fr) * 272 + sl * 64 + fq * 16);
                    g00 = __builtin_amdgcn_mfma_f32_16x16x32_bf16(b0, c0, g00, 0, 0, 0);
                    g01 = __builtin_amdgcn_mfma_f32_16x16x32_bf16(b0, c1, g01, 0, 0, 0);
                    g11 = __builtin_amdgcn_mfma_f32_16x16x32_bf16(b1, c1, g11, 0, 0, 0);
                }
                __builtin_amdgcn_sched_barrier(0);
                f32x4 yo[2] = {{0.f, 0.f, 0.f, 0.f}, {0.f, 0.f, 0.f, 0.f}};
#pragma unroll
                for (int sl = 0; sl < 4; ++sl) {
                    u32x4 sb; sb.x = cvt_pk_bf16(st[2 * sl][0], st[2 * sl][1]); sb.y = cvt_pk_bf16(st[2 * sl][2], st[2 * sl][3]); sb.z = cvt_pk_bf16(st[2 * sl + 1][0], st[2 * sl + 1][1]); sb.w = cvt_pk_bf16(st[2 * sl + 1][2], st[2 * sl + 1][3]);
                    const bf16x8 sbv = __builtin_bit_cast(bf16x8, sb);
#pragma unroll
                    for (int tt = 0; tt < 2; ++tt) {
                        const LAS unsigned char* cp = lds + L_CM + (16 * tt + fr) * 272 + sl * 64 + fq * 8;
                        const u32x2 lo = *(const LAS u32x2*)cp, hi = *(const LAS u32x2*)(cp + 32);
                        const bf16x8 av = __builtin_bit_cast(bf16x8, ((u32x4){lo.x, lo.y, hi.x, hi.y}));
                        yo[tt] = __builtin_amdgcn_mfma_f32_16x16x32_bf16(av, sbv, yo[tt], 0, 0, 0);
                    }
                }
                __builtin_amdgcn_sched_barrier(0);
                const f32x4 cslo = *(const LAS f32x4*)(dcs + 4 * fq), cshi = *(const LAS f32x4*)(dcs + 16 + 4 * fq);
                const float cst0 = dcs[fr], cst1 = dcs[16 + fr];
                float m0[4], m1a[4], m1b[4];
#pragma unroll
                for (int j = 0; j < 4; ++j) {
                    const int s = 4 * fq + j;
                    m0[j] = (s <= fr) ? g00[j] * __expf(cst0 - cslo[j]) : 0.f;
                    m1a[j] = g01[j] * __expf(cst1 - cslo[j]);
                    m1b[j] = (s <= fr) ? g11[j] * __expf(cst1 - cshi[j]) : 0.f;
                }
                const LAS unsigned char* xdp = lds + L_XD + prow * 80 + fq * 8;
                const u32x2 xl = *(const LAS u32x2*)xdp, xh = *(const LAS u32x2*)(xdp + 32);
                const bf16x8 xdv = __builtin_bit_cast(bf16x8, ((u32x4){xl.x, xl.y, xh.x, xh.y}));
                const bf16x8 md0 = __builtin_bit_cast(bf16x8, ((u32x4){cvt_pk_bf16(m0[0], m0[1]), cvt_pk_bf16(m0[2], m0[3]), 0u, 0u}));
                const bf16x8 md1 = __builtin_bit_cast(bf16x8, ((u32x4){cvt_pk_bf16(m1a[0], m1a[1]), cvt_pk_bf16(m1a[2], m1a[3]), cvt_pk_bf16(m1b[0], m1b[1]), cvt_pk_bf16(m1b[2], m1b[3])}));
                f32x4 yd[2];
                yd[0] = __builtin_amdgcn_mfma_f32_16x16x32_bf16(md0, xdv, ((f32x4){0.f, 0.f, 0.f, 0.f}), 0, 0, 0);
                yd[1] = __builtin_amdgcn_mfma_f32_16x16x32_bf16(md1, xdv, ((f32x4){0.f, 0.f, 0.f, 0.f}), 0, 0, 0);
                __builtin_amdgcn_sched_barrier(0);
#pragma unroll
                for (int tt = 0; tt < 2; ++tt) {
                    const f32x4 cst = *(const LAS f32x4*)(dcs + 16 * tt + 4 * fq);
                    const u32x2 xw2 = *(const LAS u32x2*)(lds + L_XT + prow * 80 + (16 * tt + 4 * fq) * 2);
                    const float xs[4] = {bf_lo(xw2.x), bf_hi(xw2.x), bf_lo(xw2.y), bf_hi(xw2.y)};
#pragma unroll
                    for (int j = 0; j < 4; ++j) {
                        const float y = __expf(cst[j]) * yo[tt][j] + yd[tt][j] + dskip * xs[j];
                        const int tg = 32 * c + 16 * tt + 4 * fq_o + j;
                        if (tg < L) { const float z = bf1(zv[tt][j]); *(zx + (size_t)(row0 + tg) * ZXW + zc_o) = (bf16_t)(cvt_pk_bf16(y * silu_f(z), 0.f) & 0xffffu); }
                    }
                }
                __builtin_amdgcn_sched_barrier(0);
                const float dch = __expf(dcs[31]);
                const bf16x8 xwv = *(const LAS bf16x8*)(lds + L_XW + prow * 80 + fq * 16);
#pragma unroll
                for (int nt = 0; nt < 8; ++nt) {
                    const bf16x8 btv = *(const LAS bf16x8*)(lds + L_BT + (16 * nt + fr) * 80 + fq * 16);
                    st[nt] = __builtin_amdgcn_mfma_f32_16x16x32_bf16(btv, xwv, st[nt] * dch, 0, 0, 0);
                }
            }
            __syncthreads();
        }
        { float* sp = a.out + (samp ? O_SSMS : O_SSMP) + ((size_t)(b * NH + h) * 64 + pq * 16 + fr) * 128 + 4 * fq;
#pragma unroll
            for (int nt = 0; nt < 8; ++nt) *(f32x4*)(sp + 16 * nt) = st[nt]; }
#undef SSD_FETCH
#undef SSD_DT
    }
}

__device__ __forceinline__ void gatenorm_phase(const Args& a) {
    const int lane = threadIdx.x & 63, wave = threadIdx.x >> 6; const int gw = blockIdx.x * 8 + wave, NGW = gridDim.x * 8;
    bf16_t* zx = (bf16_t*)(a.ws + WS_BIG);
    for (int m = gw; m < T; m += NGW) {
        u32x4* p = (u32x4*)(zx + (size_t)m * ZXW) + lane; u32x4 v[4];
#pragma unroll
        for (int i = 0; i < 4; ++i) v[i] = p[64 * i];
#pragma unroll
        for (int i = 0; i < 4; ++i) {
            float f[8] = {bf_lo(v[i].x), bf_hi(v[i].x), bf_lo(v[i].y), bf_hi(v[i].y), bf_lo(v[i].z), bf_hi(v[i].z), bf_lo(v[i].w), bf_hi(v[i].w)};
            float s = 0.f;
#pragma unroll
            for (int e = 0; e < 8; ++e) s += f[e] * f[e];
            s = wave_sum(s); const float r = rsqrtf(s * (1.0f / 512.0f) + EPS);
            u32x4 o; o.x = cvt_pk_bf16(f[0] * r, f[1] * r); o.y = cvt_pk_bf16(f[2] * r, f[3] * r); o.z = cvt_pk_bf16(f[4] * r, f[5] * r); o.w = cvt_pk_bf16(f[6] * r, f[7] * r);
            p[64 * i] = o;
        }
    }
}

constexpr int A_KS = 0, A_VT = 39168;
__device__ __forceinline__ void attn_phase(const Args& a, LAS unsigned char* lds) {
    const int tid = threadIdx.x, lane = tid & 63, wave = __builtin_amdgcn_readfirstlane(tid >> 6), fr = lane & 15, fq = lane >> 4;
    const bf16_t* qb = (const bf16_t*)(a.ws + WS_Q); const bf16_t* kb = (const bf16_t*)(a.ws + WS_K); const bf16_t* vb = (const bf16_t*)(a.ws + WS_V);
    bf16_t* ob = (bf16_t*)(a.ws + WS_O);
    const int NPU = NBATCH * 17 * 4, NUNITS = NPU + DECB * 4;
    for (int unit = blockIdx.x; unit < NUNITS; unit += gridDim.x) {
        const bool samp = unit >= NPU; int b, nblk, g;
        if (!samp) { b = unit / 68; const int r = unit - b * 68; nblk = r >> 2; g = r & 3; } else { const int u2 = unit - NPU; b = u2 >> 2; g = u2 & 3; nblk = 0; }
        const int q0 = samp ? 16384 : 128 * nblk;
        const int seqrow = samp ? TP + b * 8 : b * LP;
        const int nrows = samp ? 8 : (LP - 128 * nblk < 128 ? LP - 128 * nblk : 128);
        __syncthreads();
        for (int idx = tid; idx < 272 * 8; idx += 512) {
            const int kl = idx >> 3, ch = idx & 7; const int kpos = q0 - 144 + kl;
            u32x4 kw = {0u, 0u, 0u, 0u}, vw = kw;
            if (!samp) { if (kpos >= 0 && kpos < LP) { const size_t r = (size_t)(seqrow + kpos) * 256 + g * 64 + 8 * ch; kw = *(const u32x4*)(kb + r); vw = *(const u32x4*)(vb + r); } }
            else if (kpos >= 16384) { if (kpos < 16384 + 8) { const size_t r = (size_t)(seqrow + kpos - 16384) * 256 + g * 64 + 8 * ch; kw = *(const u32x4*)(kb + r); vw = *(const u32x4*)(vb + r); } }
            else if (kpos >= 16256) { const int w = kpos - 16256; const size_t r = ((size_t)(b * 128 + w) * 4 + g) * 64 + 8 * ch;
                const f32x4 k0 = *(const f32x4*)(a.in[I_SK] + r), k1 = *(const f32x4*)(a.in[I_SK] + r + 4), v0 = *(const f32x4*)(a.in[I_SV] + r), v1 = *(const f32x4*)(a.in[I_SV] + r + 4);
                kw = pack8(k0, k1); vw = pack8(v0, v1);
                if (w >= 8) { const size_t d = ((size_t)(b * 128 + w - 8) * 4 + g) * 64 + 8 * ch; float* ko = a.out + O_KS + d; float* vo = a.out + O_VS + d;
                    *(f32x4*)ko = k0; *(f32x4*)(ko + 4) = k1; *(f32x4*)vo = v0; *(f32x4*)(vo + 4) = v1; } }
            *(LAS u32x4*)(lds + A_KS + kl * 144 + ch * 16) = kw;
            const unsigned vv[4] = {vw.x, vw.y, vw.z, vw.w};
#pragma unroll
            for (int e = 0; e < 4; ++e) { *(LAS unsigned short*)(lds + A_VT + (8 * ch + 2 * e) * 560 + kl * 2) = (unsigned short)(vv[e] & 0xffffu); *(LAS unsigned short*)(lds + A_VT + (8 * ch + 2 * e + 1) * 560 + kl * 2) = (unsigned short)(vv[e] >> 16); }
        }
        __syncthreads();
        const int qt = wave;
        if (16 * qt < nrows) {
            const bool qvalid = 16 * qt + fr < nrows;
            const size_t qrow = (size_t)(seqrow + (samp ? 0 : 128 * nblk) + 16 * qt + fr);
            const int qpos = q0 + 16 * qt + fr;
            for (int hq = 0; hq < 4; ++hq) {
                const int head = 4 * g + hq;
                bf16x8 qf[2];
#pragma unroll
                for (int sl = 0; sl < 2; ++sl) { u32x4 w = {0u, 0u, 0u, 0u}; if (qvalid) w = *(const u32x4*)(qb + qrow * DM + head * 64 + 32 * sl + 8 * fq); qf[sl] = __builtin_bit_cast(bf16x8, w); }
                f32x4 s[10];
#pragma unroll
                for (int kt = 0; kt < 10; ++kt) {
                    s[kt] = (f32x4){0.f, 0.f, 0.f, 0.f};
#pragma unroll
                    for (int sl = 0; sl < 2; ++sl) { const bf16x8 kf = *(const LAS bf16x8*)(lds + A_KS + (16 * qt + 16 * kt + fr) * 144 + sl * 64 + fq * 16);
                        s[kt] = __builtin_amdgcn_mfma_f32_16x16x32_bf16(kf, qf[sl], s[kt], 0, 0, 0); }
                }
                const float sink = a.in[I_SINKS][head];
                float mx = sink;
#pragma unroll
                for (int kt = 0; kt < 10; ++kt)
#pragma unroll
                    for (int j = 0; j < 4; ++j) { const int dist = 144 + fr - (16 * kt + 4 * fq + j); const int kpos = qpos - dist;
                        const bool ok = dist >= 0 && dist < 128 && kpos >= 0; s[kt][j] = ok ? s[kt][j] : -1e30f; mx = fmaxf(mx, s[kt][j]); }
                mx = fmaxf(mx, __shfl_xor(mx, 16)); mx = fmaxf(mx, __shfl_xor(mx, 32));
                float l = 0.f;
#pragma unroll
                for (int kt = 0; kt < 10; ++kt)
#pragma unroll
                    for (int j = 0; j < 4; ++j) { const float p = __expf(s[kt][j] - mx); s[kt][j] = p; l += p; }
                l += __shfl_xor(l, 16); l += __shfl_xor(l, 32);
                l += __expf(sink - mx);
                const float rl = 1.0f / l;
                f32x4 o[4] = {{0.f, 0.f, 0.f, 0.f}, {0.f, 0.f, 0.f, 0.f}, {0.f, 0.f, 0.f, 0.f}, {0.f, 0.f, 0.f, 0.f}};
#pragma unroll
                for (int ks = 0; ks < 5; ++ks) {
                    const bf16x8 pv = __builtin_bit_cast(bf16x8, ((u32x4){cvt_pk_bf16(s[2 * ks][0], s[2 * ks][1]), cvt_pk_bf16(s[2 * ks][2], s[2 * ks][3]), cvt_pk_bf16(s[2 * ks + 1][0], s[2 * ks + 1][1]), cvt_pk_bf16(s[2 * ks + 1][2], s[2 * ks + 1][3])}));
#pragma unroll
                    for (int dt = 0; dt < 4; ++dt) {
                        const LAS unsigned char* vp = lds + A_VT + (16 * dt + fr) * 560 + (16 * qt + 32 * ks + 4 * fq) * 2;
                        const u32x2 lo = *(const LAS u32x2*)vp, hi = *(const LAS u32x2*)(vp + 32);
                        const bf16x8 vf = __builtin_bit_cast(bf16x8, ((u32x4){lo.x, lo.y, hi.x, hi.y}));
                        o[dt] = __builtin_amdgcn_mfma_f32_16x16x32_bf16(vf, pv, o[dt], 0, 0, 0);
                    }
                }
                if (qvalid) {
#pragma unroll
                    for (int dt = 0; dt < 4; ++dt) { u32x2 w; w.x = cvt_pk_bf16(o[dt][0] * rl, o[dt][1] * rl); w.y = cvt_pk_bf16(o[dt][2] * rl, o[dt][3] * rl);
                        *(u32x2*)(ob + qrow * DM + head * 64 + 16 * dt + 4 * fq) = w; }
                }
            }
        }
    }
}

__device__ __forceinline__ void final_phase(const Args& a) {
    const int lane = threadIdx.x & 63, wave = threadIdx.x >> 6; const int gw = blockIdx.x * 8 + wave, NGW = gridDim.x * 8;
    const float* ss4 = (const float*)(a.ws + WS_SS) + 4 * (size_t)T;
    const f32x4* gp = (const f32x4*)a.in[I_FING] + lane;
    f32x4 gv[4];
#pragma unroll
    for (int j = 0; j < 4; ++j) gv[j] = gp[64 * j];
    for (int m = gw; m < T; m += NGW) {
        float* yrow;
        if (m < TP) { const int b = m / LP, t = m - b * LP; if (t < 16) continue; yrow = a.out + O_YP + ((size_t)(b * 2048 + t - 16)) * DM; } else yrow = a.out + O_YS + (size_t)(m - TP) * DM;
        const float r = rs_row(ss4, m);
        f32x4* p = (f32x4*)yrow + lane;
#pragma unroll
        for (int j = 0; j < 4; ++j) p[64 * j] = p[64 * j] * r * gv[j];
    }
}

constexpr int NPHASE = 13;
__global__ void __launch_bounds__(512) yoco_fwd(Args a) {
    extern __shared__ __attribute__((aligned(16))) unsigned char lds_raw[];
    LAS unsigned char* lds = (LAS unsigned char*)lds_raw;
    cg::grid_group grid = cg::this_grid();
    unsigned char* ws = a.ws;
    float* ss = (float*)(ws + WS_SS);
    bf16_t* hb = (bf16_t*)(ws + WS_HB);
    bf16_t* big = (bf16_t*)(ws + WS_BIG);
    const int lo = a.lo, hi = a.hi, G = gridDim.x;
#define IN(k) (lo <= (k) && (k) < hi)
#define SEAM(k) do { if ((k) + 1 < hi) grid.sync(); } while (0)
    if (IN(0)) { p0_prologue(a, lds); SEAM(0); }
    if (IN(1)) { pg8::Gemm g{hb, (const bf16_t*)(ws + WS_WIN), T, NIN, 1024, 1024}; pg8::StaticOrder S; S.init(T, NIN, G, blockIdx.x);
        EpiInProj E{big, (float*)(ws + WS_DT), ss}; pg8::gemm_phase(lds, g, S, E); SEAM(1); }
    if (IN(2)) { ssd_phase(a, lds); SEAM(2); }
    if (IN(3)) { gatenorm_phase(a); SEAM(3); }
    if (IN(4)) { pg8::Gemm g{big, (const bf16_t*)(ws + WS_WOUT), T, 1024, 2048, ZXW}; pg8::StaticOrder S; S.init(T, 1024, G, blockIdx.x);
        EpiResid<false> E{hb, ss + T, nullptr}; pg8::gemm_phase(lds, g, S, E); SEAM(4); }
    if (IN(5)) { pg8::Gemm g{hb, (const bf16_t*)(ws + WS_WGU0), T, 2 * DFF, 1024, 1024}; pg8::StaticOrder S; S.init(T, 2 * DFF, G, blockIdx.x);
        EpiSwiglu E{big, ss + T}; pg8::gemm_phase(lds, g, S, E); SEAM(5); }
    if (IN(6)) { pg8::Gemm g{big, (const bf16_t*)(ws + WS_WD0), T, 1024, DFF, DFF}; pg8::StaticOrder S; S.init(T, 1024, G, blockIdx.x);
        EpiResid<false> E{hb, ss + 2 * T, nullptr}; pg8::gemm_phase(lds, g, S, E); SEAM(6); }
    if (IN(7)) { pg8::Gemm g{hb, (const bf16_t*)(ws + WS_WKVQ), T, NKVQ, 1024, 1024}; pg8::StaticOrder S; S.init(T, NKVQ, G, blockIdx.x);
        EpiKVQ E{(bf16_t*)(ws + WS_K), (bf16_t*)(ws + WS_V), (bf16_t*)(ws + WS_Q), ss + 2 * T, (const float*)(ws + WS_ROPE), a.out}; pg8::gemm_phase(lds, g, S, E); SEAM(7); }
    if (IN(8)) { attn_phase(a, lds); SEAM(8); }
    if (IN(9)) { pg8::Gemm g{(const bf16_t*)(ws + WS_O), (const bf16_t*)(ws + WS_WO), T, 1024, 1024, 1024}; pg8::StaticOrder S; S.init(T, 1024, G, blockIdx.x);
        EpiResid<false> E{hb, ss + 3 * T, nullptr}; pg8::gemm_phase(lds, g, S, E); SEAM(9); }
    if (IN(10)) { pg8::Gemm g{hb, (const bf16_t*)(ws + WS_WGU1), T, 2 * DFF, 1024, 1024}; pg8::StaticOrder S; S.init(T, 2 * DFF, G, blockIdx.x);
        EpiSwiglu E{big, ss + 3 * T}; pg8::gemm_phase(lds, g, S, E); SEAM(10); }
    if (IN(11)) { pg8::Gemm g{big, (const bf16_t*)(ws + WS_WD1), T, 1024, DFF, DFF}; pg8::StaticOrder S; S.init(T, 1024, G, blockIdx.x);
        EpiResid<true> E{hb, ss + 4 * T, a.out}; pg8::gemm_phase(lds, g, S, E); SEAM(11); }
    if (IN(12)) { final_phase(a); }
#undef IN
#undef SEAM
}

extern "C" void kernel_launch(void* const* d_in, const int* in_sizes, int n_in, void* d_out, int out_size, void* d_ws, size_t ws_size, hipStream_t stream) {
    static int grid = 0;
    if (grid == 0) {
        if (n_in != 28 || ws_size < WS_END) { fprintf(stderr, "kernel_launch: unexpected n_in %d / ws %zu (need %zu)\n", n_in, ws_size, (size_t)WS_END); grid = -1; return; }
        int dev = 0, cus = 0, per_cu = 0;
        hipGetDevice(&dev); hipDeviceGetAttribute(&cus, hipDeviceAttributeMultiprocessorCount, dev);
        hipFuncSetAttribute((const void*)yoco_fwd, hipFuncAttributeMaxDynamicSharedMemorySize, LDS_BYTES);
        hipOccupancyMaxActiveBlocksPerMultiprocessor(&per_cu, (const void*)yoco_fwd, 512, LDS_BYTES);
        if (per_cu < 1) { fprintf(stderr, "kernel_launch: occupancy query says %d blocks/CU\n", per_cu); per_cu = 1; }
        (void)hipGetLastError();
        grid = cus * per_cu;
    }
    if (grid < 0) return;
    Args a{};
    for (int i = 0; i < 28; ++i) a.in[i] = (const float*)d_in[i];
    a.out = (float*)d_out; a.ws = (unsigned char*)d_ws;
#if MK_MULTI
    for (int ph = 0; ph < NPHASE; ++ph) { a.lo = ph; a.hi = ph + 1; hipLaunchKernelGGL(yoco_fwd, dim3(grid), dim3(512), LDS_BYTES, stream, a); }
#else
    a.lo = 0; a.hi = NPHASE;
    void* args[] = {&a};
    hipError_t e = hipLaunchCooperativeKernel((const void*)yoco_fwd, dim3(grid), dim3(512), args, LDS_BYTES, stream);
    if (e != hipSuccess) fprintf(stderr, "cooperative launch failed: %s (grid %d)\n", hipGetErrorString(e), grid);
#endif
}
```

```cpp
#include <hip/hip_runtime.h>
#include <hip/hip_cooperative_groups.h>
#include <cstdio>
#include <cstdint>
namespace cg = cooperative_groups;

#ifndef MK_MULTI
#define MK_MULTI 0
#endif

#ifndef REP
#define REP 0
#endif
#define LAS __attribute__((address_space(3)))
typedef unsigned short bf16_t;
typedef short bf16x8 __attribute__((ext_vector_type(8)));
typedef float f32x4 __attribute__((ext_vector_type(4)));
typedef float f32x2 __attribute__((ext_vector_type(2)));
typedef unsigned u32x4 __attribute__((ext_vector_type(4)));
typedef unsigned u32x2 __attribute__((ext_vector_type(2)));

constexpr int DM = 1024, NBATCH = 16, LP = 2064, DECB = 128, DECS = 8;
constexpr int TP = NBATCH * LP;
constexpr int TS = DECB * DECS;
constexpr int T = TP + TS;
constexpr int DI = 2048, CONVD = 3072, NH = 32, DFF = 2816;
constexpr int ZXW = 5120;
constexpr int NIN = 5376;
constexpr int NKVQ = 1536;
constexpr float EPS = 1e-5f;

constexpr size_t O_YP = 0, O_YS = 33554432, O_SSMP = 34603008, O_CONVP = 38797312, O_KP = 38944768, O_VP = 39469056,
                 O_SSMS = 39993344, O_CONVS = 73547776, O_KS = 74727424, O_VS = 78921728;

constexpr size_t MiB = 1u << 20;
constexpr size_t WS_SS = 0;
constexpr size_t WS_ROPE = 1 * MiB;
constexpr size_t WS_DT = 2 * MiB;
constexpr size_t WS_WIN = 8 * MiB, WS_WOUT = 19 * MiB, WS_WGU0 = 23 * MiB, WS_WGU1 = 34 * MiB, WS_WD0 = 45 * MiB, WS_WD1 = 51 * MiB,
                 WS_WKVQ = 57 * MiB, WS_WO = 60 * MiB;
constexpr size_t WS_HB = 64 * MiB;
constexpr size_t WS_BIG = 132 * MiB;
constexpr size_t WS_Q = WS_BIG, WS_K = WS_BIG + 67 * MiB, WS_V = WS_BIG + 84 * MiB, WS_O = WS_BIG + 101 * MiB;
constexpr size_t WS_END = WS_BIG + (size_t)T * ZXW * 2;

constexpr int LDS_BYTES = 135168;

__device__ __forceinline__ unsigned cvt_pk_bf16(float lo, float hi) { unsigned r; asm volatile("v_cvt_pk_bf16_f32 %0, %1, %2" : "=v"(r) : "v"(lo), "v"(hi)); return r; }
__device__ __forceinline__ float bf_lo(unsigned w) { return __uint_as_float(w << 16); }
__device__ __forceinline__ float bf_hi(unsigned w) { return __uint_as_float(w & 0xffff0000u); }
__device__ __forceinline__ float bf1(unsigned short h) { return __uint_as_float(((unsigned)h) << 16); }
__device__ __forceinline__ float silu_f(float x) { return x * __builtin_amdgcn_rcpf(1.0f + __expf(-x)); }
__device__ __forceinline__ float wave_sum(float v) {
#pragma unroll
    for (int o = 1; o < 64; o <<= 1) v += __shfl_xor(v, o);
    return v;
}
__device__ __forceinline__ float rs_row(const float* ss, int row) { return rsqrtf(ss[row] * (1.0f / 1024.0f) + EPS); }

namespace pg8 {
constexpr int BM = 256, BK = 64, HALF = 128, HTB = HALF * BK * 2, STAGE_BYTES = 8 * HTB, NXCD = 8, WGM = 8;
__host__ __device__ __forceinline__ int lds_byte(int r, int c) { const int st = (r >> 4) * 2 + (c >> 5), rr = r & 15, cc = c & 31, ob = rr * 64 + cc * 2; return st * 1024 + (ob ^ (((ob >> 9) & 1) << 5)); }
__host__ __device__ __forceinline__ void stage_rc(int b, int& R, int& C) { const int st = b / 1024, sb = b % 1024, swz = sb ^ (((sb >> 9) & 1) << 5); R = (st >> 1) * 16 + swz / 64; C = (st & 1) * 32 + (swz % 64) / 2; }
__host__ __device__ __forceinline__ int perm32(int rho) { const int n = rho >> 4, i = rho & 15; return 8 * (i >> 2) + 4 * n + (i & 3); }
struct Unit { int pm, pn; };
struct Gemm { const bf16_t* A; const bf16_t* Bt; int M, N, K, lda; };
struct StaticOrder {
    int nM, nN, nwg, G, c;
    __device__ __forceinline__ void init(int M, int N, int G_, int c_) { nM = M / BM; nN = N / BM; nwg = nM * nN; G = G_; c = c_; }
    __device__ __forceinline__ bool next(int i, Unit& u) const {
        const long L = (long)i * G + c; if (L >= nwg) return false;
        int wgid = (int)L; { const int q = nwg / NXCD, r = nwg % NXCD, xcd = wgid % NXCD, off = wgid / NXCD; wgid = (xcd < r ? xcd * (q + 1) : r * (q + 1) + (xcd - r) * q) + off; }
        const int nig = WGM * nN, gid = wgid / nig, fm = gid * WGM, gsz = (nM - fm) < WGM ? (nM - fm) : WGM;
        u.pm = fm + ((wgid % nig) % gsz); u.pn = (wgid % nig) / gsz; return true;
    }
};
template <class Epi>
__device__ __forceinline__ void gemm_phase(LAS unsigned char* lds, const Gemm g, const StaticOrder& S, const Epi& E) {
    const int tid = threadIdx.x, wid = __builtin_amdgcn_readfirstlane(tid >> 6), lane = tid & 63, wr = wid >> 2, wc = wid & 3, fr = lane & 15, fq = lane >> 4;
    const int K = g.K, nt = K / BK, lda = g.lda;
    unsigned voffA[2], voffB[2];
#pragma unroll
    for (int i = 0; i < 2; ++i) { int R, C; stage_rc(tid * 16 + i * 8192, R, C); const int Rb = (R & ~31) + perm32(R & 31);
        voffA[i] = (unsigned)(R * lda + C) * 2u; voffB[i] = (unsigned)(Rb * K + C) * 2u; }
    const size_t kstep = (size_t)(BK * 2);
    const size_t hstepA = (size_t)HALF * lda * 2, tstepA = 2 * hstepA;
    const size_t hstepB = (size_t)HALF * K * 2, tstepB = 2 * hstepB;
    const unsigned ldsw = (unsigned)wid * 1024u;
    const int aoff = lds_byte(wr * 64 + fr, fq * 8), boff = lds_byte(wc * 32 + fr, fq * 8);
#define PG8_SA(b, h) (((b) * 2 + (h)) * HTB)
#define PG8_SB(b, h) ((4 + (b) * 2 + (h)) * HTB)
#define PG8_STAGE(bufoff, gbase, voff) do { _Pragma("unroll") for (int _i = 0; _i < 2; ++_i) \
        __builtin_amdgcn_global_load_lds((const unsigned*)((const char*)(gbase) + (voff)[_i]), (LAS unsigned*)(lds + (bufoff) + ldsw + _i * 8192), 16, 0, 0); } while (0)
#define PG8_LDA(dst, b, h) do { _Pragma("unroll") for (int m = 0; m < 4; ++m) _Pragma("unroll") for (int k = 0; k < 2; ++k) dst[m][k] = *(const LAS bf16x8*)(lds + PG8_SA(b, h) + aoff + m * 2048 + k * 1024); } while (0)
#define PG8_LDB(dst, b, h) do { _Pragma("unroll") for (int n = 0; n < 2; ++n) _Pragma("unroll") for (int k = 0; k < 2; ++k) dst[n][k] = *(const LAS bf16x8*)(lds + PG8_SB(b, h) + boff + n * 2048 + k * 1024); } while (0)
#define PG8_MMA(ai, bj, At, Bt) do { __builtin_amdgcn_s_setprio(1); _Pragma("unroll") for (int m = 0; m < 4; ++m) _Pragma("unroll") for (int n = 0; n < 2; ++n) _Pragma("unroll") for (int k = 0; k < 2; ++k) \
        acc[ai][bj][m][n] = __builtin_amdgcn_mfma_f32_16x16x32_bf16(Bt[n][k], At[m][k], acc[ai][bj][m][n], 0, 0, 0); __builtin_amdgcn_s_setprio(0); } while (0)
#define PG8_WAIT_V(n) asm volatile("s_waitcnt vmcnt(" #n ")" ::: "memory")
#define PG8_WAIT_L(n) asm volatile("s_waitcnt lgkmcnt(" #n ")" ::: "memory")
#define PG8_BAR __builtin_amdgcn_s_barrier()
#define PG8_SCHED __builtin_amdgcn_sched_barrier(0)
    Unit cur, nxt; int ui = 0;
    if (!S.next(0, cur)) return;
    f32x4 acc[2][2][4][2];
#pragma unroll
    for (int a = 0; a < 2; ++a)
#pragma unroll
        for (int b = 0; b < 2; ++b)
#pragma unroll
            for (int m = 0; m < 4; ++m)
#pragma unroll
                for (int n = 0; n < 2; ++n) acc[a][b][m][n] = (f32x4){0.f, 0.f, 0.f, 0.f};
    bf16x8 At[4][2], B0[2][2], B1[2][2];
    const char* cA = (const char*)g.A + (size_t)cur.pm * tstepA; const char* cB = (const char*)g.Bt + (size_t)cur.pn * tstepB;
    PG8_STAGE(PG8_SB(0, 0), cB, voffB); PG8_STAGE(PG8_SA(0, 0), cA, voffA); PG8_STAGE(PG8_SB(0, 1), cB + hstepB, voffB); PG8_STAGE(PG8_SA(0, 1), cA + hstepA, voffA);
    if (wr == 1) PG8_BAR;
    PG8_WAIT_V(4); PG8_BAR;
    PG8_STAGE(PG8_SB(1, 0), cB + kstep, voffB); PG8_STAGE(PG8_SA(1, 0), cA + kstep, voffA); PG8_STAGE(PG8_SB(1, 1), cB + hstepB + kstep, voffB);
    PG8_WAIT_V(6); PG8_BAR;
    for (;;) {
        const bool has_next = S.next(ui + 1, nxt);
        const char* nA = has_next ? (const char*)g.A + (size_t)nxt.pm * tstepA : cA; const char* nB = has_next ? (const char*)g.Bt + (size_t)nxt.pn * tstepB : cB;
        for (int t = 0; t < nt; t += 2) {
            const bool last = (t == nt - 2);
            const char* a1 = cA + (size_t)(t + 1) * kstep;
            const char* a2 = last ? nA : cA + (size_t)(t + 2) * kstep; const char* b2 = last ? nB : cB + (size_t)(t + 2) * kstep;
            const char* a3 = a2 + kstep; const char* b3 = b2 + kstep;
            PG8_LDB(B0, 0, 0); PG8_SCHED; PG8_LDA(At, 0, 0); PG8_STAGE(PG8_SA(1, 1), a1 + hstepA, voffA);
            PG8_WAIT_L(8); PG8_BAR; PG8_WAIT_L(0); PG8_MMA(0, 0, At, B0); PG8_BAR; PG8_SCHED;
            PG8_LDB(B1, 0, 1); PG8_STAGE(PG8_SB(0, 0), b2, voffB);
            PG8_BAR; PG8_WAIT_L(0); PG8_MMA(0, 1, At, B1); PG8_BAR;
            PG8_LDA(At, 0, 1); PG8_STAGE(PG8_SA(0, 0), a2, voffA);
            PG8_BAR; PG8_WAIT_L(0); PG8_MMA(1, 0, At, B0); PG8_BAR; PG8_SCHED;
            PG8_STAGE(PG8_SB(0, 1), b2 + hstepB, voffB);
            PG8_WAIT_V(6); PG8_BAR; PG8_MMA(1, 1, At, B1); PG8_BAR;
            PG8_LDB(B0, 1, 0); PG8_SCHED; PG8_LDA(At, 1, 0); PG8_STAGE(PG8_SA(0, 1), a2 + hstepA, voffA);
            PG8_WAIT_L(8); PG8_BAR; PG8_WAIT_L(0); PG8_MMA(0, 0, At, B0); PG8_BAR; PG8_SCHED;
            PG8_LDB(B1, 1, 1); PG8_STAGE(PG8_SB(1, 0), b3, voffB);
            PG8_BAR; PG8_WAIT_L(0); PG8_MMA(0, 1, At, B1); PG8_BAR;
            PG8_LDA(At, 1, 1); PG8_STAGE(PG8_SA(1, 0), a3, voffA);
            PG8_BAR; PG8_WAIT_L(0); PG8_MMA(1, 0, At, B0); PG8_BAR; PG8_SCHED;
            PG8_STAGE(PG8_SB(1, 1), b3 + hstepB, voffB);
            PG8_WAIT_V(6); PG8_BAR; PG8_MMA(1, 1, At, B1); PG8_BAR;
        }
        E(acc, cur, wr, wc, fr, fq);
        if (!has_next) break;
#pragma unroll
        for (int a = 0; a < 2; ++a)
#pragma unroll
            for (int b = 0; b < 2; ++b)
#pragma unroll
                for (int m = 0; m < 4; ++m)
#pragma unroll
                    for (int n = 0; n < 2; ++n) acc[a][b][m][n] = (f32x4){0.f, 0.f, 0.f, 0.f};
        cur = nxt; cA = nA; cB = nB; ++ui;
    }
    PG8_WAIT_V(0);
    if (wr == 0) PG8_BAR;
    PG8_BAR;
#undef PG8_SA
#undef PG8_SB
#undef PG8_STAGE
#undef PG8_LDA
#undef PG8_LDB
#undef PG8_MMA
#undef PG8_WAIT_V
#undef PG8_WAIT_L
#undef PG8_BAR
#undef PG8_SCHED
}
}
using pg8::Unit;

__device__ __forceinline__ u32x4 pack8(const f32x4 v0, const f32x4 v1) {
    u32x4 w; w.x = cvt_pk_bf16(v0[0], v0[1]); w.y = cvt_pk_bf16(v0[2], v0[3]); w.z = cvt_pk_bf16(v1[0], v1[1]); w.w = cvt_pk_bf16(v1[2], v1[3]); return w;
}
struct EpiInProj {
    bf16_t* zx; float* dtraw; const float* ss;
    __device__ __forceinline__ void operator()(const f32x4 (&acc)[2][2][4][2], const Unit& u, int wr, int wc, int fr, int fq) const {
        const int row0 = u.pm * 256 + wr * 64 + fr;
#pragma unroll
        for (int ai = 0; ai < 2; ++ai)
#pragma unroll
            for (int m = 0; m < 4; ++m) {
                const int row = row0 + ai * 128 + m * 16; const float r = rs_row(ss, row);
                if (u.pn < 20) {
#pragma unroll
                    for (int bj = 0; bj < 2; ++bj) { const int col = u.pn * 256 + bj * 128 + wc * 32 + 8 * fq;
                        *(u32x4*)(zx + (size_t)row * ZXW + col) = pack8(acc[ai][bj][m][0] * r, acc[ai][bj][m][1] * r); }
                } else if (wc == 0) {
                    float* d = dtraw + (size_t)row * 32 + 8 * fq;
                    *(f32x4*)d = acc[ai][0][m][0] * r; *(f32x4*)(d + 4) = acc[ai][0][m][1] * r;
                }
            }
    }
};
template <bool FINAL> struct EpiResid {
    bf16_t* hb; float* ssn; float* out;
    __device__ __forceinline__ void operator()(const f32x4 (&acc)[2][2][4][2], const Unit& u, int wr, int wc, int fr, int fq) const {
        const int row0 = u.pm * 256 + wr * 64 + fr;
#pragma unroll
        for (int ai = 0; ai < 2; ++ai)
#pragma unroll
            for (int m = 0; m < 4; ++m) {
                const int row = row0 + ai * 128 + m * 16; float s = 0.f;
                float* yrow = nullptr;
                if (FINAL) { if (row < TP) { const int b = row / LP, t = row - b * LP; if (t >= 16) yrow = out + O_YP + ((size_t)(b * 2048 + t - 16)) * DM; } else yrow = out + O_YS + (size_t)(row - TP) * DM; }
#pragma unroll
                for (int bj = 0; bj < 2; ++bj) { const int col = u.pn * 256 + bj * 128 + wc * 32 + 8 * fq;
                    bf16_t* p = hb + (size_t)row * DM + col; const u32x4 o = *(const u32x4*)p;
                    f32x4 v0 = acc[ai][bj][m][0], v1 = acc[ai][bj][m][1];
                    v0[0] += bf_lo(o.x); v0[1] += bf_hi(o.x); v0[2] += bf_lo(o.y); v0[3] += bf_hi(o.y);
                    v1[0] += bf_lo(o.z); v1[1] += bf_hi(o.z); v1[2] += bf_lo(o.w); v1[3] += bf_hi(o.w);
                    s += (v0[0] * v0[0] + v0[1] * v0[1]) + (v0[2] * v0[2] + v0[3] * v0[3]) + (v1[0] * v1[0] + v1[1] * v1[1]) + (v1[2] * v1[2] + v1[3] * v1[3]);
                    if (FINAL) { if (yrow) { *(f32x4*)(yrow + col) = v0; *(f32x4*)(yrow + col + 4) = v1; } }
                    else *(u32x4*)p = pack8(v0, v1); }
                s += __shfl_xor(s, 16); s += __shfl_xor(s, 32);
                if (fq == 0) atomicAdd(ssn + row, s);
            }
    }
};
struct EpiSwiglu {
    bf16_t* act; const float* ss;
    __device__ __forceinline__ void operator()(const f32x4 (&acc)[2][2][4][2], const Unit& u, int wr, int wc, int fr, int fq) const {
        const int row0 = u.pm * 256 + wr * 64 + fr, col = u.pn * 128 + wc * 32 + 8 * fq;
#pragma unroll
        for (int ai = 0; ai < 2; ++ai)
#pragma unroll
            for (int m = 0; m < 4; ++m) {
                const int row = row0 + ai * 128 + m * 16; const float r = rs_row(ss, row);
                f32x4 o[2];
#pragma unroll
                for (int n = 0; n < 2; ++n)
#pragma unroll
                    for (int j = 0; j < 4; ++j) { const float g = acc[ai][0][m][n][j] * r, uu = acc[ai][1][m][n][j] * r; o[n][j] = silu_f(g) * uu; }
                *(u32x4*)(act + (size_t)row * DFF + col) = pack8(o[0], o[1]);
            }
    }
};
struct EpiKVQ {
    bf16_t *kb, *vb, *qb; const float* ss; const float* rope; float* out;
    __device__ __forceinline__ void operator()(const f32x4 (&acc)[2][2][4][2], const Unit& u, int wr, int wc, int fr, int fq) const {
        const int row0 = u.pm * 256 + wr * 64 + fr;
        const bool do_rope = (u.pn != 1) && ((wc & 1) == 0);
#pragma unroll
        for (int ai = 0; ai < 2; ++ai)
#pragma unroll
            for (int m = 0; m < 4; ++m) {
                const int row = row0 + ai * 128 + m * 16; const float r = rs_row(ss, row);
                int b, t, pidx; long kvrow;
                if (row < TP) { b = row / LP; t = row - b * LP; pidx = t; kvrow = (t >= LP - 128) ? (long)b * 128 + (t - (LP - 128)) : -1; }
                else { const int ms = row - TP; b = ms >> 3; t = ms & 7; pidx = LP + t; kvrow = (long)b * 128 + 120 + t; }
                f32x4 cs0 = {1.f, 1.f, 1.f, 1.f}, cs1 = cs0, sn0 = {0.f, 0.f, 0.f, 0.f}, sn1 = sn0;
                if (do_rope && fq < 2) { const float* rp = rope + (size_t)pidx * 16; cs0 = *(const f32x4*)rp; cs1 = *(const f32x4*)(rp + 4); sn0 = *(const f32x4*)(rp + 8); sn1 = *(const f32x4*)(rp + 12);
                    if (fq == 0) { sn0 = -sn0; sn1 = -sn1; } }
#pragma unroll
                for (int bj = 0; bj < 2; ++bj) {
                    const int colt = bj * 128 + wc * 32 + 8 * fq;
                    f32x4 v0 = acc[ai][bj][m][0] * r, v1 = acc[ai][bj][m][1] * r;
                    if (do_rope) {
                        f32x4 p0, p1;
#pragma unroll
                        for (int j = 0; j < 4; ++j) { p0[j] = __shfl_xor(v0[j], 16); p1[j] = __shfl_xor(v1[j], 16); }
                        v0 = v0 * cs0 + p0 * sn0; v1 = v1 * cs1 + p1 * sn1;
                    }
                    const u32x4 w = pack8(v0, v1);
                    if (u.pn == 0) { *(u32x4*)(kb + (size_t)row * 256 + colt) = w;
                        if (kvrow >= 0) { float* d = out + (row < TP ? O_KP : O_KS) + (size_t)kvrow * 256 + colt; *(f32x4*)d = v0; *(f32x4*)(d + 4) = v1; } }
                    else if (u.pn == 1) { *(u32x4*)(vb + (size_t)row * 256 + colt) = w;
                        if (kvrow >= 0) { float* d = out + (row < TP ? O_VP : O_VS) + (size_t)kvrow * 256 + colt; *(f32x4*)d = v0; *(f32x4*)(d + 4) = v1; } }
                    else *(u32x4*)(qb + (size_t)row * DM + (u.pn - 2) * 256 + colt) = w;
                }
            }
    }
};

struct Args { const float* in[28]; float* out; unsigned char* ws; int lo, hi; };
enum { I_XP = 0, I_XS, I_SSSM, I_SCONV, I_SK, I_SV, I_META, I_SSMG, I_WIN, I_CONVW, I_CONVB, I_DTB, I_ALOG, I_DSKIP, I_GATEG, I_WOUT, I_KVG, I_WK, I_WV,
       I_ATTNG, I_WQ, I_SINKS, I_WOP, I_FFNG, I_WGATE, I_WUP, I_WDOWN, I_FING };

__device__ __forceinline__ void p0_item(const float* W, int ld, int col0, const float* g, float sc, bf16_t* WT, int K, int drow0, int k0, LAS float* scr, int lane) {
#pragma unroll 8
    for (int i = 0; i < 32; ++i) { const int kk = 2 * i + (lane >> 5); float v = 0.f;
        if (W) v = W[(size_t)(k0 + kk) * ld + col0 + (lane & 31)] * (g ? g[k0 + kk] : 1.0f) * sc;
        scr[kk * 33 + (lane & 31)] = v; }
    asm volatile("s_waitcnt lgkmcnt(0)" ::: "memory");
    const int c = lane & 7;
#pragma unroll
    for (int j = 0; j < 4; ++j) { const int n = (lane >> 3) + 8 * j; const LAS float* s = scr + (8 * c) * 33 + n;
        u32x4 o; o.x = cvt_pk_bf16(s[0], s[33]); o.y = cvt_pk_bf16(s[66], s[99]); o.z = cvt_pk_bf16(s[132], s[165]); o.w = cvt_pk_bf16(s[198], s[231]);
        *(u32x4*)(WT + (size_t)(drow0 + n) * K + k0 + 8 * c) = o; }
    asm volatile("s_waitcnt lgkmcnt(0)" ::: "memory");
}
__device__ __forceinline__ const float* src_row(const Args& a, int m) {
    if (m < TP) { const int b = m / LP, t = m - b * LP; return t < 16 ? a.in[I_META] + (size_t)t * DM : a.in[I_XP] + ((size_t)b * 2048 + (t - 16)) * DM; }
    return a.in[I_XS] + (size_t)(m - TP) * DM;
}
__device__ __forceinline__ void p0_prologue(const Args& a, LAS unsigned char* lds) {
    const int tid = threadIdx.x, lane = tid & 63, wave = __builtin_amdgcn_readfirstlane(tid >> 6);
    const int gw = blockIdx.x * 8 + wave, NGW = gridDim.x * 8;
    unsigned char* ws = a.ws;
    LAS float* scr = (LAS float*)(lds + wave * 8704);
    constexpr int N0 = (NIN / 32) * 16, N1 = 32 * 32, N2 = 176 * 16, N3 = N2, N4 = 32 * 44, N5 = N4, N6 = 48 * 16, N7 = 32 * 16;
    constexpr int NITEMS = N0 + N1 + N2 + N3 + N4 + N5 + N6 + N7;
    for (int it = gw; it < NITEMS; it += NGW) {
        int r = it;
        if (r < N0) { const int nb = r / 16, kb = r % 16; const bool real = nb * 32 < 5152;
            p0_item(real ? a.in[I_WIN] : nullptr, 5152, nb * 32, a.in[I_SSMG], 1.f, (bf16_t*)(ws + WS_WIN), 1024, nb * 32, kb * 64, scr, lane); continue; } r -= N0;
        if (r < N1) { const int nb = r / 32, kb = r % 32;
            p0_item(a.in[I_WOUT], 1024, nb * 32, a.in[I_GATEG], 1.f, (bf16_t*)(ws + WS_WOUT), 2048, nb * 32, kb * 64, scr, lane); continue; } r -= N1;
        if (r < N2 + N3) { const int layer = r >= N2; if (layer) r -= N2; const int nb = r / 16, kb = r % 16, tile = nb >> 3, w = nb & 7;
            const float* src = (w < 4 ? a.in[I_WGATE] : a.in[I_WUP]) + (size_t)layer * 1024 * DFF;
            p0_item(src, DFF, tile * 128 + (w & 3) * 32, a.in[I_FFNG] + layer * 1024, 1.f, (bf16_t*)(ws + (layer ? WS_WGU1 : WS_WGU0)), 1024, nb * 32, kb * 64, scr, lane); continue; } r -= N2 + N3;
        if (r < N4 + N5) { const int layer = r >= N4; if (layer) r -= N4; const int nb = r / 44, kb = r % 44;
            p0_item(a.in[I_WDOWN] + (size_t)layer * DFF * 1024, 1024, nb * 32, nullptr, 1.f, (bf16_t*)(ws + (layer ? WS_WD1 : WS_WD0)), DFF, nb * 32, kb * 64, scr, lane); continue; } r -= N4 + N5;
        if (r < N6) { const int nb = r / 16, kb = r % 16;
            if (nb < 8) p0_item(a.in[I_WK], 256, nb * 32, a.in[I_KVG], 1.f, (bf16_t*)(ws + WS_WKVQ), 1024, nb * 32, kb * 64, scr, lane);
            else if (nb < 16) p0_item(a.in[I_WV], 256, (nb - 8) * 32, a.in[I_KVG], 1.f, (bf16_t*)(ws + WS_WKVQ), 1024, nb * 32, kb * 64, scr, lane);
            else p0_item(a.in[I_WQ], 1024, (nb - 16) * 32, a.in[I_ATTNG], 0.125f, (bf16_t*)(ws + WS_WKVQ), 1024, nb * 32, kb * 64, scr, lane);
            continue; } r -= N6;
        { const int nb = r / 16, kb = r % 16; p0_item(a.in[I_WOP], 1024, nb * 32, nullptr, 1.f, (bf16_t*)(ws + WS_WO), 1024, nb * 32, kb * 64, scr, lane); }
    }
    float* ss = (float*)(ws + WS_SS);
    bf16_t* hb = (bf16_t*)(ws + WS_HB);
    for (int m = gw; m < T; m += NGW) {
        const f32x4* xr = (const f32x4*)src_row(a, m) + lane; f32x4 v[4]; float s = 0.f;
#pragma unroll
        for (int j = 0; j < 4; ++j) { v[j] = xr[64 * j]; s += (v[j][0] * v[j][0] + v[j][1] * v[j][1]) + (v[j][2] * v[j][2] + v[j][3] * v[j][3]); }
        s = wave_sum(s);
        u32x2* o = (u32x2*)(hb + (size_t)m * DM) + lane;
#pragma unroll
        for (int j = 0; j < 4; ++j) { u32x2 w; w.x = cvt_pk_bf16(v[j][0], v[j][1]); w.y = cvt_pk_bf16(v[j][2], v[j][3]); o[64 * j] = w; }
        if (lane == 0) { ss[m] = s; ss[T + m] = 0.f; ss[2 * T + m] = 0.f; ss[3 * T + m] = 0.f; ss[4 * T + m] = 0.f; }
    }
    float* rope = (float*)(ws + WS_ROPE);
    for (int e = blockIdx.x * 512 + tid; e < 2072 * 8; e += gridDim.x * 512) {
        const int pi = e >> 3, i = e & 7; const double pos = (double)(pi < LP ? pi : 16384 + pi - LP);
        const double inv = i == 0 ? 1.0 : i == 1 ? 0.19392274474868576 : i == 2 ? 0.03760603093086393 : i == 3 ? 0.007292664737217109 : i == 4 ? 0.001414213562373095
                         : i == 5 ? 0.0002742481756762073 : i == 6 ? 5.318295896944988e-05 : 1.031338537721246e-05;
        const double rev = pos * inv * 0.15915494309189535; const float fr = (float)(rev - __builtin_rint(rev));
        rope[pi * 16 + i] = __builtin_amdgcn_cosf(fr); rope[pi * 16 + 8 + i] = __builtin_amdgcn_sinf(fr);
    }
}

#define WG_BAR() do { asm volatile("s_waitcnt lgkmcnt(0)" ::: "memory"); __builtin_amdgcn_s_barrier(); asm volatile("" ::: "memory"); } while (0)
constexpr int L_CM = 0, L_BM = 8704, L_BT = 17408, L_XW = 27648, L_XD = 37888, L_XT = 48128, L_DTB = 58368;
template <bool DUMMY> __device__ __forceinline__ void ssd_phase(const Args& a, LAS unsigned char* lds) {
    const int tid = threadIdx.x, lane = tid & 63, wave = __builtin_amdgcn_readfirstlane(tid >> 6), fr = lane & 15, fq = lane >> 4;
    bf16_t* zx = (bf16_t*)(a.ws + WS_BIG);
    const float* dtraw = (const float*)(a.ws + WS_DT);
    const int NUNITS = 256 + 2048;
    for (int unit = blockIdx.x; unit < NUNITS; unit += gridDim.x) {
        const bool samp = unit >= 256; int b, g, hp;
        if (!samp) { b = unit >> 4; g = (unit >> 2) & 3; hp = unit & 3; } else { const int u2 = unit - 256; b = u2 >> 4; g = (u2 >> 2) & 3; hp = u2 & 3; }
        const int row0 = samp ? TP + b * 8 : b * LP, L = samp ? 8 : LP, nch = samp ? 1 : 65, h0 = g * 8 + hp * 2;
        const bool convthr = tid < 384; const int pr = convthr ? tid % 192 : 0, th = convthr ? tid / 192 : 0;
        int col;
        if (pr < 64) col = h0 * 64 + 2 * pr; else if (pr < 128) col = 2048 + g * 128 + 2 * (pr - 64); else col = 2560 + g * 128 + 2 * (pr - 128);
        float cw[4][2], cb[2];
#pragma unroll
        for (int k = 0; k < 4; ++k) { cw[k][0] = a.in[I_CONVW][k * CONVD + col]; cw[k][1] = a.in[I_CONVW][k * CONVD + col + 1]; }
        cb[0] = a.in[I_CONVB][col]; cb[1] = a.in[I_CONVB][col + 1];
        const bool wr_conv = (pr < 64) || (hp == 0);
        float* ncv = a.out + (samp ? O_CONVS : O_CONVP) + (size_t)b * 3 * CONVD + col;
        const int dth = wave - 6;
        const float dtbias = (wave >= 6) ? a.in[I_DTB][h0 + dth] : 0.f, negA = (wave >= 6) ? -__expf(a.in[I_ALOG][h0 + dth]) : 0.f;
        const int hh = wave >> 2, pq = wave & 3, h = h0 + hh, prow = hh * 64 + pq * 16 + fr;
        const float dskip = a.in[I_DSKIP][h];
        f32x4 st[8];
        if (samp) { const float* sp = a.in[I_SSSM] + ((size_t)(b * NH + h) * 64 + pq * 16 + fr) * 128 + 4 * fq;
#pragma unroll
            for (int nt = 0; nt < 8; ++nt) st[nt] = *(const f32x4*)(sp + 16 * nt); }
        else {
#pragma unroll
            for (int nt = 0; nt < 8; ++nt) st[nt] = (f32x4){0.f, 0.f, 0.f, 0.f}; }
        unsigned raw[19];
#define SSD_FETCH(c) do { int th_o = th, col_o = col; asm volatile("" : "+v"(th_o), "+v"(col_o)); _Pragma("unroll") for (int j = 0; j < 19; ++j) { int tg = 32 * (c) + 16 * th_o - 3 + j; \
            tg = tg < 0 ? 0 : (tg >= L ? L - 1 : tg); raw[j] = *(const unsigned*)(zx + (size_t)(row0 + tg) * ZXW + 2048 + col_o); } } while (0)
#define SSD_DT(c) do { if (wave >= 6) { const int tg = 32 * (c) + lane; float dt = 0.f; \
            if (lane < 32 && tg < L) { const float x = dtraw[(size_t)(row0 + tg) * 32 + h0 + dth] + dtbias; dt = fmaxf(x, 0.f) + __logf(1.0f + __expf(-fabsf(x))); } \
            float cs = dt * negA; \
            _Pragma("unroll") for (int o = 1; o < 32; o <<= 1) { const float up = __shfl_up(cs, o); if ((lane & 31) >= o) cs += up; } \
            const float cl = __shfl(cs, 31); \
            if (lane < 32) { LAS float* d = (LAS float*)(lds + L_DTB) + (((c) & 1) * 2 + dth) * 96; d[lane] = cs; d[32 + lane] = dt; d[64 + lane] = __expf(cl - cs); } } } while (0)
        __syncthreads();
        SSD_FETCH(0); SSD_DT(0);
        __syncthreads();
        for (int c = 0; c < nch; ++c) {
            if (convthr) {
                if (c == 0 && th == 0) {
#pragma unroll
                    for (int j = 0; j < 3; ++j) { unsigned v = 0u; if (samp) { const float* sc = a.in[I_SCONV] + ((size_t)b * 3 + j) * CONVD + col; v = cvt_pk_bf16(sc[0], sc[1]); } raw[j] = v; }
                }
                const LAS float* dtb = (const LAS float*)(lds + L_DTB) + ((c & 1) * 2 + (pr >> 5)) * 96;
#pragma unroll
                for (int hf = 0; hf < 2; ++hf) {
                    unsigned pk[3][2][4];
                    float prev[3][2];
#pragma unroll
                    for (int i8 = 0; i8 < 8; ++i8) {
                        const int i = 8 * hf + i8, tl = 16 * th + i, tg = 32 * c + tl; const bool valid = tg < L;
                        float v0 = cb[0], v1 = cb[1];
#pragma unroll
                        for (int k = 0; k < 4; ++k) { v0 += cw[k][0] * bf_lo(raw[i + k]); v1 += cw[k][1] * bf_hi(raw[i + k]); }
                        v0 = valid ? silu_f(v0) : 0.f; v1 = valid ? silu_f(v1) : 0.f;
                        if (wr_conv && tg >= L - 3 && tg < L) { float* d = ncv + (size_t)(tg - (L - 3)) * CONVD; d[0] = bf_lo(raw[i + 3]); d[1] = bf_hi(raw[i + 3]); }
                        if (pr < 64) {
                            const float dt = dtb[32 + tl], w = dtb[64 + tl];
                            const float c0[3] = {v0, v0 * dt, v0 * dt * w}, c1[3] = {v1, v1 * dt, v1 * dt * w};
#pragma unroll
                            for (int q = 0; q < 3; ++q) { if (i8 & 1) { pk[q][0][i8 >> 1] = cvt_pk_bf16(prev[q][0], c0[q]); pk[q][1][i8 >> 1] = cvt_pk_bf16(prev[q][1], c1[q]); } else { prev[q][0] = c0[q]; prev[q][1] = c1[q]; } }
                        } else if (pr < 128) {
                            *(LAS unsigned*)(lds + L_BM + tl * 272 + 4 * (pr - 64)) = cvt_pk_bf16(v0, v1);
                            if (i8 & 1) { pk[0][0][i8 >> 1] = cvt_pk_bf16(prev[0][0], v0); pk[0][1][i8 >> 1] = cvt_pk_bf16(prev[0][1], v1); } else { prev[0][0] = v0; prev[0][1] = v1; }
                        } else {
                            *(LAS unsigned*)(lds + L_CM + tl * 272 + 4 * (pr - 128)) = cvt_pk_bf16(v0, v1);
                        }
                    }
                    if (pr < 64) {
                        const int off[3] = {L_XT, L_XD, L_XW};
#pragma unroll
                        for (int q = 0; q < 3; ++q)
#pragma unroll
                            for (int e = 0; e < 2; ++e) *(LAS u32x4*)(lds + off[q] + (2 * pr + e) * 80 + 32 * th + 16 * hf) = (u32x4){pk[q][e][0], pk[q][e][1], pk[q][e][2], pk[q][e][3]};
                    } else if (pr < 128) {
#pragma unroll
                        for (int e = 0; e < 2; ++e) *(LAS u32x4*)(lds + L_BT + (2 * (pr - 64) + e) * 80 + 32 * th + 16 * hf) = (u32x4){pk[0][e][0], pk[0][e][1], pk[0][e][2], pk[0][e][3]};
                    }
                    __builtin_amdgcn_sched_barrier(0);
                }
            }
            __builtin_amdgcn_sched_barrier(0);
            if (c + 1 < nch) { SSD_FETCH(c + 1); SSD_DT(c + 1); }
            WG_BAR();
            __builtin_amdgcn_sched_barrier(0);
            {
                const LAS float* dcs = (const LAS float*)(lds + L_DTB) + ((c & 1) * 2 + hh) * 96;
                int fq_o = fq, zc_o = h * 64 + pq * 16 + fr; asm volatile("" : "+v"(fq_o), "+v"(zc_o));
                unsigned short zv[2][4];
#pragma unroll
                for (int tt = 0; tt < 2; ++tt)
#pragma unroll
                    for (int j = 0; j < 4; ++j) { const int tg = 32 * c + 16 * tt + 4 * fq_o + j; const int tgc = tg < L ? tg : 0; zv[tt][j] = *(zx + (size_t)(row0 + tgc) * ZXW + zc_o); }
                f32x4 g00 = {0.f, 0.f, 0.f, 0.f}, g01 = g00, g11 = g00;
#pragma unroll
                for (int sl = 0; sl < 4; ++sl) {
                    const bf16x8 b0 = *(const LAS bf16x8*)(lds + L_BM + fr * 272 + sl * 64 + fq * 16), b1 = *(const LAS bf16x8*)(lds + L_BM + (16 + fr) * 272 + sl * 64 + fq * 16);
                    const bf16x8 c0 = *(const LAS bf16x8*)(lds + L_CM + fr * 272 + sl * 64 + fq * 16), c1 = *(const LAS bf16x8*)(lds + L_CM + (16 + fr) * 272 + sl * 64 + fq * 16);
                    g00 = __builtin_amdgcn_mfma_f32_16x16x32_bf16(b0, c0, g00, 0, 0, 0);
                    g01 = __builtin_amdgcn_mfma_f32_16x16x32_bf16(b0, c1, g01, 0, 0, 0);
                    g11 = __builtin_amdgcn_mfma_f32_16x16x32_bf16(b1, c1, g11, 0, 0, 0);
                }
                __builtin_amdgcn_sched_barrier(0);
                f32x4 yo[2] = {{0.f, 0.f, 0.f, 0.f}, {0.f, 0.f, 0.f, 0.f}};
#pragma unroll
                for (int sl = 0; sl < 4; ++sl) {
                    u32x4 sb; sb.x = cvt_pk_bf16(st[2 * sl][0], st[2 * sl][1]); sb.y = cvt_pk_bf16(st[2 * sl][2], st[2 * sl][3]); sb.z = cvt_pk_bf16(st[2 * sl + 1][0], st[2 * sl + 1][1]); sb.w = cvt_pk_bf16(st[2 * sl + 1][2], st[2 * sl + 1][3]);
                    const bf16x8 sbv = __builtin_bit_cast(bf16x8, sb);
#pragma unroll
                    for (int tt = 0; tt < 2; ++tt) {
                        const LAS unsigned char* cp = lds + L_CM + (16 * tt + fr) * 272 + sl * 64 + fq * 8;
                        const u32x2 lo = *(const LAS u32x2*)cp, hi = *(const LAS u32x2*)(cp + 32);
                        const bf16x8 av = __builtin_bit_cast(bf16x8, ((u32x4){lo.x, lo.y, hi.x, hi.y}));
                        yo[tt] = __builtin_amdgcn_mfma_f32_16x16x32_bf16(av, sbv, yo[tt], 0, 0, 0);
                    }
                }
                __builtin_amdgcn_sched_barrier(0);
                const f32x4 cslo = *(const LAS f32x4*)(dcs + 4 * fq), cshi = *(const LAS f32x4*)(dcs + 16 + 4 * fq);
                const float cst0 = dcs[fr], cst1 = dcs[16 + fr];
                float m0[4], m1a[4], m1b[4];
#pragma unroll
                for (int j = 0; j < 4; ++j) {
                    const int s = 4 * fq + j;
                    m0[j] = (s <= fr) ? g00[j] * __expf(cst0 - cslo[j]) : 0.f;
                    m1a[j] = g01[j] * __expf(cst1 - cslo[j]);
                    m1b[j] = (s <= fr) ? g11[j] * __expf(cst1 - cshi[j]) : 0.f;
                }
                const LAS unsigned char* xdp = lds + L_XD + prow * 80 + fq * 8;
                const u32x2 xl = *(const LAS u32x2*)xdp, xh = *(const LAS u32x2*)(xdp + 32);
                const bf16x8 xdv = __builtin_bit_cast(bf16x8, ((u32x4){xl.x, xl.y, xh.x, xh.y}));
                const bf16x8 md0 = __builtin_bit_cast(bf16x8, ((u32x4){cvt_pk_bf16(m0[0], m0[1]), cvt_pk_bf16(m0[2], m0[3]), 0u, 0u}));
                const bf16x8 md1 = __builtin_bit_cast(bf16x8, ((u32x4){cvt_pk_bf16(m1a[0], m1a[1]), cvt_pk_bf16(m1a[2], m1a[3]), cvt_pk_bf16(m1b[0], m1b[1]), cvt_pk_bf16(m1b[2], m1b[3])}));
                f32x4 yd[2];
                yd[0] = __builtin_amdgcn_mfma_f32_16x16x32_bf16(md0, xdv, ((f32x4){0.f, 0.f, 0.f, 0.f}), 0, 0, 0);
                yd[1] = __builtin_amdgcn_mfma_f32_16x16x32_bf16(md1, xdv, ((f32x4){0.f, 0.f, 0.f, 0.f}), 0, 0, 0);
                __builtin_amdgcn_sched_barrier(0);
#pragma unroll
                for (int tt = 0; tt < 2; ++tt) {
                    const f32x4 cst = *(const LAS f32x4*)(dcs + 16 * tt + 4 * fq);
                    const u32x2 xw2 = *(const LAS u32x2*)(lds + L_XT + prow * 80 + (16 * tt + 4 * fq) * 2);
                    const float xs[4] = {bf_lo(xw2.x), bf_hi(xw2.x), bf_lo(xw2.y), bf_hi(xw2.y)};
#pragma unroll
                    for (int j = 0; j < 4; ++j) {
                        const float y = __expf(cst[j]) * yo[tt][j] + yd[tt][j] + dskip * xs[j];
                        const int tg = 32 * c + 16 * tt + 4 * fq_o + j;
                        if (tg < L) { const float z = bf1(zv[tt][j]); bf16_t* up = zx + (size_t)(row0 + tg) * ZXW + zc_o;
                            if (DUMMY) up = (bf16_t*)(a.ws + WS_END) + ((((size_t)(row0 + tg)) * 2048 + zc_o) & ((size_t)(16u << 20) - 1));
                            *up = (bf16_t)(cvt_pk_bf16(y * silu_f(z), 0.f) & 0xffffu); }
                    }
                }
                __builtin_amdgcn_sched_barrier(0);
                const float dch = __expf(dcs[31]);
                const bf16x8 xwv = *(const LAS bf16x8*)(lds + L_XW + prow * 80 + fq * 16);
#pragma unroll
                for (int nt = 0; nt < 8; ++nt) {
                    const bf16x8 btv = *(const LAS bf16x8*)(lds + L_BT + (16 * nt + fr) * 80 + fq * 16);
                    st[nt] = __builtin_amdgcn_mfma_f32_16x16x32_bf16(btv, xwv, st[nt] * dch, 0, 0, 0);
                }
            }
            WG_BAR();
        }
        { float* sp = a.out + (samp ? O_SSMS : O_SSMP) + ((size_t)(b * NH + h) * 64 + pq * 16 + fr) * 128 + 4 * fq;
#pragma unroll
            for (int nt = 0; nt < 8; ++nt) *(f32x4*)(sp + 16 * nt) = st[nt]; }
#undef SSD_FETCH
#undef SSD_DT
    }
}

__device__ __forceinline__ void gatenorm_phase(const Args& a) {
    const int lane = threadIdx.x & 63, wave = threadIdx.x >> 6; const int gw = blockIdx.x * 8 + wave, NGW = gridDim.x * 8;
    bf16_t* zx = (bf16_t*)(a.ws + WS_BIG);
    for (int m = gw; m < T; m += NGW) {
        u32x4* p = (u32x4*)(zx + (size_t)m * ZXW) + lane; u32x4 v[4];
#pragma unroll
        for (int i = 0; i < 4; ++i) v[i] = p[64 * i];
#pragma unroll
        for (int i = 0; i < 4; ++i) {
            float f[8] = {bf_lo(v[i].x), bf_hi(v[i].x), bf_lo(v[i].y), bf_hi(v[i].y), bf_lo(v[i].z), bf_hi(v[i].z), bf_lo(v[i].w), bf_hi(v[i].w)};
            float s = 0.f;
#pragma unroll
            for (int e = 0; e < 8; ++e) s += f[e] * f[e];
            s = wave_sum(s); const float r = rsqrtf(s * (1.0f / 512.0f) + EPS);
            u32x4 o; o.x = cvt_pk_bf16(f[0] * r, f[1] * r); o.y = cvt_pk_bf16(f[2] * r, f[3] * r); o.z = cvt_pk_bf16(f[4] * r, f[5] * r); o.w = cvt_pk_bf16(f[6] * r, f[7] * r);
            p[64 * i] = o;
        }
    }
}

constexpr int A_KS = 0, A_VT = 39168;
__device__ __forceinline__ void attn_phase(const Args& a, LAS unsigned char* lds) {
    const int tid = threadIdx.x, lane = tid & 63, wave = __builtin_amdgcn_readfirstlane(tid >> 6), fr = lane & 15, fq = lane >> 4;
    const bf16_t* qb = (const bf16_t*)(a.ws + WS_Q); const bf16_t* kb = (const bf16_t*)(a.ws + WS_K); const bf16_t* vb = (const bf16_t*)(a.ws + WS_V);
    bf16_t* ob = (bf16_t*)(a.ws + WS_O);
    const int NPU = NBATCH * 17 * 4, NUNITS = NPU + DECB * 4;
    for (int unit = blockIdx.x; unit < NUNITS; unit += gridDim.x) {
        const bool samp = unit >= NPU; int b, nblk, g;
        if (!samp) { b = unit / 68; const int r = unit - b * 68; nblk = r >> 2; g = r & 3; } else { const int u2 = unit - NPU; b = u2 >> 2; g = u2 & 3; nblk = 0; }
        const int q0 = samp ? 16384 : 128 * nblk;
        const int seqrow = samp ? TP + b * 8 : b * LP;
        const int nrows = samp ? 8 : (LP - 128 * nblk < 128 ? LP - 128 * nblk : 128);
        __syncthreads();
        for (int idx = tid; idx < 272 * 8; idx += 512) {
            const int kl = idx >> 3, ch = idx & 7; const int kpos = q0 - 144 + kl;
            u32x4 kw = {0u, 0u, 0u, 0u}, vw = kw;
            if (!samp) { if (kpos >= 0 && kpos < LP) { const size_t r = (size_t)(seqrow + kpos) * 256 + g * 64 + 8 * ch; kw = *(const u32x4*)(kb + r); vw = *(const u32x4*)(vb + r); } }
            else if (kpos >= 16384) { if (kpos < 16384 + 8) { const size_t r = (size_t)(seqrow + kpos - 16384) * 256 + g * 64 + 8 * ch; kw = *(const u32x4*)(kb + r); vw = *(const u32x4*)(vb + r); } }
            else if (kpos >= 16256) { const int w = kpos - 16256; const size_t r = ((size_t)(b * 128 + w) * 4 + g) * 64 + 8 * ch;
                const f32x4 k0 = *(const f32x4*)(a.in[I_SK] + r), k1 = *(const f32x4*)(a.in[I_SK] + r + 4), v0 = *(const f32x4*)(a.in[I_SV] + r), v1 = *(const f32x4*)(a.in[I_SV] + r + 4);
                kw = pack8(k0, k1); vw = pack8(v0, v1);
                if (w >= 8) { const size_t d = ((size_t)(b * 128 + w - 8) * 4 + g) * 64 + 8 * ch; float* ko = a.out + O_KS + d; float* vo = a.out + O_VS + d;
                    *(f32x4*)ko = k0; *(f32x4*)(ko + 4) = k1; *(f32x4*)vo = v0; *(f32x4*)(vo + 4) = v1; } }
            *(LAS u32x4*)(lds + A_KS + kl * 144 + ch * 16) = kw;
            const unsigned vv[4] = {vw.x, vw.y, vw.z, vw.w};
#pragma unroll
            for (int e = 0; e < 4; ++e) { *(LAS unsigned short*)(lds + A_VT + (8 * ch + 2 * e) * 560 + kl * 2) = (unsigned short)(vv[e] & 0xffffu); *(LAS unsigned short*)(lds + A_VT + (8 * ch + 2 * e + 1) * 560 + kl * 2) = (unsigned short)(vv[e] >> 16); }
        }
        __syncthreads();
        const int qt = wave;
        if (16 * qt < nrows) {
            const bool qvalid = 16 * qt + fr < nrows;
            const size_t qrow = (size_t)(seqrow + (samp ? 0 : 128 * nblk) + 16 * qt + fr);
            const int qpos = q0 + 16 * qt + fr;
            for (int hq = 0; hq < 4; ++hq) {
                const int head = 4 * g + hq;
                bf16x8 qf[2];
#pragma unroll
                for (int sl = 0; sl < 2; ++sl) { u32x4 w = {0u, 0u, 0u, 0u}; if (qvalid) w = *(const u32x4*)(qb + qrow * DM + head * 64 + 32 * sl + 8 * fq); qf[sl] = __builtin_bit_cast(bf16x8, w); }
                f32x4 s[10];
#pragma unroll
                for (int kt = 0; kt < 10; ++kt) {
                    s[kt] = (f32x4){0.f, 0.f, 0.f, 0.f};
#pragma unroll
                    for (int sl = 0; sl < 2; ++sl) { const bf16x8 kf = *(const LAS bf16x8*)(lds + A_KS + (16 * qt + 16 * kt + fr) * 144 + sl * 64 + fq * 16);
                        s[kt] = __builtin_amdgcn_mfma_f32_16x16x32_bf16(kf, qf[sl], s[kt], 0, 0, 0); }
                }
                const float sink = a.in[I_SINKS][head];
                float mx = sink;
#pragma unroll
                for (int kt = 0; kt < 10; ++kt)
#pragma unroll
                    for (int j = 0; j < 4; ++j) { const int dist = 144 + fr - (16 * kt + 4 * fq + j); const int kpos = qpos - dist;
                        const bool ok = dist >= 0 && dist < 128 && kpos >= 0; s[kt][j] = ok ? s[kt][j] : -1e30f; mx = fmaxf(mx, s[kt][j]); }
                mx = fmaxf(mx, __shfl_xor(mx, 16)); mx = fmaxf(mx, __shfl_xor(mx, 32));
                float l = 0.f;
#pragma unroll
                for (int kt = 0; kt < 10; ++kt)
#pragma unroll
                    for (int j = 0; j < 4; ++j) { const float p = __expf(s[kt][j] - mx); s[kt][j] = p; l += p; }
                l += __shfl_xor(l, 16); l += __shfl_xor(l, 32);
                l += __expf(sink - mx);
                const float rl = 1.0f / l;
                f32x4 o[4] = {{0.f, 0.f, 0.f, 0.f}, {0.f, 0.f, 0.f, 0.f}, {0.f, 0.f, 0.f, 0.f}, {0.f, 0.f, 0.f, 0.f}};
#pragma unroll
                for (int ks = 0; ks < 5; ++ks) {
                    const bf16x8 pv = __builtin_bit_cast(bf16x8, ((u32x4){cvt_pk_bf16(s[2 * ks][0], s[2 * ks][1]), cvt_pk_bf16(s[2 * ks][2], s[2 * ks][3]), cvt_pk_bf16(s[2 * ks + 1][0], s[2 * ks + 1][1]), cvt_pk_bf16(s[2 * ks + 1][2], s[2 * ks + 1][3])}));
#pragma unroll
                    for (int dt = 0; dt < 4; ++dt) {
                        const LAS unsigned char* vp = lds + A_VT + (16 * dt + fr) * 560 + (16 * qt + 32 * ks + 4 * fq) * 2;
                        const u32x2 lo = *(const LAS u32x2*)vp, hi = *(const LAS u32x2*)(vp + 32);
                        const bf16x8 vf = __builtin_bit_cast(bf16x8, ((u32x4){lo.x, lo.y, hi.x, hi.y}));
                        o[dt] = __builtin_amdgcn_mfma_f32_16x16x32_bf16(vf, pv, o[dt], 0, 0, 0);
                    }
                }
                if (qvalid) {
#pragma unroll
                    for (int dt = 0; dt < 4; ++dt) { u32x2 w; w.x = cvt_pk_bf16(o[dt][0] * rl, o[dt][1] * rl); w.y = cvt_pk_bf16(o[dt][2] * rl, o[dt][3] * rl);
                        *(u32x2*)(ob + qrow * DM + head * 64 + 16 * dt + 4 * fq) = w; }
                }
            }
        }
    }
}

__device__ __forceinline__ void final_phase(const Args& a) {
    const int lane = threadIdx.x & 63, wave = threadIdx.x >> 6; const int gw = blockIdx.x * 8 + wave, NGW = gridDim.x * 8;
    const float* ss4 = (const float*)(a.ws + WS_SS) + 4 * (size_t)T;
    const f32x4* gp = (const f32x4*)a.in[I_FING] + lane;
    f32x4 gv[4];
#pragma unroll
    for (int j = 0; j < 4; ++j) gv[j] = gp[64 * j];
    for (int m = gw; m < T; m += NGW) {
        float* yrow;
        if (m < TP) { const int b = m / LP, t = m - b * LP; if (t < 16) continue; yrow = a.out + O_YP + ((size_t)(b * 2048 + t - 16)) * DM; } else yrow = a.out + O_YS + (size_t)(m - TP) * DM;
        const float r = rs_row(ss4, m);
        f32x4* p = (f32x4*)yrow + lane;
#pragma unroll
        for (int j = 0; j < 4; ++j) p[64 * j] = p[64 * j] * r * gv[j];
    }
}

constexpr int NPHASE = 13;
__global__ void __launch_bounds__(512) yoco_fwd(Args a) {
    extern __shared__ __attribute__((aligned(16))) unsigned char lds_raw[];
    LAS unsigned char* lds = (LAS unsigned char*)lds_raw;
    cg::grid_group grid = cg::this_grid();
    unsigned char* ws = a.ws;
    float* ss = (float*)(ws + WS_SS);
    bf16_t* hb = (bf16_t*)(ws + WS_HB);
    bf16_t* big = (bf16_t*)(ws + WS_BIG);
    const int lo = a.lo, hi = a.hi, G = gridDim.x;
#define IN(k) (lo <= (k) && (k) < hi)
#define SEAM(k) do { if ((k) + 1 < hi) grid.sync(); } while (0)
    if (IN(0)) { if (REP & 1) { p0_prologue(a, lds); grid.sync(); } p0_prologue(a, lds); SEAM(0); }
    if (IN(1)) { pg8::Gemm g{hb, (const bf16_t*)(ws + WS_WIN), T, NIN, 1024, 1024}; pg8::StaticOrder S; S.init(T, NIN, G, blockIdx.x);
        EpiInProj E{big, (float*)(ws + WS_DT), ss}; if (REP & 2) { pg8::gemm_phase(lds, g, S, E); grid.sync(); } pg8::gemm_phase(lds, g, S, E); SEAM(1); }
    if (IN(2)) { if (REP & 4) { ssd_phase<true>(a, lds); grid.sync(); } ssd_phase<false>(a, lds); SEAM(2); }
    if (IN(3)) { gatenorm_phase(a); SEAM(3); }
    if (IN(4)) { pg8::Gemm g{big, (const bf16_t*)(ws + WS_WOUT), T, 1024, 2048, ZXW}; pg8::StaticOrder S; S.init(T, 1024, G, blockIdx.x);
        EpiResid<false> E{hb, ss + T, nullptr}; pg8::gemm_phase(lds, g, S, E); SEAM(4); }
    if (IN(5)) { pg8::Gemm g{hb, (const bf16_t*)(ws + WS_WGU0), T, 2 * DFF, 1024, 1024}; pg8::StaticOrder S; S.init(T, 2 * DFF, G, blockIdx.x);
        EpiSwiglu E{big, ss + T}; pg8::gemm_phase(lds, g, S, E); SEAM(5); }
    if (IN(6)) { pg8::Gemm g{big, (const bf16_t*)(ws + WS_WD0), T, 1024, DFF, DFF}; pg8::StaticOrder S; S.init(T, 1024, G, blockIdx.x);
        EpiResid<false> E{hb, ss + 2 * T, nullptr}; pg8::gemm_phase(lds, g, S, E); SEAM(6); }
    if (IN(7)) { pg8::Gemm g{hb, (const bf16_t*)(ws + WS_WKVQ), T, NKVQ, 1024, 1024}; pg8::StaticOrder S; S.init(T, NKVQ, G, blockIdx.x);
        EpiKVQ E{(bf16_t*)(ws + WS_K), (bf16_t*)(ws + WS_V), (bf16_t*)(ws + WS_Q), ss + 2 * T, (const float*)(ws + WS_ROPE), a.out}; pg8::gemm_phase(lds, g, S, E); SEAM(7); }
    if (IN(8)) { if (REP & 256) { attn_phase(a, lds); grid.sync(); } attn_phase(a, lds); SEAM(8); }
    if (IN(9)) { pg8::Gemm g{(const bf16_t*)(ws + WS_O), (const bf16_t*)(ws + WS_WO), T, 1024, 1024, 1024}; pg8::StaticOrder S; S.init(T, 1024, G, blockIdx.x);
        EpiResid<false> E{hb, ss + 3 * T, nullptr}; pg8::gemm_phase(lds, g, S, E); SEAM(9); }
    if (IN(10)) { pg8::Gemm g{hb, (const bf16_t*)(ws + WS_WGU1), T, 2 * DFF, 1024, 1024}; pg8::StaticOrder S; S.init(T, 2 * DFF, G, blockIdx.x);
        EpiSwiglu E{big, ss + 3 * T}; pg8::gemm_phase(lds, g, S, E); SEAM(10); }
    if (IN(11)) { pg8::Gemm g{big, (const bf16_t*)(ws + WS_WD1), T, 1024, DFF, DFF}; pg8::StaticOrder S; S.init(T, 1024, G, blockIdx.x);
        EpiResid<true> E{hb, ss + 4 * T, a.out}; pg8::gemm_phase(lds, g, S, E); SEAM(11); }
    if (IN(12)) { final_phase(a); }
#undef IN
#undef SEAM
}

extern "C" void kernel_launch(void* const* d_in, const int* in_sizes, int n_in, void* d_out, int out_size, void* d_ws, size_t ws_size, hipStream_t stream) {
    static int grid = 0;
    if (grid == 0) {
        if (n_in != 28 || ws_size < WS_END) { fprintf(stderr, "kernel_launch: unexpected n_in %d / ws %zu (need %zu)\n", n_in, ws_size, (size_t)WS_END); grid = -1; return; }
        int dev = 0, cus = 0, per_cu = 0;
        hipGetDevice(&dev); hipDeviceGetAttribute(&cus, hipDeviceAttributeMultiprocessorCount, dev);
        hipFuncSetAttribute((const void*)yoco_fwd, hipFuncAttributeMaxDynamicSharedMemorySize, LDS_BYTES);
        hipOccupancyMaxActiveBlocksPerMultiprocessor(&per_cu, (const void*)yoco_fwd, 512, LDS_BYTES);
        if (per_cu < 1) { fprintf(stderr, "kernel_launch: occupancy query says %d blocks/CU\n", per_cu); per_cu = 1; }
        (void)hipGetLastError();
        grid = cus * per_cu;
    }
    if (grid < 0) return;
    Args a{};
    for (int i = 0; i < 28; ++i) a.in[i] = (const float*)d_in[i];
    a.out = (float*)d_out; a.ws = (unsigned char*)d_ws;
#if MK_MULTI
    for (int ph = 0; ph < NPHASE; ++ph) { a.lo = ph; a.hi = ph + 1; hipLaunchKernelGGL(yoco_fwd, dim3(grid), dim3(512), LDS_BYTES, stream, a); }
#else
    a.lo = 0; a.hi = NPHASE;
    void* args[] = {&a};
    hipError_t e = hipLaunchCooperativeKernel((const void*)yoco_fwd, dim3(grid), dim3(512), args, LDS_BYTES, stream);
    if (e != hipSuccess) fprintf(stderr, "cooperative launch failed: %s (grid %d)\n", hipGetErrorString(e), grid);
#endif
}
```

```cpp
#include <hip/hip_runtime.h>
#include <hip/hip_cooperative_groups.h>
#include <cstdio>
#include <cstdint>
namespace cg = cooperative_groups;

#ifndef MK_MULTI
#define MK_MULTI 0
#endif

#ifndef REP
#define REP 0
#endif
#define PROBE_MASK 0
#define LAS __attribute__((address_space(3)))
typedef unsigned short bf16_t;
typedef short bf16x8 __attribute__((ext_vector_type(8)));
typedef float f32x4 __attribute__((ext_vector_type(4)));
typedef float f32x2 __attribute__((ext_vector_type(2)));
typedef unsigned u32x4 __attribute__((ext_vector_type(4)));
typedef unsigned u32x2 __attribute__((ext_vector_type(2)));

constexpr int DM = 1024, NBATCH = 16, LP = 2064, DECB = 128, DECS = 8;
constexpr int TP = NBATCH * LP;
constexpr int TS = DECB * DECS;
constexpr int T = TP + TS;
constexpr int DI = 2048, CONVD = 3072, NH = 32, DFF = 2816;
constexpr int ZXW = 5120;
constexpr int NIN = 5376;
constexpr int NKVQ = 1536;
constexpr float EPS = 1e-5f;

constexpr size_t O_YP = 0, O_YS = 33554432, O_SSMP = 34603008, O_CONVP = 38797312, O_KP = 38944768, O_VP = 39469056,
                 O_SSMS = 39993344, O_CONVS = 73547776, O_KS = 74727424, O_VS = 78921728;

constexpr size_t MiB = 1u << 20;
constexpr size_t WS_SS = 0;
constexpr size_t WS_ROPE = 1 * MiB;
constexpr size_t WS_BAR = 1 * MiB + 512 * 1024;
constexpr size_t WS_DT = 2 * MiB;
constexpr size_t WS_WIN = 8 * MiB, WS_WOUT = 19 * MiB, WS_WGU0 = 23 * MiB, WS_WGU1 = 34 * MiB, WS_WD0 = 45 * MiB, WS_WD1 = 51 * MiB,
                 WS_WKVQ = 57 * MiB, WS_WO = 60 * MiB;
constexpr size_t WS_HB = 64 * MiB;
constexpr size_t WS_BIG = 132 * MiB;
constexpr size_t WS_Q = WS_BIG, WS_K = WS_BIG + 67 * MiB, WS_V = WS_BIG + 84 * MiB, WS_O = WS_BIG + 101 * MiB;
constexpr size_t WS_END = WS_BIG + (size_t)T * ZXW * 2;

constexpr int LDS_BYTES = 135168, LDS_MISC = 133120;

__device__ __forceinline__ unsigned cvt_pk_bf16(float lo, float hi) { unsigned r; asm volatile("v_cvt_pk_bf16_f32 %0, %1, %2" : "=v"(r) : "v"(lo), "v"(hi)); return r; }
__device__ __forceinline__ float bf_lo(unsigned w) { return __uint_as_float(w << 16); }
__device__ __forceinline__ float bf_hi(unsigned w) { return __uint_as_float(w & 0xffff0000u); }
__device__ __forceinline__ float bf1(unsigned short h) { return __uint_as_float(((unsigned)h) << 16); }
__device__ __forceinline__ float silu_f(float x) { return x * __builtin_amdgcn_rcpf(1.0f + __expf(-x)); }
__device__ __forceinline__ float wave_sum(float v) {
#pragma unroll
    for (int o = 1; o < 64; o <<= 1) v += __shfl_xor(v, o);
    return v;
}
__device__ __forceinline__ float rs_row(const float* ss, int row) { return rsqrtf(ss[row] * (1.0f / 1024.0f) + EPS); }

namespace pg8 {
constexpr int BM = 256, BK = 64, HALF = 128, HTB = HALF * BK * 2, STAGE_BYTES = 8 * HTB, NXCD = 8, WGM = 8;
__host__ __device__ __forceinline__ int lds_byte(int r, int c) { const int st = (r >> 4) * 2 + (c >> 5), rr = r & 15, cc = c & 31, ob = rr * 64 + cc * 2; return st * 1024 + (ob ^ (((ob >> 9) & 1) << 5)); }
__host__ __device__ __forceinline__ void stage_rc(int b, int& R, int& C) { const int st = b / 1024, sb = b % 1024, swz = sb ^ (((sb >> 9) & 1) << 5); R = (st >> 1) * 16 + swz / 64; C = (st & 1) * 32 + (swz % 64) / 2; }
__host__ __device__ __forceinline__ int perm32(int rho) { const int n = rho >> 4, i = rho & 15; return 8 * (i >> 2) + 4 * n + (i & 3); }
struct Unit { int pm, pn, ks; };
struct Gemm { const bf16_t* A; const bf16_t* Bt; int M, N, K, lda, klen; };
struct StaticOrder {
    int nM, nN, nwg, G, c;
    __device__ __forceinline__ void init(int M, int N, int G_, int c_) { nM = M / BM; nN = N / BM; nwg = nM * nN; G = G_; c = c_; }
    __device__ __forceinline__ bool next(int i, Unit& u) const {
        const long L = (long)i * G + c; if (L >= nwg) return false;
        int wgid = (int)L; { const int q = nwg / NXCD, r = nwg % NXCD, xcd = wgid % NXCD, off = wgid / NXCD; wgid = (xcd < r ? xcd * (q + 1) : r * (q + 1) + (xcd - r) * q) + off; }
        const int nig = WGM * nN, gid = wgid / nig, fm = gid * WGM, gsz = (nM - fm) < WGM ? (nM - fm) : WGM;
        u.pm = fm + ((wgid % nig) % gsz); u.pn = (wgid % nig) / gsz; u.ks = 0; return true;
    }
};
struct TailOrder {
    int S, G, c, pm0, nN, npan;
    __device__ __forceinline__ bool next(int i, Unit& u) const {
        const int L = i * G + c; if (L >= npan * nN * S) return false;
        u.ks = L % S; const int t = L / S; u.pn = t % nN; u.pm = pm0 + t / nN; return true;
    }
};
template <class Epi, class Order>
__device__ __forceinline__ void gemm_phase(LAS unsigned char* lds, const Gemm g, const Order& S, const Epi& E) {
    const int tid = threadIdx.x, wid = __builtin_amdgcn_readfirstlane(tid >> 6), lane = tid & 63, wr = wid >> 2, wc = wid & 3, fr = lane & 15, fq = lane >> 4;
    const int K = g.K, nt = g.klen / BK, lda = g.lda; const size_t ksplit = (size_t)g.klen * 2;
    unsigned voffA[2], voffB[2];
#pragma unroll
    for (int i = 0; i < 2; ++i) { int R, C; stage_rc(tid * 16 + i * 8192, R, C); const int Rb = (R & ~31) + perm32(R & 31);
        voffA[i] = (unsigned)(R * lda + C) * 2u; voffB[i] = (unsigned)(Rb * K + C) * 2u; }
    const size_t kstep = (size_t)(BK * 2);
    const size_t hstepA = (size_t)HALF * lda * 2, tstepA = 2 * hstepA;
    const size_t hstepB = (size_t)HALF * K * 2, tstepB = 2 * hstepB;
    const unsigned ldsw = (unsigned)wid * 1024u;
    const int aoff = lds_byte(wr * 64 + fr, fq * 8), boff = lds_byte(wc * 32 + fr, fq * 8);
#define PG8_SA(b, h) (((b) * 2 + (h)) * HTB)
#define PG8_SB(b, h) ((4 + (b) * 2 + (h)) * HTB)
#define PG8_STAGE(bufoff, gbase, voff) do { _Pragma("unroll") for (int _i = 0; _i < 2; ++_i) \
        __builtin_amdgcn_global_load_lds((const unsigned*)((const char*)(gbase) + (voff)[_i]), (LAS unsigned*)(lds + (bufoff) + ldsw + _i * 8192), 16, 0, 0); } while (0)
#define PG8_LDA(dst, b, h) do { _Pragma("unroll") for (int m = 0; m < 4; ++m) _Pragma("unroll") for (int k = 0; k < 2; ++k) dst[m][k] = *(const LAS bf16x8*)(lds + PG8_SA(b, h) + aoff + m * 2048 + k * 1024); } while (0)
#define PG8_LDB(dst, b, h) do { _Pragma("unroll") for (int n = 0; n < 2; ++n) _Pragma("unroll") for (int k = 0; k < 2; ++k) dst[n][k] = *(const LAS bf16x8*)(lds + PG8_SB(b, h) + boff + n * 2048 + k * 1024); } while (0)
#define PG8_MMA(ai, bj, At, Bt) do { __builtin_amdgcn_s_setprio(1); _Pragma("unroll") for (int m = 0; m < 4; ++m) _Pragma("unroll") for (int n = 0; n < 2; ++n) _Pragma("unroll") for (int k = 0; k < 2; ++k) \
        acc[ai][bj][m][n] = __builtin_amdgcn_mfma_f32_16x16x32_bf16(Bt[n][k], At[m][k], acc[ai][bj][m][n], 0, 0, 0); __builtin_amdgcn_s_setprio(0); } while (0)
#define PG8_WAIT_V(n) asm volatile("s_waitcnt vmcnt(" #n ")" ::: "memory")
#define PG8_WAIT_L(n) asm volatile("s_waitcnt lgkmcnt(" #n ")" ::: "memory")
#define PG8_BAR __builtin_amdgcn_s_barrier()
#define PG8_SCHED __builtin_amdgcn_sched_barrier(0)
    Unit cur, nxt; int ui = 0;
    if (!S.next(0, cur)) return;
    f32x4 acc[2][2][4][2];
#pragma unroll
    for (int a = 0; a < 2; ++a)
#pragma unroll
        for (int b = 0; b < 2; ++b)
#pragma unroll
            for (int m = 0; m < 4; ++m)
#pragma unroll
                for (int n = 0; n < 2; ++n) acc[a][b][m][n] = (f32x4){0.f, 0.f, 0.f, 0.f};
    bf16x8 At[4][2], B0[2][2], B1[2][2];
    const char* cA = (const char*)g.A + (size_t)cur.pm * tstepA + cur.ks * ksplit; const char* cB = (const char*)g.Bt + (size_t)cur.pn * tstepB + cur.ks * ksplit;
    PG8_STAGE(PG8_SB(0, 0), cB, voffB); PG8_STAGE(PG8_SA(0, 0), cA, voffA); PG8_STAGE(PG8_SB(0, 1), cB + hstepB, voffB); PG8_STAGE(PG8_SA(0, 1), cA + hstepA, voffA);
    if (wr == 1) PG8_BAR;
    PG8_WAIT_V(4); PG8_BAR;
    PG8_STAGE(PG8_SB(1, 0), cB + kstep, voffB); PG8_STAGE(PG8_SA(1, 0), cA + kstep, voffA); PG8_STAGE(PG8_SB(1, 1), cB + hstepB + kstep, voffB);
    PG8_WAIT_V(6); PG8_BAR;
    for (;;) {
        const bool has_next = S.next(ui + 1, nxt);
        const char* nA = has_next ? (const char*)g.A + (size_t)nxt.pm * tstepA + nxt.ks * ksplit : cA; const char* nB = has_next ? (const char*)g.Bt + (size_t)nxt.pn * tstepB + nxt.ks * ksplit : cB;
        for (int t = 0; t < nt; t += 2) {
            const bool last = (t == nt - 2);
            const char* a1 = cA + (size_t)(t + 1) * kstep;
            const char* a2 = last ? nA : cA + (size_t)(t + 2) * kstep; const char* b2 = last ? nB : cB + (size_t)(t + 2) * kstep;
            const char* a3 = a2 + kstep; const char* b3 = b2 + kstep;
            PG8_LDB(B0, 0, 0); PG8_SCHED; PG8_LDA(At, 0, 0); PG8_STAGE(PG8_SA(1, 1), a1 + hstepA, voffA);
            PG8_WAIT_L(8); PG8_BAR; PG8_WAIT_L(0); PG8_MMA(0, 0, At, B0); PG8_BAR; PG8_SCHED;
            PG8_LDB(B1, 0, 1); PG8_STAGE(PG8_SB(0, 0), b2, voffB);
            PG8_BAR; PG8_WAIT_L(0); PG8_MMA(0, 1, At, B1); PG8_BAR;
            PG8_LDA(At, 0, 1); PG8_STAGE(PG8_SA(0, 0), a2, voffA);
            PG8_BAR; PG8_WAIT_L(0); PG8_MMA(1, 0, At, B0); PG8_BAR; PG8_SCHED;
            PG8_STAGE(PG8_SB(0, 1), b2 + hstepB, voffB);
            PG8_WAIT_V(6); PG8_BAR; PG8_MMA(1, 1, At, B1); PG8_BAR;
            PG8_LDB(B0, 1, 0); PG8_SCHED; PG8_LDA(At, 1, 0); PG8_STAGE(PG8_SA(0, 1), a2 + hstepA, voffA);
            PG8_WAIT_L(8); PG8_BAR; PG8_WAIT_L(0); PG8_MMA(0, 0, At, B0); PG8_BAR; PG8_SCHED;
            PG8_LDB(B1, 1, 1); PG8_STAGE(PG8_SB(1, 0), b3, voffB);
            PG8_BAR; PG8_WAIT_L(0); PG8_MMA(0, 1, At, B1); PG8_BAR;
            PG8_LDA(At, 1, 1); PG8_STAGE(PG8_SA(1, 0), a3, voffA);
            PG8_BAR; PG8_WAIT_L(0); PG8_MMA(1, 0, At, B0); PG8_BAR; PG8_SCHED;
            PG8_STAGE(PG8_SB(1, 1), b3 + hstepB, voffB);
            PG8_WAIT_V(6); PG8_BAR; PG8_MMA(1, 1, At, B1); PG8_BAR;
        }
        E(acc, cur, wr, wc, fr, fq);
        if (!has_next) break;
#pragma unroll
        for (int a = 0; a < 2; ++a)
#pragma unroll
            for (int b = 0; b < 2; ++b)
#pragma unroll
                for (int m = 0; m < 4; ++m)
#pragma unroll
                    for (int n = 0; n < 2; ++n) acc[a][b][m][n] = (f32x4){0.f, 0.f, 0.f, 0.f};
        cur = nxt; cA = nA; cB = nB; ++ui;
    }
    PG8_WAIT_V(0);
    if (wr == 0) PG8_BAR;
    PG8_BAR;
#undef PG8_SA
#undef PG8_SB
#undef PG8_STAGE
#undef PG8_LDA
#undef PG8_LDB
#undef PG8_MMA
#undef PG8_WAIT_V
#undef PG8_WAIT_L
#undef PG8_BAR
#undef PG8_SCHED
}
}
using pg8::Unit;

__device__ __forceinline__ u32x4 pack8(const f32x4 v0, const f32x4 v1) {
    u32x4 w; w.x = cvt_pk_bf16(v0[0], v0[1]); w.y = cvt_pk_bf16(v0[2], v0[3]); w.z = cvt_pk_bf16(v1[0], v1[1]); w.w = cvt_pk_bf16(v1[2], v1[3]); return w;
}
struct EpiInProj {
    bf16_t* zx; float* dtraw; const float* ss;
    __device__ __forceinline__ void operator()(const f32x4 (&acc)[2][2][4][2], const Unit& u, int wr, int wc, int fr, int fq) const {
        const int row0 = u.pm * 256 + wr * 64 + fr;
        float rsv[8];
#pragma unroll
        for (int i = 0; i < 8; ++i) rsv[i] = ss[row0 + (i >> 2) * 128 + (i & 3) * 16];
#pragma unroll
        for (int i = 0; i < 8; ++i) rsv[i] = rsqrtf(rsv[i] * (1.0f / 1024.0f) + EPS);
#pragma unroll
        for (int ai = 0; ai < 2; ++ai)
#pragma unroll
            for (int m = 0; m < 4; ++m) {
                const int row = row0 + ai * 128 + m * 16; const float r = rsv[ai * 4 + m];
                if (u.pn < 20) {
#pragma unroll
                    for (int bj = 0; bj < 2; ++bj) { const int col = u.pn * 256 + bj * 128 + wc * 32 + 8 * fq;
                        __builtin_nontemporal_store(pack8(acc[ai][bj][m][0] * r, acc[ai][bj][m][1] * r), (u32x4*)(zx + (size_t)row * ZXW + col)); }
                } else if (wc == 0) {
                    float* d = dtraw + (size_t)row * 32 + 8 * fq;
                    *(f32x4*)d = acc[ai][0][m][0] * r; *(f32x4*)(d + 4) = acc[ai][0][m][1] * r;
                }
            }
    }
};
template <bool FINAL> struct EpiResid {
    bf16_t* hb; float* ssn; float* out;
    __device__ __forceinline__ void operator()(const f32x4 (&acc)[2][2][4][2], const Unit& u, int wr, int wc, int fr, int fq) const {
        const int row0 = u.pm * 256 + wr * 64 + fr;
#pragma unroll
        for (int ai = 0; ai < 2; ++ai)
#pragma unroll
            for (int m = 0; m < 4; ++m) {
                const int row = row0 + ai * 128 + m * 16; float s = 0.f;
                float* yrow = nullptr;
                if (FINAL) { if (row < TP) { const int b = row / LP, t = row - b * LP; if (t >= 16) yrow = out + O_YP + ((size_t)(b * 2048 + t - 16)) * DM; } else yrow = out + O_YS + (size_t)(row - TP) * DM; }
#pragma unroll
                for (int bj = 0; bj < 2; ++bj) { const int col = u.pn * 256 + bj * 128 + wc * 32 + 8 * fq;
                    bf16_t* p = hb + (size_t)row * DM + col; const u32x4 o = *(const u32x4*)p;
                    f32x4 v0 = acc[ai][bj][m][0], v1 = acc[ai][bj][m][1];
                    v0[0] += bf_lo(o.x); v0[1] += bf_hi(o.x); v0[2] += bf_lo(o.y); v0[3] += bf_hi(o.y);
                    v1[0] += bf_lo(o.z); v1[1] += bf_hi(o.z); v1[2] += bf_lo(o.w); v1[3] += bf_hi(o.w);
                    s += (v0[0] * v0[0] + v0[1] * v0[1]) + (v0[2] * v0[2] + v0[3] * v0[3]) + (v1[0] * v1[0] + v1[1] * v1[1]) + (v1[2] * v1[2] + v1[3] * v1[3]);
                    if (FINAL) { if (yrow) { *(f32x4*)(yrow + col) = v0; *(f32x4*)(yrow + col + 4) = v1; } }
                    else *(u32x4*)p = pack8(v0, v1); }
                s += __shfl_xor(s, 16); s += __shfl_xor(s, 32);
                if (fq == 0) atomicAdd(ssn + row, s);
            }
    }
};
constexpr int TAIL_ROW0 = 32768, TAIL_ROWS = T - TAIL_ROW0;
struct EpiPartial {
    float* P;
    __device__ __forceinline__ void operator()(const f32x4 (&acc)[2][2][4][2], const Unit& u, int wr, int wc, int fr, int fq) const {
        const int row0 = u.pm * 256 + wr * 64 + fr - TAIL_ROW0;
#pragma unroll
        for (int ai = 0; ai < 2; ++ai)
#pragma unroll
            for (int m = 0; m < 4; ++m) {
                float* rp = P + ((size_t)u.ks * TAIL_ROWS + row0 + ai * 128 + m * 16) * DM + u.pn * 256 + wc * 32 + 8 * fq;
#pragma unroll
                for (int bj = 0; bj < 2; ++bj) { *(f32x4*)(rp + bj * 128) = acc[ai][bj][m][0]; *(f32x4*)(rp + bj * 128 + 4) = acc[ai][bj][m][1]; }
            }
    }
};
__device__ __forceinline__ void tail_fixup(bf16_t* hb, float* ssn, const float* P, int S) {
    const int lane = threadIdx.x & 63, wave = threadIdx.x >> 6; const int gw = blockIdx.x * 8 + wave, NGW = gridDim.x * 8;
    for (int r = gw; r < TAIL_ROWS; r += NGW) {
        const int row = TAIL_ROW0 + r; f32x4 v[4];
        u32x2* hp = (u32x2*)(hb + (size_t)row * DM) + lane;
#pragma unroll
        for (int j = 0; j < 4; ++j) { const u32x2 o = hp[64 * j]; v[j] = (f32x4){bf_lo(o.x), bf_hi(o.x), bf_lo(o.y), bf_hi(o.y)}; }
        for (int s = 0; s < S; ++s) { const f32x4* pp = (const f32x4*)(P + ((size_t)s * TAIL_ROWS + r) * DM) + lane;
#pragma unroll
            for (int j = 0; j < 4; ++j) v[j] += pp[64 * j]; }
        float q = 0.f;
#pragma unroll
        for (int j = 0; j < 4; ++j) { q += (v[j][0] * v[j][0] + v[j][1] * v[j][1]) + (v[j][2] * v[j][2] + v[j][3] * v[j][3]); u32x2 w; w.x = cvt_pk_bf16(v[j][0], v[j][1]); w.y = cvt_pk_bf16(v[j][2], v[j][3]); hp[64 * j] = w; }
        q = wave_sum(q);
        if (lane == 0) ssn[row] = q;
    }
}
struct EpiSwiglu {
    bf16_t* act; const float* ss;
    __device__ __forceinline__ void operator()(const f32x4 (&acc)[2][2][4][2], const Unit& u, int wr, int wc, int fr, int fq) const {
        const int row0 = u.pm * 256 + wr * 64 + fr, col = u.pn * 128 + wc * 32 + 8 * fq;
        float rsv[8];
#pragma unroll
        for (int i = 0; i < 8; ++i) rsv[i] = ss[row0 + (i >> 2) * 128 + (i & 3) * 16];
#pragma unroll
        for (int i = 0; i < 8; ++i) rsv[i] = rsqrtf(rsv[i] * (1.0f / 1024.0f) + EPS);
#pragma unroll
        for (int ai = 0; ai < 2; ++ai)
#pragma unroll
            for (int m = 0; m < 4; ++m) {
                const int row = row0 + ai * 128 + m * 16; const float r = rsv[ai * 4 + m];
                f32x4 o[2];
#pragma unroll
                for (int n = 0; n < 2; ++n)
#pragma unroll
                    for (int j = 0; j < 4; ++j) { const float g = acc[ai][0][m][n][j] * r, uu = acc[ai][1][m][n][j] * r; o[n][j] = silu_f(g) * uu; }
                __builtin_nontemporal_store(pack8(o[0], o[1]), (u32x4*)(act + (size_t)row * DFF + col));
            }
    }
};
struct EpiKVQ {
    bf16_t *kb, *vb, *qb; const float* ss; const float* rope; float* out;
    __device__ __forceinline__ void operator()(const f32x4 (&acc)[2][2][4][2], const Unit& u, int wr, int wc, int fr, int fq) const {
        const int row0 = u.pm * 256 + wr * 64 + fr;
        const bool do_rope = (u.pn != 1) && ((wc & 1) == 0);
        float rsv[8];
#pragma unroll
        for (int i = 0; i < 8; ++i) rsv[i] = ss[row0 + (i >> 2) * 128 + (i & 3) * 16];
#pragma unroll
        for (int i = 0; i < 8; ++i) rsv[i] = rsqrtf(rsv[i] * (1.0f / 1024.0f) + EPS);
#pragma unroll
        for (int ai = 0; ai < 2; ++ai)
#pragma unroll
            for (int m = 0; m < 4; ++m) {
                const int row = row0 + ai * 128 + m * 16; const float r = rsv[ai * 4 + m];
                int b, t, pidx; long kvrow;
                if (row < TP) { b = row / LP; t = row - b * LP; pidx = t; kvrow = (t >= LP - 128) ? (long)b * 128 + (t - (LP - 128)) : -1; }
                else { const int ms = row - TP; b = ms >> 3; t = ms & 7; pidx = LP + t; kvrow = (long)b * 128 + 120 + t; }
                f32x4 cs0 = {1.f, 1.f, 1.f, 1.f}, cs1 = cs0, sn0 = {0.f, 0.f, 0.f, 0.f}, sn1 = sn0;
                if (do_rope && fq < 2) { const float* rp = rope + (size_t)pidx * 16; cs0 = *(const f32x4*)rp; cs1 = *(const f32x4*)(rp + 4); sn0 = *(const f32x4*)(rp + 8); sn1 = *(const f32x4*)(rp + 12);
                    if (fq == 0) { sn0 = -sn0; sn1 = -sn1; } }
#pragma unroll
                for (int bj = 0; bj < 2; ++bj) {
                    const int colt = bj * 128 + wc * 32 + 8 * fq;
                    f32x4 v0 = acc[ai][bj][m][0] * r, v1 = acc[ai][bj][m][1] * r;
                    if (do_rope) {
                        f32x4 p0, p1;
#pragma unroll
                        for (int j = 0; j < 4; ++j) { p0[j] = __shfl_xor(v0[j], 16); p1[j] = __shfl_xor(v1[j], 16); }
                        v0 = v0 * cs0 + p0 * sn0; v1 = v1 * cs1 + p1 * sn1;
                    }
                    const u32x4 w = pack8(v0, v1);
                    if (u.pn == 0) { *(u32x4*)(kb + (size_t)row * 256 + colt) = w;
                        if (kvrow >= 0) { float* d = out + (row < TP ? O_KP : O_KS) + (size_t)kvrow * 256 + colt; *(f32x4*)d = v0; *(f32x4*)(d + 4) = v1; } }
                    else if (u.pn == 1) { *(u32x4*)(vb + (size_t)row * 256 + colt) = w;
                        if (kvrow >= 0) { float* d = out + (row < TP ? O_VP : O_VS) + (size_t)kvrow * 256 + colt; *(f32x4*)d = v0; *(f32x4*)(d + 4) = v1; } }
                    else __builtin_nontemporal_store(w, (u32x4*)(qb + (size_t)row * DM + (u.pn - 2) * 256 + colt));
                }
            }
    }
};

#define XB_TMO      128
#define XB_XCNT(j)  (256  + 64 * (j))
#define XB_XSUB(j)  (1280 + 64 * (j))
#define XB_XGEN(j)  (2304 + 64 * (j))
#define XB_TOP      3328
#define XB_TOPGEN   3392
#define XCD_BAR_WORDS 3456
#define XB_SPIN_CAP (1u << 18)

__device__ __forceinline__ unsigned xb_ld(unsigned* p)              { return __hip_atomic_load(p, __ATOMIC_RELAXED, __HIP_MEMORY_SCOPE_AGENT); }
__device__ __forceinline__ unsigned xb_add(unsigned* p, unsigned v) { return __hip_atomic_fetch_add(p, v, __ATOMIC_RELAXED, __HIP_MEMORY_SCOPE_AGENT); }
__device__ __forceinline__ unsigned xb_xcc_id() { return (unsigned)__builtin_amdgcn_s_getreg((3 << 11) | 20) & 0xFu; }
#define XB_SPIN(cond, bar) do { unsigned _sp = 0; while (cond) { __builtin_amdgcn_s_sleep(1); \
    if ((++_sp & 255u) == 0u) { if (xb_ld(&(bar)[XB_TMO])) break; if (_sp > XB_SPIN_CAP) { atomicAdd(&(bar)[XB_TMO], 1u); break; } } } } while (0)

struct XcdBarrier {
    unsigned* bar; unsigned x;
    volatile LAS unsigned* st;
};

__device__ __forceinline__ XcdBarrier xcd_barrier_post(unsigned* bar, volatile LAS unsigned* st) {
    XcdBarrier b; b.bar = bar; b.x = xb_xcc_id(); b.st = st;
    if (threadIdx.x == 0) (void)xb_add(&bar[XB_XCNT(b.x)], 1u);
    return b;
}
__device__ __forceinline__ void xcd_barrier_complete(unsigned* bar, unsigned x, unsigned& nloc, unsigned& nx) {
    const unsigned G = gridDim.x * gridDim.y * gridDim.z;
    unsigned sum, cnt, mine, sp = 0u;
    for (;;) {
        sum = 0u; cnt = 0u; mine = 0u;
#pragma unroll
        for (unsigned j = 0; j < 16; ++j) { const unsigned c = xb_ld(&bar[XB_XCNT(j)]); sum += c; cnt += (c > 0u) ? 1u : 0u; mine = (j == x) ? c : mine; }
        if (sum == G) break;
        __builtin_amdgcn_s_sleep(1);
        if ((++sp & 255u) == 0u) { if (xb_ld(&bar[XB_TMO])) break; if (sp > XB_SPIN_CAP) { atomicAdd(&bar[XB_TMO], 1u); break; } }
    }
    nloc = mine > 0u ? mine : 1u; nx = cnt > 0u ? cnt : 1u;
}

__device__ __forceinline__ void xcd_barrier(const XcdBarrier& b) {
    asm volatile("s_waitcnt vmcnt(0)" ::: "memory");
    __syncthreads();
    if (threadIdx.x == 0) {
        unsigned* bar = b.bar;
        __builtin_amdgcn_s_waitcnt(0);
        unsigned nloc = b.st[0], nx = b.st[1];
        if (nloc == 0u) { xcd_barrier_complete(bar, b.x, nloc, nx); b.st[0] = nloc; b.st[1] = nx; }
        const unsigned old = xb_add(&bar[XB_XSUB(b.x)], 1u);
        const unsigned gen = old / nloc;
        if (old + 1u == (gen + 1u) * nloc) {
            __builtin_amdgcn_fence(__ATOMIC_RELEASE, "agent");
            asm volatile("s_waitcnt vmcnt(0)" ::: "memory");
            const unsigned og = xb_add(&bar[XB_TOP], 1u);
            const unsigned tg = og / nx;
            if (og + 1u == (tg + 1u) * nx) xb_add(&bar[XB_TOPGEN], 1u);
            else XB_SPIN(xb_ld(&bar[XB_TOPGEN]) == tg, bar);
            __builtin_amdgcn_fence(__ATOMIC_ACQUIRE, "agent");
            xb_add(&bar[XB_XGEN(b.x)], 1u);
            asm volatile("s_waitcnt vmcnt(0)" ::: "memory");
        } else {
            XB_SPIN(xb_ld(&bar[XB_XGEN(b.x)]) == gen, bar);
            __builtin_amdgcn_fence(__ATOMIC_ACQUIRE, "agent");
            asm volatile("s_waitcnt vmcnt(0)" ::: "memory");
        }
    }
    __syncthreads();
}

struct Args { const float* in[28]; float* out; unsigned char* ws; int lo, hi; };
enum { I_XP = 0, I_XS, I_SSSM, I_SCONV, I_SK, I_SV, I_META, I_SSMG, I_WIN, I_CONVW, I_CONVB, I_DTB, I_ALOG, I_DSKIP, I_GATEG, I_WOUT, I_KVG, I_WK, I_WV,
       I_ATTNG, I_WQ, I_SINKS, I_WOP, I_FFNG, I_WGATE, I_WUP, I_WDOWN, I_FING };

__device__ __forceinline__ void p0_item(const float* W, int ld, int col0, const float* g, float sc, bf16_t* WT, int K, int drow0, int k0, LAS float* scr, int lane) {
    const int kk = lane >> 3, n4 = (lane & 7) * 4;
    f32x4 v[8];
#pragma unroll
    for (int i = 0; i < 8; ++i) { v[i] = (f32x4){0.f, 0.f, 0.f, 0.f};
        if (W) v[i] = __builtin_nontemporal_load((const f32x4*)(W + (size_t)(k0 + 8 * i + kk) * ld + col0 + n4)) * ((g ? g[k0 + 8 * i + kk] : 1.0f) * sc); }
#pragma unroll
    for (int i = 0; i < 8; ++i) { LAS float* d = scr + (8 * i + kk) * 33 + n4; d[0] = v[i][0]; d[1] = v[i][1]; d[2] = v[i][2]; d[3] = v[i][3]; }
    asm volatile("s_waitcnt lgkmcnt(0)" ::: "memory");
    const int c = lane & 7;
#pragma unroll
    for (int j = 0; j < 4; ++j) { const int n = (lane >> 3) + 8 * j; const LAS float* s = scr + (8 * c) * 33 + n;
        u32x4 o; o.x = cvt_pk_bf16(s[0], s[33]); o.y = cvt_pk_bf16(s[66], s[99]); o.z = cvt_pk_bf16(s[132], s[165]); o.w = cvt_pk_bf16(s[198], s[231]);
        *(u32x4*)(WT + (size_t)(drow0 + n) * K + k0 + 8 * c) = o; }
    asm volatile("s_waitcnt lgkmcnt(0)" ::: "memory");
}
__device__ __forceinline__ const float* src_row(const Args& a, int m) {
    if (m < TP) { const int b = m / LP, t = m - b * LP; return t < 16 ? a.in[I_META] + (size_t)t * DM : a.in[I_XP] + ((size_t)b * 2048 + (t - 16)) * DM; }
    return a.in[I_XS] + (size_t)(m - TP) * DM;
}
__device__ __forceinline__ void p0_prologue(const Args& a, LAS unsigned char* lds) {
    const int tid = threadIdx.x, lane = tid & 63, wave = __builtin_amdgcn_readfirstlane(tid >> 6);
    const int gw = blockIdx.x * 8 + wave, NGW = gridDim.x * 8;
    unsigned char* ws = a.ws;
    LAS float* scr = (LAS float*)(lds + wave * 8704);
    constexpr int N0 = (NIN / 32) * 16, N1 = 32 * 32, N2 = 176 * 16, N3 = N2, N4 = 32 * 44, N5 = N4, N6 = 48 * 16, N7 = 32 * 16;
    constexpr int NITEMS = N0 + N1 + N2 + N3 + N4 + N5 + N6 + N7;
    for (int it = gw; it < NITEMS; it += NGW) {
        int r = it;
        if (r < N0) { const int nb = r / 16, kb = r % 16; const bool real = nb * 32 < 5152;
            p0_item(real ? a.in[I_WIN] : nullptr, 5152, nb * 32, a.in[I_SSMG], 1.f, (bf16_t*)(ws + WS_WIN), 1024, nb * 32, kb * 64, scr, lane); continue; } r -= N0;
        if (r < N1) { const int nb = r / 32, kb = r % 32;
            p0_item(a.in[I_WOUT], 1024, nb * 32, a.in[I_GATEG], 1.f, (bf16_t*)(ws + WS_WOUT), 2048, nb * 32, kb * 64, scr, lane); continue; } r -= N1;
        if (r < N2 + N3) { const int layer = r >= N2; if (layer) r -= N2; const int nb = r / 16, kb = r % 16, tile = nb >> 3, w = nb & 7;
            const float* src = (w < 4 ? a.in[I_WGATE] : a.in[I_WUP]) + (size_t)layer * 1024 * DFF;
            p0_item(src, DFF, tile * 128 + (w & 3) * 32, a.in[I_FFNG] + layer * 1024, 1.f, (bf16_t*)(ws + (layer ? WS_WGU1 : WS_WGU0)), 1024, nb * 32, kb * 64, scr, lane); continue; } r -= N2 + N3;
        if (r < N4 + N5) { const int layer = r >= N4; if (layer) r -= N4; const int nb = r / 44, kb = r % 44;
            p0_item(a.in[I_WDOWN] + (size_t)layer * DFF * 1024, 1024, nb * 32, nullptr, 1.f, (bf16_t*)(ws + (layer ? WS_WD1 : WS_WD0)), DFF, nb * 32, kb * 64, scr, lane); continue; } r -= N4 + N5;
        if (r < N6) { const int nb = r / 16, kb = r % 16;
            if (nb < 8) p0_item(a.in[I_WK], 256, nb * 32, a.in[I_KVG], 1.f, (bf16_t*)(ws + WS_WKVQ), 1024, nb * 32, kb * 64, scr, lane);
            else if (nb < 16) p0_item(a.in[I_WV], 256, (nb - 8) * 32, a.in[I_KVG], 1.f, (bf16_t*)(ws + WS_WKVQ), 1024, nb * 32, kb * 64, scr, lane);
            else p0_item(a.in[I_WQ], 1024, (nb - 16) * 32, a.in[I_ATTNG], 0.125f, (bf16_t*)(ws + WS_WKVQ), 1024, nb * 32, kb * 64, scr, lane);
            continue; } r -= N6;
        { const int nb = r / 16, kb = r % 16; p0_item(a.in[I_WOP], 1024, nb * 32, nullptr, 1.f, (bf16_t*)(ws + WS_WO), 1024, nb * 32, kb * 64, scr, lane); }
    }
    float* ss = (float*)(ws + WS_SS);
    bf16_t* hb = (bf16_t*)(ws + WS_HB);
    for (int m0 = gw; m0 < T; m0 += 2 * NGW) {
        const int m1 = m0 + NGW < T ? m0 + NGW : m0;
        const f32x4* xa = (const f32x4*)src_row(a, m0) + lane; const f32x4* xb = (const f32x4*)src_row(a, m1) + lane; f32x4 va[4], vb[4]; float sa = 0.f, sb = 0.f;
#pragma unroll
        for (int j = 0; j < 4; ++j) { va[j] = __builtin_nontemporal_load(xa + 64 * j); vb[j] = __builtin_nontemporal_load(xb + 64 * j); }
#pragma unroll
        for (int j = 0; j < 4; ++j) { sa += (va[j][0] * va[j][0] + va[j][1] * va[j][1]) + (va[j][2] * va[j][2] + va[j][3] * va[j][3]); sb += (vb[j][0] * vb[j][0] + vb[j][1] * vb[j][1]) + (vb[j][2] * vb[j][2] + vb[j][3] * vb[j][3]); }
        sa = wave_sum(sa); sb = wave_sum(sb);
        u32x2* oa = (u32x2*)(hb + (size_t)m0 * DM) + lane; u32x2* ob = (u32x2*)(hb + (size_t)m1 * DM) + lane;
#pragma unroll
        for (int j = 0; j < 4; ++j) { u32x2 w; w.x = cvt_pk_bf16(va[j][0], va[j][1]); w.y = cvt_pk_bf16(va[j][2], va[j][3]); oa[64 * j] = w; w.x = cvt_pk_bf16(vb[j][0], vb[j][1]); w.y = cvt_pk_bf16(vb[j][2], vb[j][3]); ob[64 * j] = w; }
        if (lane == 0) { ss[m0] = sa; ss[T + m0] = 0.f; ss[2 * T + m0] = 0.f; ss[3 * T + m0] = 0.f; ss[4 * T + m0] = 0.f; ss[m1] = sb; ss[T + m1] = 0.f; ss[2 * T + m1] = 0.f; ss[3 * T + m1] = 0.f; ss[4 * T + m1] = 0.f; }
    }
    float* rope = (float*)(ws + WS_ROPE);
    for (int e = blockIdx.x * 512 + tid; e < 2072 * 8; e += gridDim.x * 512) {
        const int pi = e >> 3, i = e & 7; const double pos = (double)(pi < LP ? pi : 16384 + pi - LP);
        const double inv = i == 0 ? 1.0 : i == 1 ? 0.19392274474868576 : i == 2 ? 0.03760603093086393 : i == 3 ? 0.007292664737217109 : i == 4 ? 0.001414213562373095
                         : i == 5 ? 0.0002742481756762073 : i == 6 ? 5.318295896944988e-05 : 1.031338537721246e-05;
        const double rev = pos * inv * 0.15915494309189535; const float fr = (float)(rev - __builtin_rint(rev));
        rope[pi * 16 + i] = __builtin_amdgcn_cosf(fr); rope[pi * 16 + 8 + i] = __builtin_amdgcn_sinf(fr);
    }
}

__device__ __forceinline__ void conv8(const u32x4 (&cur)[4], const float (&w)[4][8], const float (&bias)[8], const bool (&zero)[4], float (&o)[8]) {
#pragma unroll
    for (int e = 0; e < 8; ++e) o[e] = bias[e];
#pragma unroll
    for (int k = 0; k < 4; ++k) {
        const unsigned wd[4] = {cur[k].x, cur[k].y, cur[k].z, cur[k].w};
#pragma unroll
        for (int e = 0; e < 8; ++e) { const float v = (e & 1) ? bf_hi(wd[e >> 1]) : bf_lo(wd[e >> 1]); o[e] += zero[k] ? 0.f : w[k][e] * v; }
    }
#pragma unroll
    for (int e = 0; e < 8; ++e) o[e] = silu_f(o[e]);
}
__device__ __forceinline__ void conv_phase(const Args& a, LAS unsigned char* lds) {
    const int tid = threadIdx.x, r = tid >> 3, ch = tid & 7;
    bf16_t* zx = (bf16_t*)(a.ws + WS_BIG);
    const int NPT = NBATCH * 48, NST = 16 * 48;
    for (int task = blockIdx.x; task < NPT + NST; task += gridDim.x) {
        const bool samp = task >= NPT; const int tt = samp ? task - NPT : task; const int cb = tt % 48, bb = tt / 48;
        const int col = cb * 64 + 8 * ch;
        float w[4][8], bias[8];
#pragma unroll
        for (int k = 0; k < 4; ++k) { const f32x4 w0 = *(const f32x4*)(a.in[I_CONVW] + k * CONVD + col), w1 = *(const f32x4*)(a.in[I_CONVW] + k * CONVD + col + 4);
#pragma unroll
            for (int e = 0; e < 4; ++e) { w[k][e] = w0[e]; w[k][4 + e] = w1[e]; } }
        { const f32x4 b0 = *(const f32x4*)(a.in[I_CONVB] + col), b1 = *(const f32x4*)(a.in[I_CONVB] + col + 4);
#pragma unroll
            for (int e = 0; e < 4; ++e) { bias[e] = b0[e]; bias[4 + e] = b1[e]; } }
        if (!samp) {
            const size_t rowb = (size_t)bb * LP; bf16_t* base = zx + 2048 + col;
            float* ncv = a.out + O_CONVP + (size_t)bb * 3 * CONVD + col;
            u32x4 own[2], halo = {0u, 0u, 0u, 0u};
#define CONV_LOAD(t0) do { _Pragma("unroll") for (int q = 0; q < 2; ++q) { int tg = (t0) + r + 64 * q; tg = tg >= LP ? LP - 1 : tg; own[q] = __builtin_nontemporal_load((const u32x4*)(base + (rowb + tg) * ZXW)); } \
                if (tid < 24) { const int th = (t0) - 3 + (tid >> 3); if (th >= 0) halo = *(const u32x4*)(base + (rowb + th) * ZXW); else halo = (u32x4){0u, 0u, 0u, 0u}; } } while (0)
            CONV_LOAD(2048);
            for (int kt = 0; kt < 17; ++kt) {
                const int t0 = 2048 - 128 * kt;
                LAS unsigned char* tile = lds + (kt & 1) * (131 * 128);
#pragma unroll
                for (int q = 0; q < 2; ++q) *(LAS u32x4*)(tile + (3 + r + 64 * q) * 128 + ch * 16) = own[q];
                if (tid < 24) *(LAS u32x4*)(tile + (tid >> 3) * 128 + ch * 16) = halo;
                const u32x4 raw[2] = {own[0], own[1]};
                if (kt + 1 < 17) CONV_LOAD(t0 - 128);
                asm volatile("s_waitcnt lgkmcnt(0)" ::: "memory"); __builtin_amdgcn_s_barrier(); asm volatile("" ::: "memory");
#pragma unroll
                for (int q = 0; q < 2; ++q) {
                    const int t = t0 + r + 64 * q;
                    u32x4 cur[4];
#pragma unroll
                    for (int k = 0; k < 4; ++k) cur[k] = *(const LAS u32x4*)(tile + (r + 64 * q + k) * 128 + ch * 16);
                    const bool zero[4] = {false, false, false, false};
                    float o[8]; conv8(cur, w, bias, zero, o);
                    if (t < LP) {
                        __builtin_nontemporal_store(((u32x4){cvt_pk_bf16(o[0], o[1]), cvt_pk_bf16(o[2], o[3]), cvt_pk_bf16(o[4], o[5]), cvt_pk_bf16(o[6], o[7])}), (u32x4*)(base + (rowb + t) * ZXW));
                        if (t >= LP - 3) { float* d = ncv + (size_t)(t - (LP - 3)) * CONVD;
                            *(f32x4*)d = (f32x4){bf_lo(raw[q].x), bf_hi(raw[q].x), bf_lo(raw[q].y), bf_hi(raw[q].y)}; *(f32x4*)(d + 4) = (f32x4){bf_lo(raw[q].z), bf_hi(raw[q].z), bf_lo(raw[q].w), bf_hi(raw[q].w)}; }
                    }
                }
            }
#undef CONV_LOAD
        } else {
            const int b = bb * 8 + (r >> 3), t = r & 7; const size_t row = (size_t)TP + b * 8 + t; bf16_t* base = zx + 2048 + col;
            u32x4 cur[4];
#pragma unroll
            for (int k = 0; k < 4; ++k) { const int tk = t - 3 + k;
                if (tk >= 0) cur[k] = *(const u32x4*)(base + (row - 3 + k) * ZXW);
                else { const float* sc = a.in[I_SCONV] + ((size_t)b * 3 + (3 + tk)) * CONVD + col; const f32x4 s0 = *(const f32x4*)sc, s1 = *(const f32x4*)(sc + 4); cur[k] = pack8(s0, s1); } }
            const bool zero[4] = {false, false, false, false};
            float o[8]; conv8(cur, w, bias, zero, o);
            const u32x4 raw = cur[3];
            __syncthreads();
            *(u32x4*)(base + row * ZXW) = (u32x4){cvt_pk_bf16(o[0], o[1]), cvt_pk_bf16(o[2], o[3]), cvt_pk_bf16(o[4], o[5]), cvt_pk_bf16(o[6], o[7])};
            if (t >= 5) { float* d = a.out + O_CONVS + ((size_t)b * 3 + (t - 5)) * CONVD + col;
                *(f32x4*)d = (f32x4){bf_lo(raw.x), bf_hi(raw.x), bf_lo(raw.y), bf_hi(raw.y)}; *(f32x4*)(d + 4) = (f32x4){bf_lo(raw.z), bf_hi(raw.z), bf_lo(raw.w), bf_hi(raw.w)}; }
        }
        __syncthreads();
    }
}

#define WG_BAR() do { asm volatile("s_waitcnt lgkmcnt(0)" ::: "memory"); __builtin_amdgcn_s_barrier(); asm volatile("" ::: "memory"); } while (0)
constexpr int L_CM = 0, L_BM = 8704, L_XN = 17408, L_XD = 26112, L_XW = 34816, L_ZN = 43520, L_UN = 52224, L_SET = 61440, L_DTB = 2 * L_SET;
typedef short s16x4 __attribute__((ext_vector_type(4)));
__device__ __forceinline__ bf16x8 tr8(const LAS unsigned char* p0, const LAS unsigned char* p1) {
    const s16x4 a = __builtin_amdgcn_ds_read_tr16_b64_v4i16((LAS s16x4*)p0), b = __builtin_amdgcn_ds_read_tr16_b64_v4i16((LAS s16x4*)p1);
    return (bf16x8){a[0], a[1], a[2], a[3], b[0], b[1], b[2], b[3]};
}
template <bool DUMMY> __device__ __forceinline__ void ssd_phase(const Args& a, LAS unsigned char* lds) {
    const int tid = threadIdx.x, lane = tid & 63, wave = __builtin_amdgcn_readfirstlane(tid >> 6), fr = lane & 15, fq = lane >> 4;
    bf16_t* zx = (bf16_t*)(a.ws + WS_BIG);
    const float* dtraw = (const float*)(a.ws + WS_DT);
    const bool loader = wave >= 4;
    const int NUNITS = 256 + 2048;
    for (int unit = blockIdx.x; unit < NUNITS; unit += gridDim.x) {
        const bool samp = unit >= 256; int b, g, hp;
        if (!samp) { b = unit >> 4; g = (unit >> 2) & 3; hp = unit & 3; } else { const int u2 = unit - 256; b = u2 >> 4; g = (u2 >> 2) & 3; hp = u2 & 3; }
        const int row0 = samp ? TP + b * 8 : b * LP, L = samp ? 8 : LP, nch = samp ? 1 : 65, h0 = g * 8 + hp * 2;
        const int ltid = tid & 255, t1 = ltid >> 4, ch1 = ltid & 15;
        const int xcol = 2048 + h0 * 64 + 8 * ch1, bcol = 2048 + 2048 + g * 128 + 8 * ch1, ccol = 2048 + 2560 + g * 128 + 8 * ch1, zcol1 = h0 * 64 + 8 * ch1;
        const int dth = lane >> 5;
        const float dtbias = (wave == 7) ? a.in[I_DTB][h0 + dth] : 0.f, negA = (wave == 7) ? -__expf(a.in[I_ALOG][h0 + dth]) : 0.f;
        const int hh = (wave >> 1) & 1, ph = wave & 1, h = h0 + hh, pcol = hh * 64 + ph * 32;
        const float dskip = a.in[I_DSKIP][h];
        f32x4 st[2][8];
#pragma unroll
        for (int pt = 0; pt < 2; ++pt)
#pragma unroll
            for (int nt = 0; nt < 8; ++nt) st[pt][nt] = (f32x4){0.f, 0.f, 0.f, 0.f};
        if (samp && !loader) {
#pragma unroll
            for (int pt = 0; pt < 2; ++pt) { const float* sp = a.in[I_SSSM] + ((size_t)(b * NH + h) * 64 + ph * 32 + pt * 16 + fr) * 128 + 4 * fq;
#pragma unroll
                for (int nt = 0; nt < 8; ++nt) st[pt][nt] = *(const f32x4*)(sp + 16 * nt); } }
        u32x4 xg[2], bg[2], cg[2], zg[2];
        float dtr = 0.f;
#define SSD_FETCH(c) do { if (loader) { int t_o = t1; asm volatile("" : "+v"(t_o)); _Pragma("unroll") for (int q = 0; q < 2; ++q) { int tg = 32 * (c) + t_o + 16 * q; tg = tg >= L ? L - 1 : tg; const bf16_t* rp = zx + (size_t)(row0 + tg) * ZXW; \
            xg[q] = *(const u32x4*)(rp + xcol); bg[q] = *(const u32x4*)(rp + bcol); cg[q] = *(const u32x4*)(rp + ccol); zg[q] = *(const u32x4*)(rp + zcol1); } } } while (0)
#define SSD_DTLOAD(c) do { if (wave == 7) { int tg = 32 * (c) + (lane & 31); tg = tg >= L ? L - 1 : tg; dtr = dtraw[(size_t)(row0 + tg) * 32 + h0 + dth]; } } while (0)
#define SSD_DT(c) do { if (wave == 7) { const int tg = 32 * (c) + (lane & 31); float dt = 0.f; \
            if (tg < L) { const float x = dtr + dtbias; dt = fmaxf(x, 0.f) + __logf(1.0f + __expf(-fabsf(x))); } \
            float cs = dt * negA; \
            _Pragma("unroll") for (int o = 1; o < 32; o <<= 1) { const float up = __shfl_up(cs, o); if ((lane & 31) >= o) cs += up; } \
            const float cl = __shfl(cs, (lane & 32) | 31); \
            LAS float* d = (LAS float*)(lds + L_DTB) + (((c) % 3) * 2 + dth) * 96; d[lane & 31] = cs; d[32 + (lane & 31)] = dt; d[64 + (lane & 31)] = __expf(cl - cs); } } while (0)
#define SSD_STAGE1(cc) do { if (loader) { LAS unsigned char* ts1 = lds + ((cc) & 1) * L_SET; \
            const LAS float* dtb = (const LAS float*)(lds + L_DTB) + (((cc) % 3) * 2 + (ch1 >> 3)) * 96; \
            _Pragma("unroll") for (int q = 0; q < 2; ++q) { const int tq = t1 + 16 * q; \
                const bool valid = 32 * (cc) + tq < L; \
                const float dt = dtb[32 + tq], dw = dt * dtb[64 + tq]; \
                const u32x4 z4 = {0u, 0u, 0u, 0u}; \
                const u32x4 xv = valid ? xg[q] : z4; \
                const unsigned xw4[4] = {xv.x, xv.y, xv.z, xv.w}; \
                unsigned od[4], ow[4]; \
                _Pragma("unroll") for (int e = 0; e < 4; ++e) { const float lo = bf_lo(xw4[e]), hi = bf_hi(xw4[e]); od[e] = cvt_pk_bf16(lo * dt, hi * dt); ow[e] = cvt_pk_bf16(lo * dw, hi * dw); } \
                const int lo_ = tq * 272 + ch1 * 16; \
                *(LAS u32x4*)(ts1 + L_CM + lo_) = valid ? cg[q] : z4; \
                *(LAS u32x4*)(ts1 + L_BM + lo_) = valid ? bg[q] : z4; \
                *(LAS u32x4*)(ts1 + L_XN + lo_) = xv; \
                *(LAS u32x4*)(ts1 + L_XD + lo_) = (u32x4){od[0], od[1], od[2], od[3]}; \
                *(LAS u32x4*)(ts1 + L_XW + lo_) = (u32x4){ow[0], ow[1], ow[2], ow[3]}; \
                *(LAS u32x4*)(ts1 + L_ZN + lo_) = zg[q]; } } } while (0)
#define SSD_USTORE(cc) do { if (loader && !DUMMY) { _Pragma("unroll") for (int q = 0; q < 2; ++q) { const int tg = 32 * (cc) + t1 + 16 * q; \
            if (tg < L) __builtin_nontemporal_store(*(const LAS u32x4*)(lds + ((cc) & 1) * L_SET + L_UN + (t1 + 16 * q) * 272 + ch1 * 16), (u32x4*)(zx + (size_t)(row0 + tg) * ZXW + zcol1)); } } } while (0)
        SSD_FETCH(0); SSD_DTLOAD(0);
        __syncthreads();
        SSD_DT(0); if (nch > 1) SSD_DTLOAD(1);
        WG_BAR();
        SSD_STAGE1(0);
        if (nch > 1) { SSD_FETCH(1); SSD_DT(1); if (nch > 2) SSD_DTLOAD(2); }
        WG_BAR();
        for (int c = 0; c < nch; ++c) {
            if (loader) {
                if (c > 0) SSD_USTORE(c - 1);
                if (c + 1 < nch) {
                    SSD_STAGE1(c + 1);
                    if (c + 2 < nch) { SSD_FETCH(c + 2); SSD_DT(c + 2); if (c + 3 < nch) SSD_DTLOAD(c + 3); }
                }
            } else {
                LAS unsigned char* tsm = lds + (c & 1) * L_SET;
                const LAS float* dcs = (const LAS float*)(lds + L_DTB) + ((c % 3) * 2 + hh) * 96;
                f32x4 g00 = {0.f, 0.f, 0.f, 0.f}, g01 = g00, g11 = g00;
#pragma unroll
                for (int sl = 0; sl < 4; ++sl) {
                    const bf16x8 b0 = *(const LAS bf16x8*)(tsm + L_BM + fr * 272 + sl * 64 + fq * 16), b1 = *(const LAS bf16x8*)(tsm + L_BM + (16 + fr) * 272 + sl * 64 + fq * 16);
                    const bf16x8 c0 = *(const LAS bf16x8*)(tsm + L_CM + fr * 272 + sl * 64 + fq * 16), c1 = *(const LAS bf16x8*)(tsm + L_CM + (16 + fr) * 272 + sl * 64 + fq * 16);
                    g00 = __builtin_amdgcn_mfma_f32_16x16x32_bf16(b0, c0, g00, 0, 0, 0);
                    g01 = __builtin_amdgcn_mfma_f32_16x16x32_bf16(b0, c1, g01, 0, 0, 0);
                    g11 = __builtin_amdgcn_mfma_f32_16x16x32_bf16(b1, c1, g11, 0, 0, 0);
                }
                f32x4 yo[2][2];
#pragma unroll
                for (int pt = 0; pt < 2; ++pt) { yo[pt][0] = (f32x4){0.f, 0.f, 0.f, 0.f}; yo[pt][1] = yo[pt][0]; }
#pragma unroll
                for (int sl = 0; sl < 4; ++sl) {
                    bf16x8 av[2];
#pragma unroll
                    for (int tt = 0; tt < 2; ++tt) { const LAS unsigned char* cp = tsm + L_CM + (16 * tt + fr) * 272 + sl * 64 + fq * 8;
                        const u32x2 lo = *(const LAS u32x2*)cp, hi = *(const LAS u32x2*)(cp + 32); av[tt] = __builtin_bit_cast(bf16x8, ((u32x4){lo.x, lo.y, hi.x, hi.y})); }
#pragma unroll
                    for (int pt = 0; pt < 2; ++pt) {
                        u32x4 sb; sb.x = cvt_pk_bf16(st[pt][2 * sl][0], st[pt][2 * sl][1]); sb.y = cvt_pk_bf16(st[pt][2 * sl][2], st[pt][2 * sl][3]); sb.z = cvt_pk_bf16(st[pt][2 * sl + 1][0], st[pt][2 * sl + 1][1]); sb.w = cvt_pk_bf16(st[pt][2 * sl + 1][2], st[pt][2 * sl + 1][3]);
                        const bf16x8 sbv = __builtin_bit_cast(bf16x8, sb);
                        yo[pt][0] = __builtin_amdgcn_mfma_f32_16x16x32_bf16(av[0], sbv, yo[pt][0], 0, 0, 0);
                        yo[pt][1] = __builtin_amdgcn_mfma_f32_16x16x32_bf16(av[1], sbv, yo[pt][1], 0, 0, 0);
                    }
                }
                const f32x4 cslo = *(const LAS f32x4*)(dcs + 4 * fq), cshi = *(const LAS f32x4*)(dcs + 16 + 4 * fq);
                const float cst0 = dcs[fr], cst1 = dcs[16 + fr];
                float m0[4], m1a[4], m1b[4];
#pragma unroll
                for (int j = 0; j < 4; ++j) {
                    const int s = 4 * fq + j;
                    m0[j] = (s <= fr) ? g00[j] * __expf(cst0 - cslo[j]) : 0.f;
                    m1a[j] = g01[j] * __expf(cst1 - cslo[j]);
                    m1b[j] = (s <= fr) ? g11[j] * __expf(cst1 - cshi[j]) : 0.f;
                }
                const bf16x8 md0 = __builtin_bit_cast(bf16x8, ((u32x4){cvt_pk_bf16(m0[0], m0[1]), cvt_pk_bf16(m0[2], m0[3]), 0u, 0u}));
                const bf16x8 md1 = __builtin_bit_cast(bf16x8, ((u32x4){cvt_pk_bf16(m1a[0], m1a[1]), cvt_pk_bf16(m1a[2], m1a[3]), cvt_pk_bf16(m1b[0], m1b[1]), cvt_pk_bf16(m1b[2], m1b[3])}));
                const float dch = __expf(dcs[31]);
                const int btoff = (8 * fq + (fr >> 2)) * 272 + (4 * (fr & 3)) * 2;
#pragma unroll
                for (int pt = 0; pt < 2; ++pt) {
                    const int troff = (fr >> 2) * 272 + (pcol + 16 * pt + 4 * (fr & 3)) * 2;
                    const bf16x8 xdv = tr8(tsm + L_XD + (4 * fq) * 272 + troff, tsm + L_XD + (16 + 4 * fq) * 272 + troff);
                    f32x4 yd[2];
                    yd[0] = __builtin_amdgcn_mfma_f32_16x16x32_bf16(md0, xdv, ((f32x4){0.f, 0.f, 0.f, 0.f}), 0, 0, 0);
                    yd[1] = __builtin_amdgcn_mfma_f32_16x16x32_bf16(md1, xdv, ((f32x4){0.f, 0.f, 0.f, 0.f}), 0, 0, 0);
#pragma unroll
                    for (int tt = 0; tt < 2; ++tt) {
                        const f32x4 cst = *(const LAS f32x4*)(dcs + 16 * tt + 4 * fq);
                        const s16x4 xs4 = __builtin_amdgcn_ds_read_tr16_b64_v4i16((LAS s16x4*)(tsm + L_XN + (16 * tt + 4 * fq) * 272 + troff));
                        const s16x4 zs4 = __builtin_amdgcn_ds_read_tr16_b64_v4i16((LAS s16x4*)(tsm + L_ZN + (16 * tt + 4 * fq) * 272 + troff));
#pragma unroll
                        for (int j = 0; j < 4; ++j) {
                            const float y = __expf(cst[j]) * yo[pt][tt][j] + yd[tt][j] + dskip * bf1((unsigned short)xs4[j]);
                            const float z = bf1((unsigned short)zs4[j]);
                            *(LAS unsigned short*)(tsm + L_UN + (16 * tt + 4 * fq + j) * 272 + (pcol + 16 * pt + fr) * 2) = (unsigned short)(cvt_pk_bf16(y * silu_f(z), 0.f) & 0xffffu);
                        }
                    }
                }
                bf16x8 xwv[2];
#pragma unroll
                for (int pt = 0; pt < 2; ++pt) { const int troff = (fr >> 2) * 272 + (pcol + 16 * pt + 4 * (fr & 3)) * 2; xwv[pt] = tr8(tsm + L_XW + (8 * fq) * 272 + troff, tsm + L_XW + (8 * fq + 4) * 272 + troff); }
#pragma unroll
                for (int nt = 0; nt < 8; ++nt) {
                    const bf16x8 btv = tr8(tsm + L_BM + btoff + nt * 32, tsm + L_BM + btoff + 4 * 272 + nt * 32);
                    st[0][nt] = __builtin_amdgcn_mfma_f32_16x16x32_bf16(btv, xwv[0], st[0][nt] * dch, 0, 0, 0);
                    st[1][nt] = __builtin_amdgcn_mfma_f32_16x16x32_bf16(btv, xwv[1], st[1][nt] * dch, 0, 0, 0);
                }
            }
            WG_BAR();
        }
        SSD_USTORE(nch - 1);
        if (!loader) {
#pragma unroll
            for (int pt = 0; pt < 2; ++pt) { float* sp = a.out + (samp ? O_SSMS : O_SSMP) + ((size_t)(b * NH + h) * 64 + ph * 32 + pt * 16 + fr) * 128 + 4 * fq;
#pragma unroll
                for (int nt = 0; nt < 8; ++nt) *(f32x4*)(sp + 16 * nt) = st[pt][nt]; } }
#undef SSD_FETCH
#undef SSD_DT
#undef SSD_DTLOAD
#undef SSD_STAGE1
#undef SSD_USTORE
    }
}

__device__ __forceinline__ void gatenorm_phase(const Args& a) {
    const int lane = threadIdx.x & 63, wave = threadIdx.x >> 6; const int gw = blockIdx.x * 8 + wave, NGW = gridDim.x * 8;
    bf16_t* zx = (bf16_t*)(a.ws + WS_BIG);
    for (int m0 = gw; m0 < T; m0 += 2 * NGW) {
        const int m1 = m0 + NGW < T ? m0 + NGW : m0;
        u32x4* p[2] = {(u32x4*)(zx + (size_t)m0 * ZXW) + lane, (u32x4*)(zx + (size_t)m1 * ZXW) + lane}; u32x4 v[2][4];
#pragma unroll
        for (int q = 0; q < 2; ++q)
#pragma unroll
            for (int i = 0; i < 4; ++i) v[q][i] = __builtin_nontemporal_load(p[q] + 64 * i);
#pragma unroll
        for (int q = 0; q < 2; ++q)
#pragma unroll
            for (int i = 0; i < 4; ++i) {
                float f[8] = {bf_lo(v[q][i].x), bf_hi(v[q][i].x), bf_lo(v[q][i].y), bf_hi(v[q][i].y), bf_lo(v[q][i].z), bf_hi(v[q][i].z), bf_lo(v[q][i].w), bf_hi(v[q][i].w)};
                float s = 0.f;
#pragma unroll
                for (int e = 0; e < 8; ++e) s += f[e] * f[e];
                s = wave_sum(s); const float r = rsqrtf(s * (1.0f / 512.0f) + EPS);
                u32x4 o; o.x = cvt_pk_bf16(f[0] * r, f[1] * r); o.y = cvt_pk_bf16(f[2] * r, f[3] * r); o.z = cvt_pk_bf16(f[4] * r, f[5] * r); o.w = cvt_pk_bf16(f[6] * r, f[7] * r);
                if (q == 0 || m1 != m0) p[q][64 * i] = o;
            }
    }
}

constexpr int A_KS = 0, A_VS = 39168;
__device__ __forceinline__ void attn_phase(const Args& a, LAS unsigned char* lds) {
    const int tid = threadIdx.x, lane = tid & 63, wave = __builtin_amdgcn_readfirstlane(tid >> 6), fr = lane & 15, fq = lane >> 4;
    const bf16_t* qb = (const bf16_t*)(a.ws + WS_Q); const bf16_t* kb = (const bf16_t*)(a.ws + WS_K); const bf16_t* vb = (const bf16_t*)(a.ws + WS_V);
    bf16_t* ob = (bf16_t*)(a.ws + WS_O);
    const int NPU = NBATCH * 17 * 4, NUNITS = NPU + DECB * 4;
    for (int unit = blockIdx.x; unit < NUNITS; unit += gridDim.x) {
        const bool samp = unit >= NPU; int b, nblk, g;
        if (!samp) { b = unit / 68; const int r = unit - b * 68; nblk = r >> 2; g = r & 3; } else { const int u2 = unit - NPU; b = u2 >> 2; g = u2 & 3; nblk = 0; }
        const int q0 = samp ? 16384 : 128 * nblk;
        const int seqrow = samp ? TP + b * 8 : b * LP;
        const int nrows = samp ? 8 : (LP - 128 * nblk < 128 ? LP - 128 * nblk : 128);
        __syncthreads();
        for (int idx = tid; idx < 272 * 8; idx += 512) {
            const int kl = idx >> 3, ch = idx & 7; const int kpos = q0 - 144 + kl;
            u32x4 kw = {0u, 0u, 0u, 0u}, vw = kw;
            if (!samp) { if (kpos >= 0 && kpos < LP) { const size_t r = (size_t)(seqrow + kpos) * 256 + g * 64 + 8 * ch; kw = *(const u32x4*)(kb + r); vw = *(const u32x4*)(vb + r); } }
            else if (kpos >= 16384) { if (kpos < 16384 + 8) { const size_t r = (size_t)(seqrow + kpos - 16384) * 256 + g * 64 + 8 * ch; kw = *(const u32x4*)(kb + r); vw = *(const u32x4*)(vb + r); } }
            else if (kpos >= 16256) { const int w = kpos - 16256; const size_t r = ((size_t)(b * 128 + w) * 4 + g) * 64 + 8 * ch;
                const f32x4 k0 = *(const f32x4*)(a.in[I_SK] + r), k1 = *(const f32x4*)(a.in[I_SK] + r + 4), v0 = *(const f32x4*)(a.in[I_SV] + r), v1 = *(const f32x4*)(a.in[I_SV] + r + 4);
                kw = pack8(k0, k1); vw = pack8(v0, v1);
                if (w >= 8) { const size_t d = ((size_t)(b * 128 + w - 8) * 4 + g) * 64 + 8 * ch; float* ko = a.out + O_KS + d; float* vo = a.out + O_VS + d;
                    *(f32x4*)ko = k0; *(f32x4*)(ko + 4) = k1; *(f32x4*)vo = v0; *(f32x4*)(vo + 4) = v1; } }
            *(LAS u32x4*)(lds + A_KS + kl * 144 + ch * 16) = kw;
            *(LAS u32x4*)(lds + A_VS + kl * 144 + ch * 16) = vw;
        }
        const int qt = wave;
        const bool qvalid = 16 * qt + fr < nrows;
        const size_t qrow = (size_t)(seqrow + (samp ? 0 : 128 * nblk) + 16 * qt + fr);
        u32x4 qall[4][2];
#pragma unroll
        for (int hq = 0; hq < 4; ++hq)
#pragma unroll
            for (int sl = 0; sl < 2; ++sl) { qall[hq][sl] = (u32x4){0u, 0u, 0u, 0u}; if (qvalid) qall[hq][sl] = *(const u32x4*)(qb + qrow * DM + (4 * g + hq) * 64 + 32 * sl + 8 * fq); }
        __syncthreads();
        if (16 * qt < nrows) {
            const int qpos = q0 + 16 * qt + fr;
#pragma unroll
            for (int hq = 0; hq < 4; ++hq) {
                const int head = 4 * g + hq;
                bf16x8 qf[2];
#pragma unroll
                for (int sl = 0; sl < 2; ++sl) qf[sl] = __builtin_bit_cast(bf16x8, qall[hq][sl]);
                f32x4 s[10];
                s[0] = (f32x4){-1e30f, -1e30f, -1e30f, -1e30f};
#pragma unroll
                for (int kt = 1; kt < 10; ++kt) {
                    s[kt] = (f32x4){0.f, 0.f, 0.f, 0.f};
#pragma unroll
                    for (int sl = 0; sl < 2; ++sl) { const bf16x8 kf = *(const LAS bf16x8*)(lds + A_KS + (16 * qt + 16 * kt + fr) * 144 + sl * 64 + fq * 16);
                        s[kt] = __builtin_amdgcn_mfma_f32_16x16x32_bf16(kf, qf[sl], s[kt], 0, 0, 0); }
                }
                const float sink = a.in[I_SINKS][head];
                float mx = sink;
                const bool near_start = q0 < 144;
#pragma unroll
                for (int kt = 1; kt < 10; ++kt)
#pragma unroll
                    for (int j = 0; j < 4; ++j) { const int dist = 144 + fr - (16 * kt + 4 * fq + j);
                        if (kt == 1 || kt == 9 || near_start) { const int kpos = qpos - dist; const bool ok = dist >= 0 && dist < 128 && kpos >= 0; s[kt][j] = ok ? s[kt][j] : -1e30f; }
                        mx = fmaxf(mx, s[kt][j]); }
                mx = fmaxf(mx, __shfl_xor(mx, 16)); mx = fmaxf(mx, __shfl_xor(mx, 32));
                float l = 0.f;
#pragma unroll
                for (int kt = 0; kt < 10; ++kt)
#pragma unroll
                    for (int j = 0; j < 4; ++j) { const float p = __expf(s[kt][j] - mx); s[kt][j] = p; l += p; }
                l += __shfl_xor(l, 16); l += __shfl_xor(l, 32);
                l += __expf(sink - mx);
                const float rl = 1.0f / l;
                f32x4 o[4] = {{0.f, 0.f, 0.f, 0.f}, {0.f, 0.f, 0.f, 0.f}, {0.f, 0.f, 0.f, 0.f}, {0.f, 0.f, 0.f, 0.f}};
#pragma unroll
                for (int ks = 0; ks < 5; ++ks) {
                    const bf16x8 pv = __builtin_bit_cast(bf16x8, ((u32x4){cvt_pk_bf16(s[2 * ks][0], s[2 * ks][1]), cvt_pk_bf16(s[2 * ks][2], s[2 * ks][3]), cvt_pk_bf16(s[2 * ks + 1][0], s[2 * ks + 1][1]), cvt_pk_bf16(s[2 * ks + 1][2], s[2 * ks + 1][3])}));
#pragma unroll
                    for (int dt = 0; dt < 4; ++dt) {
                        const LAS unsigned char* vp = lds + A_VS + (16 * qt + 32 * ks + 4 * fq + (fr >> 2)) * 144 + (16 * dt + 4 * (fr & 3)) * 2;
                        const bf16x8 vf = tr8(vp, vp + 16 * 144);
                        o[dt] = __builtin_amdgcn_mfma_f32_16x16x32_bf16(vf, pv, o[dt], 0, 0, 0);
                    }
                }
                if (qvalid) {
#pragma unroll
                    for (int dt = 0; dt < 4; ++dt) { u32x2 w; w.x = cvt_pk_bf16(o[dt][0] * rl, o[dt][1] * rl); w.y = cvt_pk_bf16(o[dt][2] * rl, o[dt][3] * rl);
                        __builtin_nontemporal_store(w, (u32x2*)(ob + qrow * DM + head * 64 + 16 * dt + 4 * fq)); }
                }
            }
        }
    }
}

__device__ __forceinline__ void final_phase(const Args& a) {
    const int lane = threadIdx.x & 63, wave = threadIdx.x >> 6; const int gw = blockIdx.x * 8 + wave, NGW = gridDim.x * 8;
    const float* ss4 = (const float*)(a.ws + WS_SS) + 4 * (size_t)T;
    const f32x4* gp = (const f32x4*)a.in[I_FING] + lane;
    f32x4 gv[4];
#pragma unroll
    for (int j = 0; j < 4; ++j) gv[j] = gp[64 * j];
    const bf16_t* hb = (const bf16_t*)(a.ws + WS_HB);
    for (int m0 = gw; m0 < T; m0 += 2 * NGW) {
        f32x4* p[2]; float r[2]; u32x2 v[2][4];
#pragma unroll
        for (int q = 0; q < 2; ++q) { const int m = m0 + q * NGW; p[q] = nullptr; r[q] = 0.f;
            if (m < T) { float* yrow = nullptr;
                if (m < TP) { const int b = m / LP, t = m - b * LP; if (t >= 16) yrow = a.out + O_YP + ((size_t)(b * 2048 + t - 16)) * DM; } else yrow = a.out + O_YS + (size_t)(m - TP) * DM;
                if (yrow) { p[q] = (f32x4*)yrow + lane; r[q] = rs_row(ss4, m);
#pragma unroll
                    for (int j = 0; j < 4; ++j) v[q][j] = ((const u32x2*)(hb + (size_t)m * DM) + lane)[64 * j]; } } }
#pragma unroll
        for (int q = 0; q < 2; ++q) if (p[q]) {
#pragma unroll
            for (int j = 0; j < 4; ++j) __builtin_nontemporal_store(((f32x4){bf_lo(v[q][j].x), bf_hi(v[q][j].x), bf_lo(v[q][j].y), bf_hi(v[q][j].y)} * r[q] * gv[j]), p[q] + 64 * j); }
    }
}

constexpr int NPHASE = 13;
__global__ void __launch_bounds__(512) yoco_fwd(Args a) {
    extern __shared__ __attribute__((aligned(16))) unsigned char lds_raw[];
    LAS unsigned char* lds = (LAS unsigned char*)lds_raw;
    cg::grid_group grid = cg::this_grid();
    unsigned char* ws = a.ws;
    float* ss = (float*)(ws + WS_SS);
    bf16_t* hb = (bf16_t*)(ws + WS_HB);
    bf16_t* big = (bf16_t*)(ws + WS_BIG);
    const int lo = a.lo, hi = a.hi, G = gridDim.x;
#ifndef PROBE_MASK
#define PROBE_MASK 0
#endif
    unsigned long long pr_acc = 0ull, pr_t0 = 0ull;
#define PR_BEGIN(k) do { if ((PROBE_MASK >> (k)) & 1) pr_t0 = __builtin_amdgcn_s_memrealtime(); } while (0)
#define PR_END(k) do { if ((PROBE_MASK >> (k)) & 1) pr_acc += __builtin_amdgcn_s_memrealtime() - pr_t0; } while (0)
#define IN(k) (lo <= (k) && (k) < hi)
    volatile LAS unsigned* misc = (volatile LAS unsigned*)(lds + LDS_MISC);
    if (threadIdx.x < 2) misc[threadIdx.x] = 0u;
    __syncthreads();
    const XcdBarrier xbar = xcd_barrier_post((unsigned*)(ws + WS_BAR), misc);
    if (lo < 0) grid.sync();
#define GSYNC() xcd_barrier(xbar)
#define SEAM(k) do { if ((k) + 1 < hi) GSYNC(); } while (0)
    if (IN(0)) { PR_BEGIN(0); if (REP & 1) { p0_prologue(a, lds); GSYNC(); } p0_prologue(a, lds); SEAM(0); PR_END(0); }
    if (IN(1)) { PR_BEGIN(1); pg8::Gemm g{hb, (const bf16_t*)(ws + WS_WIN), T, NIN, 1024, 1024, 1024}; pg8::StaticOrder S; S.init(T, NIN, G, blockIdx.x);
        EpiInProj E{big, (float*)(ws + WS_DT), ss}; if (REP & 2) { pg8::gemm_phase(lds, g, S, E); GSYNC(); } pg8::gemm_phase(lds, g, S, E); SEAM(1); PR_END(1); }
    if (IN(2)) { PR_BEGIN(2); PR_BEGIN(13); conv_phase(a, lds); GSYNC(); PR_END(13); PR_BEGIN(14); if (REP & 4) { ssd_phase<true>(a, lds); GSYNC(); } ssd_phase<false>(a, lds); SEAM(2); PR_END(14); PR_END(2); }
    if (IN(3)) { PR_BEGIN(3); gatenorm_phase(a); SEAM(3); PR_END(3); }
    if (IN(4)) { PR_BEGIN(4); { pg8::Gemm g{big, (const bf16_t*)(ws + WS_WOUT), TAIL_ROW0, 1024, 2048, ZXW, 2048}; pg8::StaticOrder S; S.init(TAIL_ROW0, 1024, G, blockIdx.x);
            EpiResid<false> E{hb, ss + T, nullptr}; pg8::gemm_phase(lds, g, S, E); }
        { pg8::Gemm g{big, (const bf16_t*)(ws + WS_WOUT), T, 1024, 2048, ZXW, 256}; pg8::TailOrder S{8, G, (int)blockIdx.x, TAIL_ROW0 / 256, 4, TAIL_ROWS / 256};
            EpiPartial E{(float*)(ws + WS_END)}; pg8::gemm_phase(lds, g, S, E); }
        GSYNC(); tail_fixup(hb, ss + T, (const float*)(ws + WS_END), 8); SEAM(4); PR_END(4); }
    if (IN(5)) { PR_BEGIN(5); pg8::Gemm g{hb, (const bf16_t*)(ws + WS_WGU0), T, 2 * DFF, 1024, 1024, 1024}; pg8::StaticOrder S; S.init(T, 2 * DFF, G, blockIdx.x);
        EpiSwiglu E{big, ss + T}; pg8::gemm_phase(lds, g, S, E); SEAM(5); PR_END(5); }
    if (IN(6)) { PR_BEGIN(6); { pg8::Gemm g{big, (const bf16_t*)(ws + WS_WD0), TAIL_ROW0, 1024, DFF, DFF, DFF}; pg8::StaticOrder S; S.init(TAIL_ROW0, 1024, G, blockIdx.x);
            EpiResid<false> E{hb, ss + 2 * T, nullptr}; pg8::gemm_phase(lds, g, S, E); }
        { pg8::Gemm g{big, (const bf16_t*)(ws + WS_WD0), T, 1024, DFF, DFF, 256}; pg8::TailOrder S{11, G, (int)blockIdx.x, TAIL_ROW0 / 256, 4, TAIL_ROWS / 256};
            EpiPartial E{(float*)(ws + WS_BIG + 200 * MiB)}; pg8::gemm_phase(lds, g, S, E); }
        GSYNC(); tail_fixup(hb, ss + 2 * T, (const float*)(ws + WS_BIG + 200 * MiB), 11); SEAM(6); PR_END(6); }
    if (IN(7)) { PR_BEGIN(7); pg8::Gemm g{hb, (const bf16_t*)(ws + WS_WKVQ), T, NKVQ, 1024, 1024, 1024}; pg8::StaticOrder S; S.init(T, NKVQ, G, blockIdx.x);
        EpiKVQ E{(bf16_t*)(ws + WS_K), (bf16_t*)(ws + WS_V), (bf16_t*)(ws + WS_Q), ss + 2 * T, (const float*)(ws + WS_ROPE), a.out}; pg8::gemm_phase(lds, g, S, E); SEAM(7); PR_END(7); }
    if (IN(8)) { PR_BEGIN(8); if (REP & 256) { attn_phase(a, lds); GSYNC(); } attn_phase(a, lds); SEAM(8); PR_END(8); }
    if (IN(9)) { PR_BEGIN(9); { pg8::Gemm g{(const bf16_t*)(ws + WS_O), (const bf16_t*)(ws + WS_WO), TAIL_ROW0, 1024, 1024, 1024, 1024}; pg8::StaticOrder S; S.init(TAIL_ROW0, 1024, G, blockIdx.x);
            EpiResid<false> E{hb, ss + 3 * T, nullptr}; pg8::gemm_phase(lds, g, S, E); }
        { pg8::Gemm g{(const bf16_t*)(ws + WS_O), (const bf16_t*)(ws + WS_WO), T, 1024, 1024, 1024, 256}; pg8::TailOrder S{4, G, (int)blockIdx.x, TAIL_ROW0 / 256, 4, TAIL_ROWS / 256};
            EpiPartial E{(float*)(ws + WS_END)}; pg8::gemm_phase(lds, g, S, E); }
        GSYNC(); tail_fixup(hb, ss + 3 * T, (const float*)(ws + WS_END), 4); SEAM(9); PR_END(9); }
    if (IN(10)) { PR_BEGIN(10); pg8::Gemm g{hb, (const bf16_t*)(ws + WS_WGU1), T, 2 * DFF, 1024, 1024, 1024}; pg8::StaticOrder S; S.init(T, 2 * DFF, G, blockIdx.x);
        EpiSwiglu E{big, ss + 3 * T}; pg8::gemm_phase(lds, g, S, E); SEAM(10); PR_END(10); }
    if (IN(11)) { PR_BEGIN(11); { pg8::Gemm g{big, (const bf16_t*)(ws + WS_WD1), TAIL_ROW0, 1024, DFF, DFF, DFF}; pg8::StaticOrder S; S.init(TAIL_ROW0, 1024, G, blockIdx.x);
            EpiResid<false> E{hb, ss + 4 * T, nullptr}; pg8::gemm_phase(lds, g, S, E); }
        { pg8::Gemm g{big, (const bf16_t*)(ws + WS_WD1), T, 1024, DFF, DFF, 256}; pg8::TailOrder S{11, G, (int)blockIdx.x, TAIL_ROW0 / 256, 4, TAIL_ROWS / 256};
            EpiPartial E{(float*)(ws + WS_BIG + 200 * MiB)}; pg8::gemm_phase(lds, g, S, E); }
        GSYNC(); tail_fixup(hb, ss + 4 * T, (const float*)(ws + WS_BIG + 200 * MiB), 11); SEAM(11); PR_END(11); }
    if (IN(12)) { PR_BEGIN(12); final_phase(a); if (PROBE_MASK & (1 << 12)) { grid.sync(); PR_END(12); } }
    if (PROBE_MASK && blockIdx.x == 0 && threadIdx.x == 0) { const unsigned long long t0 = __builtin_amdgcn_s_memrealtime(); while (__builtin_amdgcn_s_memrealtime() - t0 < 4ull * pr_acc) __builtin_amdgcn_s_sleep(8); }
#undef IN
#undef SEAM
}

extern "C" void kernel_launch(void* const* d_in, const int* in_sizes, int n_in, void* d_out, int out_size, void* d_ws, size_t ws_size, hipStream_t stream) {
    static int grid = 0;
    if (grid == 0) {
        if (n_in != 28 || ws_size < WS_END + 42 * MiB) { fprintf(stderr, "kernel_launch: unexpected n_in %d / ws %zu (need %zu)\n", n_in, ws_size, (size_t)WS_END); grid = -1; return; }
        int dev = 0, cus = 0, per_cu = 0;
        hipGetDevice(&dev); hipDeviceGetAttribute(&cus, hipDeviceAttributeMultiprocessorCount, dev);
        hipFuncSetAttribute((const void*)yoco_fwd, hipFuncAttributeMaxDynamicSharedMemorySize, LDS_BYTES);
        hipOccupancyMaxActiveBlocksPerMultiprocessor(&per_cu, (const void*)yoco_fwd, 512, LDS_BYTES);
        if (per_cu < 1) { fprintf(stderr, "kernel_launch: occupancy query says %d blocks/CU\n", per_cu); per_cu = 1; }
        (void)hipGetLastError();
        grid = cus * per_cu;
    }
    if (grid < 0) return;
    Args a{};
    for (int i = 0; i < 28; ++i) a.in[i] = (const float*)d_in[i];
    a.out = (float*)d_out; a.ws = (unsigned char*)d_ws;
#if MK_MULTI
    for (int ph = 0; ph < NPHASE; ++ph) { a.lo = ph; a.hi = ph + 1; hipLaunchKernelGGL(yoco_fwd, dim3(grid), dim3(512), LDS_BYTES, stream, a); }
#else
    a.lo = 0; a.hi = NPHASE;
    (void)hipMemsetAsync((unsigned char*)d_ws + WS_BAR, 0, 16384, stream);
    void* args[] = {&a};
    hipError_t e = hipLaunchCooperativeKernel((const void*)yoco_fwd, dim3(grid), dim3(512), args, LDS_BYTES, stream);
    if (e != hipSuccess) fprintf(stderr, "cooperative launch failed: %s (grid %d)\n", hipGetErrorString(e), grid);
#endif
}
```

```cpp
#include <hip/hip_runtime.h>
#include <hip/hip_cooperative_groups.h>
#include <cstdio>
#include <cstdint>
namespace cg = cooperative_groups;

#ifndef MK_MULTI
#define MK_MULTI 0
#endif

#ifndef REP
#define REP 0
#endif
#define PROBE_MASK 0
#define LAS __attribute__((address_space(3)))
typedef unsigned short bf16_t;
typedef short bf16x8 __attribute__((ext_vector_type(8)));
typedef float f32x4 __attribute__((ext_vector_type(4)));
typedef float f32x2 __attribute__((ext_vector_type(2)));
typedef unsigned u32x4 __attribute__((ext_vector_type(4)));
typedef unsigned u32x2 __attribute__((ext_vector_type(2)));

constexpr int DM = 1024, NBATCH = 16, LP = 2064, DECB = 128, DECS = 8;
constexpr int TP = NBATCH * LP;
constexpr int TS = DECB * DECS;
constexpr int T = TP + TS;
constexpr int DI = 2048, CONVD = 3072, NH = 32, DFF = 2816;
constexpr int ZXW = 5120;
constexpr int NIN = 5376;
constexpr int NKVQ = 1536;
constexpr float EPS = 1e-5f;

constexpr size_t O_YP = 0, O_YS = 33554432, O_SSMP = 34603008, O_CONVP = 38797312, O_KP = 38944768, O_VP = 39469056,
                 O_SSMS = 39993344, O_CONVS = 73547776, O_KS = 74727424, O_VS = 78921728;

constexpr size_t MiB = 1u << 20;
constexpr size_t WS_SS = 0;
constexpr size_t WS_ROPE = 1 * MiB;
constexpr size_t WS_BAR = 1 * MiB + 512 * 1024;
constexpr size_t WS_DT = 2 * MiB;
constexpr size_t WS_WIN = 8 * MiB, WS_WOUT = 19 * MiB, WS_WGU0 = 23 * MiB, WS_WGU1 = 34 * MiB, WS_WD0 = 45 * MiB, WS_WD1 = 51 * MiB,
                 WS_WKVQ = 57 * MiB, WS_WO = 60 * MiB;
constexpr size_t WS_HB = 64 * MiB;
constexpr size_t WS_BIG = 132 * MiB;
constexpr size_t WS_Q = WS_BIG, WS_K = WS_BIG + 67 * MiB, WS_V = WS_BIG + 84 * MiB, WS_O = WS_BIG + 101 * MiB;
constexpr size_t WS_END = WS_BIG + (size_t)T * ZXW * 2;

constexpr int LDS_BYTES = 135168, LDS_MISC = 133120;

__device__ __forceinline__ unsigned cvt_pk_bf16(float lo, float hi) { unsigned r; asm volatile("v_cvt_pk_bf16_f32 %0, %1, %2" : "=v"(r) : "v"(lo), "v"(hi)); return r; }
__device__ __forceinline__ float bf_lo(unsigned w) { return __uint_as_float(w << 16); }
__device__ __forceinline__ float bf_hi(unsigned w) { return __uint_as_float(w & 0xffff0000u); }
__device__ __forceinline__ float bf1(unsigned short h) { return __uint_as_float(((unsigned)h) << 16); }
__device__ __forceinline__ float silu_f(float x) { return x * __builtin_amdgcn_rcpf(1.0f + __expf(-x)); }
__device__ __forceinline__ float wave_sum(float v) {
#pragma unroll
    for (int o = 1; o < 64; o <<= 1) v += __shfl_xor(v, o);
    return v;
}
__device__ __forceinline__ float rs_row(const float* ss, int row) { return rsqrtf(ss[row] * (1.0f / 1024.0f) + EPS); }

namespace pg8 {
constexpr int BM = 256, BK = 64, HALF = 128, HTB = HALF * BK * 2, STAGE_BYTES = 8 * HTB, NXCD = 8, WGM = 8;
__host__ __device__ __forceinline__ int lds_byte(int r, int c) { const int st = (r >> 4) * 2 + (c >> 5), rr = r & 15, cc = c & 31, ob = rr * 64 + cc * 2; return st * 1024 + (ob ^ (((ob >> 9) & 1) << 5)); }
__host__ __device__ __forceinline__ void stage_rc(int b, int& R, int& C) { const int st = b / 1024, sb = b % 1024, swz = sb ^ (((sb >> 9) & 1) << 5); R = (st >> 1) * 16 + swz / 64; C = (st & 1) * 32 + (swz % 64) / 2; }
__host__ __device__ __forceinline__ int perm32(int rho) { const int n = rho >> 4, i = rho & 15; return 8 * (i >> 2) + 4 * n + (i & 3); }
struct Unit { int pm, pn, ks; };
struct Gemm { const bf16_t* A; const bf16_t* Bt; int M, N, K, lda, klen; };
struct StaticOrder {
    int nM, nN, nwg, G, c;
    __device__ __forceinline__ void init(int M, int N, int G_, int c_) { nM = M / BM; nN = N / BM; nwg = nM * nN; G = G_; c = c_; }
    __device__ __forceinline__ bool next(int i, Unit& u) const {
        const long L = (long)i * G + c; if (L >= nwg) return false;
        int wgid = (int)L; { const int q = nwg / NXCD, r = nwg % NXCD, xcd = wgid % NXCD, off = wgid / NXCD; wgid = (xcd < r ? xcd * (q + 1) : r * (q + 1) + (xcd - r) * q) + off; }
        const int nig = WGM * nN, gid = wgid / nig, fm = gid * WGM, gsz = (nM - fm) < WGM ? (nM - fm) : WGM;
        u.pm = fm + ((wgid % nig) % gsz); u.pn = (wgid % nig) / gsz; u.ks = 0; return true;
    }
};
struct TailOrder {
    int S, G, c, pm0, nN, npan;
    __device__ __forceinline__ bool next(int i, Unit& u) const {
        const int L = i * G + c; if (L >= npan * nN * S) return false;
        u.ks = L % S; const int t = L / S; u.pn = t % nN; u.pm = pm0 + t / nN; return true;
    }
};
#ifndef PG8_SP2
#define PG8_SP2 true
#endif
#ifndef PG8_ALIGN
#define PG8_ALIGN true
#endif
template <class Epi, class Order, bool ALIGN_EPI = PG8_ALIGN, bool SP2 = PG8_SP2>
__device__ __forceinline__ void gemm_phase(LAS unsigned char* lds, const Gemm g, const Order& S, const Epi& E) {
    const int tid = threadIdx.x, wid = __builtin_amdgcn_readfirstlane(tid >> 6), lane = tid & 63, wr = wid >> 2, wc = wid & 3, fr = lane & 15, fq = lane >> 4;
    const int K = g.K, nt = g.klen / BK, lda = g.lda; const size_t ksplit = (size_t)g.klen * 2;
    unsigned voffA[2], voffB[2];
#pragma unroll
    for (int i = 0; i < 2; ++i) { int R, C; stage_rc(tid * 16 + i * 8192, R, C); const int Rb = (R & ~31) + perm32(R & 31);
        voffA[i] = (unsigned)(R * lda + C) * 2u; voffB[i] = (unsigned)(Rb * K + C) * 2u; }
    const size_t kstep = (size_t)(BK * 2);
    const size_t hstepA = (size_t)HALF * lda * 2, tstepA = 2 * hstepA;
    const size_t hstepB = (size_t)HALF * K * 2, tstepB = 2 * hstepB;
    const unsigned ldsw = (unsigned)wid * 1024u;
    const int aoff = lds_byte(wr * 64 + fr, fq * 8), boff = lds_byte(wc * 32 + fr, fq * 8);
#define PG8_SA(b, h) (((b) * 2 + (h)) * HTB)
#define PG8_SB(b, h) ((4 + (b) * 2 + (h)) * HTB)
#define PG8_STAGE(bufoff, gbase, voff) do { _Pragma("unroll") for (int _i = 0; _i < 2; ++_i) \
        __builtin_amdgcn_global_load_lds((const unsigned*)((const char*)(gbase) + (voff)[_i]), (LAS unsigned*)(lds + (bufoff) + ldsw + _i * 8192), 16, 0, 0); } while (0)
#define PG8_LDA(dst, b, h) do { _Pragma("unroll") for (int m = 0; m < 4; ++m) _Pragma("unroll") for (int k = 0; k < 2; ++k) dst[m][k] = *(const LAS bf16x8*)(lds + PG8_SA(b, h) + aoff + m * 2048 + k * 1024); } while (0)
#define PG8_LDB(dst, b, h) do { _Pragma("unroll") for (int n = 0; n < 2; ++n) _Pragma("unroll") for (int k = 0; k < 2; ++k) dst[n][k] = *(const LAS bf16x8*)(lds + PG8_SB(b, h) + boff + n * 2048 + k * 1024); } while (0)
#define PG8_MMA(ai, bj, At, Bt) do { __builtin_amdgcn_s_setprio(1); _Pragma("unroll") for (int m = 0; m < 4; ++m) _Pragma("unroll") for (int n = 0; n < 2; ++n) _Pragma("unroll") for (int k = 0; k < 2; ++k) \
        acc[ai][bj][m][n] = __builtin_amdgcn_mfma_f32_16x16x32_bf16(Bt[n][k], At[m][k], acc[ai][bj][m][n], 0, 0, 0); __builtin_amdgcn_s_setprio(0); } while (0)
#define PG8_WAIT_V(n) asm volatile("s_waitcnt vmcnt(" #n ")" ::: "memory")
#define PG8_WAIT_L(n) asm volatile("s_waitcnt lgkmcnt(" #n ")" ::: "memory")
#define PG8_BAR __builtin_amdgcn_s_barrier()
#define PG8_SCHED __builtin_amdgcn_sched_barrier(0)
    Unit cur, nxt; int ui = 0;
    if (!S.next(0, cur)) return;
    f32x4 acc[2][2][4][2];
#pragma unroll
    for (int a = 0; a < 2; ++a)
#pragma unroll
        for (int b = 0; b < 2; ++b)
#pragma unroll
            for (int m = 0; m < 4; ++m)
#pragma unroll
                for (int n = 0; n < 2; ++n) acc[a][b][m][n] = (f32x4){0.f, 0.f, 0.f, 0.f};
    bf16x8 At[4][2], B0[2][2], B1[2][2];
    const char* cA = (const char*)g.A + (size_t)cur.pm * tstepA + cur.ks * ksplit; const char* cB = (const char*)g.Bt + (size_t)cur.pn * tstepB + cur.ks * ksplit;
    if constexpr (SP2) {
        PG8_STAGE(PG8_SB(0, 0), cB, voffB); PG8_STAGE(PG8_SB(0, 1), cB + hstepB, voffB); PG8_STAGE(PG8_SA(0, 0), cA, voffA); PG8_STAGE(PG8_SA(0, 1), cA + hstepA, voffA);
        if (wr == 1) PG8_BAR;
        PG8_WAIT_V(2); PG8_BAR;
        PG8_STAGE(PG8_SB(1, 0), cB + kstep, voffB); PG8_STAGE(PG8_SA(1, 0), cA + kstep, voffA); PG8_STAGE(PG8_SB(1, 1), cB + hstepB + kstep, voffB);
        PG8_WAIT_V(6); PG8_BAR;
    } else {
        PG8_STAGE(PG8_SB(0, 0), cB, voffB); PG8_STAGE(PG8_SA(0, 0), cA, voffA); PG8_STAGE(PG8_SB(0, 1), cB + hstepB, voffB); PG8_STAGE(PG8_SA(0, 1), cA + hstepA, voffA);
        if (wr == 1) PG8_BAR;
        PG8_WAIT_V(4); PG8_BAR;
        PG8_STAGE(PG8_SB(1, 0), cB + kstep, voffB); PG8_STAGE(PG8_SA(1, 0), cA + kstep, voffA); PG8_STAGE(PG8_SB(1, 1), cB + hstepB + kstep, voffB);
        PG8_WAIT_V(6); PG8_BAR;
    }
    for (;;) {
        const bool has_next = S.next(ui + 1, nxt);
        const char* nA = has_next ? (const char*)g.A + (size_t)nxt.pm * tstepA + nxt.ks * ksplit : cA; const char* nB = has_next ? (const char*)g.Bt + (size_t)nxt.pn * tstepB + nxt.ks * ksplit : cB;
        for (int t = 0; t < nt; t += 2) {
            const bool last = (t == nt - 2);
            const char* a1 = cA + (size_t)(t + 1) * kstep;
            const char* a2 = last ? nA : cA + (size_t)(t + 2) * kstep; const char* b2 = last ? nB : cB + (size_t)(t + 2) * kstep;
            const char* a3 = a2 + kstep; const char* b3 = b2 + kstep;
            if constexpr (SP2) {
            PG8_LDB(B0, 0, 0); PG8_LDB(B1, 0, 1); PG8_SCHED; PG8_LDA(At, 0, 0); PG8_STAGE(PG8_SA(1, 1), a1 + hstepA, voffA);
            PG8_WAIT_V(8); PG8_WAIT_L(0); PG8_BAR; PG8_MMA(0, 0, At, B0); PG8_MMA(0, 1, At, B1); PG8_BAR; PG8_SCHED;
            PG8_LDA(At, 0, 1); PG8_STAGE(PG8_SB(0, 0), b2, voffB); PG8_STAGE(PG8_SB(0, 1), b2 + hstepB, voffB); PG8_STAGE(PG8_SA(0, 0), a2, voffA);
            PG8_WAIT_V(8); PG8_WAIT_L(0); PG8_BAR; PG8_MMA(1, 0, At, B0); PG8_MMA(1, 1, At, B1); PG8_BAR; PG8_SCHED;
            PG8_LDB(B0, 1, 0); PG8_LDB(B1, 1, 1); PG8_SCHED; PG8_LDA(At, 1, 0); PG8_STAGE(PG8_SA(0, 1), a2 + hstepA, voffA);
            PG8_WAIT_V(8); PG8_WAIT_L(0); PG8_BAR; PG8_MMA(0, 0, At, B0); PG8_MMA(0, 1, At, B1); PG8_BAR; PG8_SCHED;
            PG8_LDA(At, 1, 1); PG8_STAGE(PG8_SB(1, 0), b3, voffB); PG8_STAGE(PG8_SB(1, 1), b3 + hstepB, voffB); PG8_STAGE(PG8_SA(1, 0), a3, voffA);
            PG8_WAIT_V(8); PG8_WAIT_L(0); PG8_BAR; PG8_MMA(1, 0, At, B0); PG8_MMA(1, 1, At, B1); PG8_BAR; PG8_SCHED;
            } else {
            PG8_LDB(B0, 0, 0); PG8_SCHED; PG8_LDA(At, 0, 0); PG8_STAGE(PG8_SA(1, 1), a1 + hstepA, voffA);
            PG8_WAIT_L(8); PG8_BAR; PG8_WAIT_L(0); PG8_MMA(0, 0, At, B0); PG8_BAR; PG8_SCHED;
            PG8_LDB(B1, 0, 1); PG8_STAGE(PG8_SB(0, 0), b2, voffB);
            PG8_BAR; PG8_WAIT_L(0); PG8_MMA(0, 1, At, B1); PG8_BAR;
            PG8_LDA(At, 0, 1); PG8_STAGE(PG8_SA(0, 0), a2, voffA);
            PG8_BAR; PG8_WAIT_L(0); PG8_MMA(1, 0, At, B0); PG8_BAR; PG8_SCHED;
            PG8_STAGE(PG8_SB(0, 1), b2 + hstepB, voffB);
            PG8_WAIT_V(6); PG8_BAR; PG8_MMA(1, 1, At, B1); PG8_BAR;
            PG8_LDB(B0, 1, 0); PG8_SCHED; PG8_LDA(At, 1, 0); PG8_STAGE(PG8_SA(0, 1), a2 + hstepA, voffA);
            PG8_WAIT_L(8); PG8_BAR; PG8_WAIT_L(0); PG8_MMA(0, 0, At, B0); PG8_BAR; PG8_SCHED;
            PG8_LDB(B1, 1, 1); PG8_STAGE(PG8_SB(1, 0), b3, voffB);
            PG8_BAR; PG8_WAIT_L(0); PG8_MMA(0, 1, At, B1); PG8_BAR;
            PG8_LDA(At, 1, 1); PG8_STAGE(PG8_SA(1, 0), a3, voffA);
            PG8_BAR; PG8_WAIT_L(0); PG8_MMA(1, 0, At, B0); PG8_BAR; PG8_SCHED;
            PG8_STAGE(PG8_SB(1, 1), b3 + hstepB, voffB);
            PG8_WAIT_V(6); PG8_BAR; PG8_MMA(1, 1, At, B1); PG8_BAR;
            }
        }
        if constexpr (ALIGN_EPI) { if (wr == 0) PG8_BAR; }
        E(acc, cur, wr, wc, fr, fq);
        if (!has_next) break;
#pragma unroll
        for (int a = 0; a < 2; ++a)
#pragma unroll
            for (int b = 0; b < 2; ++b)
#pragma unroll
                for (int m = 0; m < 4; ++m)
#pragma unroll
                    for (int n = 0; n < 2; ++n) acc[a][b][m][n] = (f32x4){0.f, 0.f, 0.f, 0.f};
        cur = nxt; cA = nA; cB = nB; ++ui;
        if constexpr (ALIGN_EPI) { if (wr == 1) PG8_BAR; }
    }
    PG8_WAIT_V(0);
    if constexpr (!ALIGN_EPI) { if (wr == 0) PG8_BAR; }
    PG8_BAR;
#undef PG8_SA
#undef PG8_SB
#undef PG8_STAGE
#undef PG8_LDA
#undef PG8_LDB
#undef PG8_MMA
#undef PG8_WAIT_V
#undef PG8_WAIT_L
#undef PG8_BAR
#undef PG8_SCHED
}
}
using pg8::Unit;

__device__ __forceinline__ u32x4 pack8(const f32x4 v0, const f32x4 v1) {
    u32x4 w; w.x = cvt_pk_bf16(v0[0], v0[1]); w.y = cvt_pk_bf16(v0[2], v0[3]); w.z = cvt_pk_bf16(v1[0], v1[1]); w.w = cvt_pk_bf16(v1[2], v1[3]); return w;
}
struct EpiInProj {
    bf16_t* zx; float* dtraw; const float* ss;
    __device__ __forceinline__ void operator()(const f32x4 (&acc)[2][2][4][2], const Unit& u, int wr, int wc, int fr, int fq) const {
        const int row0 = u.pm * 256 + wr * 64 + fr;
        float rsv[8];
#pragma unroll
        for (int i = 0; i < 8; ++i) rsv[i] = ss[row0 + (i >> 2) * 128 + (i & 3) * 16];
#pragma unroll
        for (int i = 0; i < 8; ++i) rsv[i] = rsqrtf(rsv[i] * (1.0f / 1024.0f) + EPS);
#pragma unroll
        for (int ai = 0; ai < 2; ++ai)
#pragma unroll
            for (int m = 0; m < 4; ++m) {
                const int row = row0 + ai * 128 + m * 16; const float r = rsv[ai * 4 + m];
                if (u.pn < 20) {
#pragma unroll
                    for (int bj = 0; bj < 2; ++bj) { const int col = u.pn * 256 + bj * 128 + wc * 32 + 8 * fq;
                        __builtin_nontemporal_store(pack8(acc[ai][bj][m][0] * r, acc[ai][bj][m][1] * r), (u32x4*)(zx + (size_t)row * ZXW + col)); }
                } else if (wc == 0) {
                    float* d = dtraw + (size_t)row * 32 + 8 * fq;
                    *(f32x4*)d = acc[ai][0][m][0] * r; *(f32x4*)(d + 4) = acc[ai][0][m][1] * r;
                }
            }
    }
};
template <bool FINAL> struct EpiResid {
    bf16_t* hb; float* ssn; float* out;
    __device__ __forceinline__ void operator()(const f32x4 (&acc)[2][2][4][2], const Unit& u, int wr, int wc, int fr, int fq) const {
        const int row0 = u.pm * 256 + wr * 64 + fr;
#pragma unroll
        for (int ai = 0; ai < 2; ++ai)
#pragma unroll
            for (int m = 0; m < 4; ++m) {
                const int row = row0 + ai * 128 + m * 16; float s = 0.f;
                float* yrow = nullptr;
                if (FINAL) { if (row < TP) { const int b = row / LP, t = row - b * LP; if (t >= 16) yrow = out + O_YP + ((size_t)(b * 2048 + t - 16)) * DM; } else yrow = out + O_YS + (size_t)(row - TP) * DM; }
#pragma unroll
                for (int bj = 0; bj < 2; ++bj) { const int col = u.pn * 256 + bj * 128 + wc * 32 + 8 * fq;
                    bf16_t* p = hb + (size_t)row * DM + col; const u32x4 o = *(const u32x4*)p;
                    f32x4 v0 = acc[ai][bj][m][0], v1 = acc[ai][bj][m][1];
                    v0[0] += bf_lo(o.x); v0[1] += bf_hi(o.x); v0[2] += bf_lo(o.y); v0[3] += bf_hi(o.y);
                    v1[0] += bf_lo(o.z); v1[1] += bf_hi(o.z); v1[2] += bf_lo(o.w); v1[3] += bf_hi(o.w);
                    s += (v0[0] * v0[0] + v0[1] * v0[1]) + (v0[2] * v0[2] + v0[3] * v0[3]) + (v1[0] * v1[0] + v1[1] * v1[1]) + (v1[2] * v1[2] + v1[3] * v1[3]);
                    if (FINAL) { if (yrow) { *(f32x4*)(yrow + col) = v0; *(f32x4*)(yrow + col + 4) = v1; } }
                    else *(u32x4*)p = pack8(v0, v1); }
                s += __shfl_xor(s, 16); s += __shfl_xor(s, 32);
                if (fq == 0) atomicAdd(ssn + row, s);
            }
    }
};
constexpr int TAIL_ROW0 = 32768, TAIL_ROWS = T - TAIL_ROW0;
struct EpiPartial {
    float* P;
    __device__ __forceinline__ void operator()(const f32x4 (&acc)[2][2][4][2], const Unit& u, int wr, int wc, int fr, int fq) const {
        const int row0 = u.pm * 256 + wr * 64 + fr - TAIL_ROW0;
#pragma unroll
        for (int ai = 0; ai < 2; ++ai)
#pragma unroll
            for (int m = 0; m < 4; ++m) {
                float* rp = P + ((size_t)u.ks * TAIL_ROWS + row0 + ai * 128 + m * 16) * DM + u.pn * 256 + wc * 32 + 8 * fq;
#pragma unroll
                for (int bj = 0; bj < 2; ++bj) { *(f32x4*)(rp + bj * 128) = acc[ai][bj][m][0]; *(f32x4*)(rp + bj * 128 + 4) = acc[ai][bj][m][1]; }
            }
    }
};
__device__ __forceinline__ void tail_fixup(bf16_t* hb, float* ssn, const float* P, int S) {
    const int lane = threadIdx.x & 63, wave = threadIdx.x >> 6; const int gw = blockIdx.x * 8 + wave, NGW = gridDim.x * 8;
    for (int r = gw; r < TAIL_ROWS; r += NGW) {
        const int row = TAIL_ROW0 + r; f32x4 v[4];
        u32x2* hp = (u32x2*)(hb + (size_t)row * DM) + lane;
#pragma unroll
        for (int j = 0; j < 4; ++j) { const u32x2 o = hp[64 * j]; v[j] = (f32x4){bf_lo(o.x), bf_hi(o.x), bf_lo(o.y), bf_hi(o.y)}; }
        for (int s = 0; s < S; ++s) { const f32x4* pp = (const f32x4*)(P + ((size_t)s * TAIL_ROWS + r) * DM) + lane;
#pragma unroll
            for (int j = 0; j < 4; ++j) v[j] += pp[64 * j]; }
        float q = 0.f;
#pragma unroll
        for (int j = 0; j < 4; ++j) { q += (v[j][0] * v[j][0] + v[j][1] * v[j][1]) + (v[j][2] * v[j][2] + v[j][3] * v[j][3]); u32x2 w; w.x = cvt_pk_bf16(v[j][0], v[j][1]); w.y = cvt_pk_bf16(v[j][2], v[j][3]); hp[64 * j] = w; }
        q = wave_sum(q);
        if (lane == 0) ssn[row] = q;
    }
}
struct EpiSwiglu {
    bf16_t* act; const float* ss;
    __device__ __forceinline__ void operator()(const f32x4 (&acc)[2][2][4][2], const Unit& u, int wr, int wc, int fr, int fq) const {
        const int row0 = u.pm * 256 + wr * 64 + fr, col = u.pn * 128 + wc * 32 + 8 * fq;
        float rsv[8];
#pragma unroll
        for (int i = 0; i < 8; ++i) rsv[i] = ss[row0 + (i >> 2) * 128 + (i & 3) * 16];
#pragma unroll
        for (int i = 0; i < 8; ++i) rsv[i] = rsqrtf(rsv[i] * (1.0f / 1024.0f) + EPS);
#pragma unroll
        for (int ai = 0; ai < 2; ++ai)
#pragma unroll
            for (int m = 0; m < 4; ++m) {
                const int row = row0 + ai * 128 + m * 16; const float r = rsv[ai * 4 + m];
                f32x4 o[2];
#pragma unroll
                for (int n = 0; n < 2; ++n)
#pragma unroll
                    for (int j = 0; j < 4; ++j) { const float g = acc[ai][0][m][n][j] * r, uu = acc[ai][1][m][n][j] * r; o[n][j] = silu_f(g) * uu; }
                __builtin_nontemporal_store(pack8(o[0], o[1]), (u32x4*)(act + (size_t)row * DFF + col));
            }
    }
};
struct EpiKVQ {
    bf16_t *kb, *vb, *qb; const float* ss; const float* rope; float* out;
    __device__ __forceinline__ void operator()(const f32x4 (&acc)[2][2][4][2], const Unit& u, int wr, int wc, int fr, int fq) const {
        const int row0 = u.pm * 256 + wr * 64 + fr;
        const bool do_rope = (u.pn != 1) && ((wc & 1) == 0);
        float rsv[8];
#pragma unroll
        for (int i = 0; i < 8; ++i) rsv[i] = ss[row0 + (i >> 2) * 128 + (i & 3) * 16];
#pragma unroll
        for (int i = 0; i < 8; ++i) rsv[i] = rsqrtf(rsv[i] * (1.0f / 1024.0f) + EPS);
#pragma unroll
        for (int ai = 0; ai < 2; ++ai)
#pragma unroll
            for (int m = 0; m < 4; ++m) {
                const int row = row0 + ai * 128 + m * 16; const float r = rsv[ai * 4 + m];
                int b, t, pidx; long kvrow;
                if (row < TP) { b = row / LP; t = row - b * LP; pidx = t; kvrow = (t >= LP - 128) ? (long)b * 128 + (t - (LP - 128)) : -1; }
                else { const int ms = row - TP; b = ms >> 3; t = ms & 7; pidx = LP + t; kvrow = (long)b * 128 + 120 + t; }
                f32x4 cs0 = {1.f, 1.f, 1.f, 1.f}, cs1 = cs0, sn0 = {0.f, 0.f, 0.f, 0.f}, sn1 = sn0;
                if (do_rope && fq < 2) { const float* rp = rope + (size_t)pidx * 16; cs0 = *(const f32x4*)rp; cs1 = *(const f32x4*)(rp + 4); sn0 = *(const f32x4*)(rp + 8); sn1 = *(const f32x4*)(rp + 12);
                    if (fq == 0) { sn0 = -sn0; sn1 = -sn1; } }
#pragma unroll
                for (int bj = 0; bj < 2; ++bj) {
                    const int colt = bj * 128 + wc * 32 + 8 * fq;
                    f32x4 v0 = acc[ai][bj][m][0] * r, v1 = acc[ai][bj][m][1] * r;
                    if (do_rope) {
                        f32x4 p0, p1;
#pragma unroll
                        for (int j = 0; j < 4; ++j) { p0[j] = __shfl_xor(v0[j], 16); p1[j] = __shfl_xor(v1[j], 16); }
                        v0 = v0 * cs0 + p0 * sn0; v1 = v1 * cs1 + p1 * sn1;
                    }
                    const u32x4 w = pack8(v0, v1);
                    if (u.pn == 0) { *(u32x4*)(kb + (size_t)row * 256 + colt) = w;
                        if (kvrow >= 0) { float* d = out + (row < TP ? O_KP : O_KS) + (size_t)kvrow * 256 + colt; *(f32x4*)d = v0; *(f32x4*)(d + 4) = v1; } }
                    else if (u.pn == 1) { *(u32x4*)(vb + (size_t)row * 256 + colt) = w;
                        if (kvrow >= 0) { float* d = out + (row < TP ? O_VP : O_VS) + (size_t)kvrow * 256 + colt; *(f32x4*)d = v0; *(f32x4*)(d + 4) = v1; } }
                    else *(u32x4*)(qb + (size_t)row * DM + (u.pn - 2) * 256 + colt) = w;
                }
            }
    }
};

#define XB_TMO      128
#define XB_XCNT(j)  (256  + 64 * (j))
#define XB_XSUB(j)  (1280 + 64 * (j))
#define XB_XGEN(j)  (2304 + 64 * (j))
#define XB_TOP      3328
#define XB_TOPGEN   3392
#define XCD_BAR_WORDS 3456
#define XB_SPIN_CAP (1u << 18)

__device__ __forceinline__ unsigned xb_ld(unsigned* p)              { return __hip_atomic_load(p, __ATOMIC_RELAXED, __HIP_MEMORY_SCOPE_AGENT); }
__device__ __forceinline__ unsigned xb_add(unsigned* p, unsigned v) { return __hip_atomic_fetch_add(p, v, __ATOMIC_RELAXED, __HIP_MEMORY_SCOPE_AGENT); }
__device__ __forceinline__ unsigned xb_xcc_id() { return (unsigned)__builtin_amdgcn_s_getreg((3 << 11) | 20) & 0xFu; }
#define XB_SPIN(cond, bar) do { unsigned _sp = 0; while (cond) { __builtin_amdgcn_s_sleep(1); \
    if ((++_sp & 255u) == 0u) { if (xb_ld(&(bar)[XB_TMO])) break; if (_sp > XB_SPIN_CAP) { atomicAdd(&(bar)[XB_TMO], 1u); break; } } } } while (0)

struct XcdBarrier {
    unsigned* bar; unsigned x;
    volatile LAS unsigned* st;
};

__device__ __forceinline__ XcdBarrier xcd_barrier_post(unsigned* bar, volatile LAS unsigned* st) {
    XcdBarrier b; b.bar = bar; b.x = xb_xcc_id(); b.st = st;
    if (threadIdx.x == 0) (void)xb_add(&bar[XB_XCNT(b.x)], 1u);
    return b;
}
__device__ __forceinline__ void xcd_barrier_complete(unsigned* bar, unsigned x, unsigned& nloc, unsigned& nx) {
    const unsigned G = gridDim.x * gridDim.y * gridDim.z;
    unsigned sum, cnt, mine, sp = 0u;
    for (;;) {
        sum = 0u; cnt = 0u; mine = 0u;
#pragma unroll
        for (unsigned j = 0; j < 16; ++j) { const unsigned c = xb_ld(&bar[XB_XCNT(j)]); sum += c; cnt += (c > 0u) ? 1u : 0u; mine = (j == x) ? c : mine; }
        if (sum == G) break;
        __builtin_amdgcn_s_sleep(1);
        if ((++sp & 255u) == 0u) { if (xb_ld(&bar[XB_TMO])) break; if (sp > XB_SPIN_CAP) { atomicAdd(&bar[XB_TMO], 1u); break; } }
    }
    nloc = mine > 0u ? mine : 1u; nx = cnt > 0u ? cnt : 1u;
}

__device__ __forceinline__ void xcd_barrier(const XcdBarrier& b) {
    asm volatile("s_waitcnt vmcnt(0)" ::: "memory");
    __syncthreads();
    if (threadIdx.x == 0) {
        unsigned* bar = b.bar;
        __builtin_amdgcn_s_waitcnt(0);
        unsigned nloc = b.st[0], nx = b.st[1];
        if (nloc == 0u) { xcd_barrier_complete(bar, b.x, nloc, nx); b.st[0] = nloc; b.st[1] = nx; }
        const unsigned old = xb_add(&bar[XB_XSUB(b.x)], 1u);
        const unsigned gen = old / nloc;
        if (old + 1u == (gen + 1u) * nloc) {
            __builtin_amdgcn_fence(__ATOMIC_RELEASE, "agent");
            asm volatile("s_waitcnt vmcnt(0)" ::: "memory");
            const unsigned og = xb_add(&bar[XB_TOP], 1u);
            const unsigned tg = og / nx;
            if (og + 1u == (tg + 1u) * nx) xb_add(&bar[XB_TOPGEN], 1u);
            else XB_SPIN(xb_ld(&bar[XB_TOPGEN]) == tg, bar);
            __builtin_amdgcn_fence(__ATOMIC_ACQUIRE, "agent");
            xb_add(&bar[XB_XGEN(b.x)], 1u);
            asm volatile("s_waitcnt vmcnt(0)" ::: "memory");
        } else {
            XB_SPIN(xb_ld(&bar[XB_XGEN(b.x)]) == gen, bar);
            __builtin_amdgcn_fence(__ATOMIC_ACQUIRE, "agent");
            asm volatile("s_waitcnt vmcnt(0)" ::: "memory");
        }
    }
    __syncthreads();
}

struct Args { const float* in[28]; float* out; unsigned char* ws; int lo, hi; };
enum { I_XP = 0, I_XS, I_SSSM, I_SCONV, I_SK, I_SV, I_META, I_SSMG, I_WIN, I_CONVW, I_CONVB, I_DTB, I_ALOG, I_DSKIP, I_GATEG, I_WOUT, I_KVG, I_WK, I_WV,
       I_ATTNG, I_WQ, I_SINKS, I_WOP, I_FFNG, I_WGATE, I_WUP, I_WDOWN, I_FING };

__device__ __forceinline__ void p0_item(const float* W, int ld, int col0, const float* g, float sc, bf16_t* WT, int K, int drow0, int k0, LAS float* scr, int lane) {
    const int kk = lane >> 3, n4 = (lane & 7) * 4;
    f32x4 v[8];
#pragma unroll
    for (int i = 0; i < 8; ++i) { v[i] = (f32x4){0.f, 0.f, 0.f, 0.f};
        if (W) v[i] = __builtin_nontemporal_load((const f32x4*)(W + (size_t)(k0 + 8 * i + kk) * ld + col0 + n4)) * ((g ? g[k0 + 8 * i + kk] : 1.0f) * sc); }
#pragma unroll
    for (int i = 0; i < 8; ++i) { LAS float* d = scr + (8 * i + kk) * 33 + n4; d[0] = v[i][0]; d[1] = v[i][1]; d[2] = v[i][2]; d[3] = v[i][3]; }
    asm volatile("s_waitcnt lgkmcnt(0)" ::: "memory");
    const int c = lane & 7;
#pragma unroll
    for (int j = 0; j < 4; ++j) { const int n = (lane >> 3) + 8 * j; const LAS float* s = scr + (8 * c) * 33 + n;
        u32x4 o; o.x = cvt_pk_bf16(s[0], s[33]); o.y = cvt_pk_bf16(s[66], s[99]); o.z = cvt_pk_bf16(s[132], s[165]); o.w = cvt_pk_bf16(s[198], s[231]);
        *(u32x4*)(WT + (size_t)(drow0 + n) * K + k0 + 8 * c) = o; }
    asm volatile("s_waitcnt lgkmcnt(0)" ::: "memory");
}
__device__ __forceinline__ const float* src_row(const Args& a, int m) {
    if (m < TP) { const int b = m / LP, t = m - b * LP; return t < 16 ? a.in[I_META] + (size_t)t * DM : a.in[I_XP] + ((size_t)b * 2048 + (t - 16)) * DM; }
    return a.in[I_XS] + (size_t)(m - TP) * DM;
}
__device__ __forceinline__ void p0_prologue(const Args& a, LAS unsigned char* lds) {
    const int tid = threadIdx.x, lane = tid & 63, wave = __builtin_amdgcn_readfirstlane(tid >> 6);
    const int gw = blockIdx.x * 8 + wave, NGW = gridDim.x * 8;
    unsigned char* ws = a.ws;
    LAS float* scr = (LAS float*)(lds + wave * 8704);
    constexpr int N0 = (NIN / 32) * 16, N1 = 32 * 32, N2 = 176 * 16, N3 = N2, N4 = 32 * 44, N5 = N4, N6 = 48 * 16, N7 = 32 * 16;
    constexpr int NITEMS = N0 + N1 + N2 + N3 + N4 + N5 + N6 + N7;
    for (int it = gw; it < NITEMS; it += NGW) {
        int r = it;
        if (r < N0) { const int nb = r / 16, kb = r % 16; const bool real = nb * 32 < 5152;
            p0_item(real ? a.in[I_WIN] : nullptr, 5152, nb * 32, a.in[I_SSMG], 1.f, (bf16_t*)(ws + WS_WIN), 1024, nb * 32, kb * 64, scr, lane); continue; } r -= N0;
        if (r < N1) { const int nb = r / 32, kb = r % 32;
            p0_item(a.in[I_WOUT], 1024, nb * 32, a.in[I_GATEG], 1.f, (bf16_t*)(ws + WS_WOUT), 2048, nb * 32, kb * 64, scr, lane); continue; } r -= N1;
        if (r < N2 + N3) { const int layer = r >= N2; if (layer) r -= N2; const int nb = r / 16, kb = r % 16, tile = nb >> 3, w = nb & 7;
            const float* src = (w < 4 ? a.in[I_WGATE] : a.in[I_WUP]) + (size_t)layer * 1024 * DFF;
            p0_item(src, DFF, tile * 128 + (w & 3) * 32, a.in[I_FFNG] + layer * 1024, 1.f, (bf16_t*)(ws + (layer ? WS_WGU1 : WS_WGU0)), 1024, nb * 32, kb * 64, scr, lane); continue; } r -= N2 + N3;
        if (r < N4 + N5) { const int layer = r >= N4; if (layer) r -= N4; const int nb = r / 44, kb = r % 44;
            p0_item(a.in[I_WDOWN] + (size_t)layer * DFF * 1024, 1024, nb * 32, nullptr, 1.f, (bf16_t*)(ws + (layer ? WS_WD1 : WS_WD0)), DFF, nb * 32, kb * 64, scr, lane); continue; } r -= N4 + N5;
        if (r < N6) { const int nb = r / 16, kb = r % 16;
            if (nb < 8) p0_item(a.in[I_WK], 256, nb * 32, a.in[I_KVG], 1.f, (bf16_t*)(ws + WS_WKVQ), 1024, nb * 32, kb * 64, scr, lane);
            else if (nb < 16) p0_item(a.in[I_WV], 256, (nb - 8) * 32, a.in[I_KVG], 1.f, (bf16_t*)(ws + WS_WKVQ), 1024, nb * 32, kb * 64, scr, lane);
            else p0_item(a.in[I_WQ], 1024, (nb - 16) * 32, a.in[I_ATTNG], 0.125f, (bf16_t*)(ws + WS_WKVQ), 1024, nb * 32, kb * 64, scr, lane);
            continue; } r -= N6;
        { const int nb = r / 16, kb = r % 16; p0_item(a.in[I_WOP], 1024, nb * 32, nullptr, 1.f, (bf16_t*)(ws + WS_WO), 1024, nb * 32, kb * 64, scr, lane); }
    }
    float* ss = (float*)(ws + WS_SS);
    bf16_t* hb = (bf16_t*)(ws + WS_HB);
    for (int m0 = gw; m0 < T; m0 += 2 * NGW) {
        const int m1 = m0 + NGW < T ? m0 + NGW : m0;
        const f32x4* xa = (const f32x4*)src_row(a, m0) + lane; const f32x4* xb = (const f32x4*)src_row(a, m1) + lane; f32x4 va[4], vb[4]; float sa = 0.f, sb = 0.f;
#pragma unroll
        for (int j = 0; j < 4; ++j) { va[j] = __builtin_nontemporal_load(xa + 64 * j); vb[j] = __builtin_nontemporal_load(xb + 64 * j); }
#pragma unroll
        for (int j = 0; j < 4; ++j) { sa += (va[j][0] * va[j][0] + va[j][1] * va[j][1]) + (va[j][2] * va[j][2] + va[j][3] * va[j][3]); sb += (vb[j][0] * vb[j][0] + vb[j][1] * vb[j][1]) + (vb[j][2] * vb[j][2] + vb[j][3] * vb[j][3]); }
        sa = wave_sum(sa); sb = wave_sum(sb);
        u32x2* oa = (u32x2*)(hb + (size_t)m0 * DM) + lane; u32x2* ob = (u32x2*)(hb + (size_t)m1 * DM) + lane;
#pragma unroll
        for (int j = 0; j < 4; ++j) { u32x2 w; w.x = cvt_pk_bf16(va[j][0], va[j][1]); w.y = cvt_pk_bf16(va[j][2], va[j][3]); oa[64 * j] = w; w.x = cvt_pk_bf16(vb[j][0], vb[j][1]); w.y = cvt_pk_bf16(vb[j][2], vb[j][3]); ob[64 * j] = w; }
        if (lane == 0) { ss[m0] = sa; ss[T + m0] = 0.f; ss[2 * T + m0] = 0.f; ss[3 * T + m0] = 0.f; ss[4 * T + m0] = 0.f; ss[m1] = sb; ss[T + m1] = 0.f; ss[2 * T + m1] = 0.f; ss[3 * T + m1] = 0.f; ss[4 * T + m1] = 0.f; }
    }
    float* rope = (float*)(ws + WS_ROPE);
    for (int e = blockIdx.x * 512 + tid; e < 2072 * 8; e += gridDim.x * 512) {
        const int pi = e >> 3, i = e & 7; const double pos = (double)(pi < LP ? pi : 16384 + pi - LP);
        const double inv = i == 0 ? 1.0 : i == 1 ? 0.19392274474868576 : i == 2 ? 0.03760603093086393 : i == 3 ? 0.007292664737217109 : i == 4 ? 0.001414213562373095
                         : i == 5 ? 0.0002742481756762073 : i == 6 ? 5.318295896944988e-05 : 1.031338537721246e-05;
        const double rev = pos * inv * 0.15915494309189535; const float fr = (float)(rev - __builtin_rint(rev));
        rope[pi * 16 + i] = __builtin_amdgcn_cosf(fr); rope[pi * 16 + 8 + i] = __builtin_amdgcn_sinf(fr);
    }
}

__device__ __forceinline__ void conv8(const u32x4 (&cur)[4], const float (&w)[4][8], const float (&bias)[8], const bool (&zero)[4], float (&o)[8]) {
#pragma unroll
    for (int e = 0; e < 8; ++e) o[e] = bias[e];
#pragma unroll
    for (int k = 0; k < 4; ++k) {
        const unsigned wd[4] = {cur[k].x, cur[k].y, cur[k].z, cur[k].w};
#pragma unroll
        for (int e = 0; e < 8; ++e) { const float v = (e & 1) ? bf_hi(wd[e >> 1]) : bf_lo(wd[e >> 1]); o[e] += zero[k] ? 0.f : w[k][e] * v; }
    }
#pragma unroll
    for (int e = 0; e < 8; ++e) o[e] = silu_f(o[e]);
}
__device__ __forceinline__ void conv_phase(const Args& a, LAS unsigned char* lds) {
    const int tid = threadIdx.x, r = tid >> 3, ch = tid & 7;
    bf16_t* zx = (bf16_t*)(a.ws + WS_BIG);
    const int NPT = NBATCH * 48, NST = 16 * 48;
    for (int task = blockIdx.x; task < NPT + NST; task += gridDim.x) {
        const bool samp = task >= NPT; const int tt = samp ? task - NPT : task; const int cb = tt % 48, bb = tt / 48;
        const int col = cb * 64 + 8 * ch;
        float w[4][8], bias[8];
#pragma unroll
        for (int k = 0; k < 4; ++k) { const f32x4 w0 = *(const f32x4*)(a.in[I_CONVW] + k * CONVD + col), w1 = *(const f32x4*)(a.in[I_CONVW] + k * CONVD + col + 4);
#pragma unroll
            for (int e = 0; e < 4; ++e) { w[k][e] = w0[e]; w[k][4 + e] = w1[e]; } }
        { const f32x4 b0 = *(const f32x4*)(a.in[I_CONVB] + col), b1 = *(const f32x4*)(a.in[I_CONVB] + col + 4);
#pragma unroll
            for (int e = 0; e < 4; ++e) { bias[e] = b0[e]; bias[4 + e] = b1[e]; } }
        if (!samp) {
            const size_t rowb = (size_t)bb * LP; bf16_t* base = zx + 2048 + col;
            float* ncv = a.out + O_CONVP + (size_t)bb * 3 * CONVD + col;
            u32x4 own[2], halo = {0u, 0u, 0u, 0u};
#define CONV_LOAD(t0) do { _Pragma("unroll") for (int q = 0; q < 2; ++q) { int tg = (t0) + r + 64 * q; tg = tg >= LP ? LP - 1 : tg; own[q] = __builtin_nontemporal_load((const u32x4*)(base + (rowb + tg) * ZXW)); } \
                if (tid < 24) { const int th = (t0) - 3 + (tid >> 3); if (th >= 0) halo = *(const u32x4*)(base + (rowb + th) * ZXW); else halo = (u32x4){0u, 0u, 0u, 0u}; } } while (0)
            CONV_LOAD(2048);
            for (int kt = 0; kt < 17; ++kt) {
                const int t0 = 2048 - 128 * kt;
                LAS unsigned char* tile = lds + (kt & 1) * (131 * 128);
#pragma unroll
                for (int q = 0; q < 2; ++q) *(LAS u32x4*)(tile + (3 + r + 64 * q) * 128 + ch * 16) = own[q];
                if (tid < 24) *(LAS u32x4*)(tile + (tid >> 3) * 128 + ch * 16) = halo;
                const u32x4 raw[2] = {own[0], own[1]};
                if (kt + 1 < 17) CONV_LOAD(t0 - 128);
                asm volatile("s_waitcnt lgkmcnt(0)" ::: "memory"); __builtin_amdgcn_s_barrier(); asm volatile("" ::: "memory");
#pragma unroll
                for (int q = 0; q < 2; ++q) {
                    const int t = t0 + r + 64 * q;
                    u32x4 cur[4];
#pragma unroll
                    for (int k = 0; k < 4; ++k) cur[k] = *(const LAS u32x4*)(tile + (r + 64 * q + k) * 128 + ch * 16);
                    const bool zero[4] = {false, false, false, false};
                    float o[8]; conv8(cur, w, bias, zero, o);
                    if (t < LP) {
                        __builtin_nontemporal_store(((u32x4){cvt_pk_bf16(o[0], o[1]), cvt_pk_bf16(o[2], o[3]), cvt_pk_bf16(o[4], o[5]), cvt_pk_bf16(o[6], o[7])}), (u32x4*)(base + (rowb + t) * ZXW));
                        if (t >= LP - 3) { float* d = ncv + (size_t)(t - (LP - 3)) * CONVD;
                            *(f32x4*)d = (f32x4){bf_lo(raw[q].x), bf_hi(raw[q].x), bf_lo(raw[q].y), bf_hi(raw[q].y)}; *(f32x4*)(d + 4) = (f32x4){bf_lo(raw[q].z), bf_hi(raw[q].z), bf_lo(raw[q].w), bf_hi(raw[q].w)}; }
                    }
                }
            }
#undef CONV_LOAD
        } else {
            const int b = bb * 8 + (r >> 3), t = r & 7; const size_t row = (size_t)TP + b * 8 + t; bf16_t* base = zx + 2048 + col;
            u32x4 cur[4];
#pragma unroll
            for (int k = 0; k < 4; ++k) { const int tk = t - 3 + k;
                if (tk >= 0) cur[k] = *(const u32x4*)(base + (row - 3 + k) * ZXW);
                else { const float* sc = a.in[I_SCONV] + ((size_t)b * 3 + (3 + tk)) * CONVD + col; const f32x4 s0 = *(const f32x4*)sc, s1 = *(const f32x4*)(sc + 4); cur[k] = pack8(s0, s1); } }
            const bool zero[4] = {false, false, false, false};
            float o[8]; conv8(cur, w, bias, zero, o);
            const u32x4 raw = cur[3];
            __syncthreads();
            *(u32x4*)(base + row * ZXW) = (u32x4){cvt_pk_bf16(o[0], o[1]), cvt_pk_bf16(o[2], o[3]), cvt_pk_bf16(o[4], o[5]), cvt_pk_bf16(o[6], o[7])};
            if (t >= 5) { float* d = a.out + O_CONVS + ((size_t)b * 3 + (t - 5)) * CONVD + col;
                *(f32x4*)d = (f32x4){bf_lo(raw.x), bf_hi(raw.x), bf_lo(raw.y), bf_hi(raw.y)}; *(f32x4*)(d + 4) = (f32x4){bf_lo(raw.z), bf_hi(raw.z), bf_lo(raw.w), bf_hi(raw.w)}; }
        }
        __syncthreads();
    }
}

#define WG_BAR() do { asm volatile("s_waitcnt lgkmcnt(0)" ::: "memory"); __builtin_amdgcn_s_barrier(); asm volatile("" ::: "memory"); } while (0)
constexpr int L_CM = 0, L_BM = 8704, L_XN = 17408, L_XD = 26112, L_XW = 34816, L_ZN = 43520, L_UN = 52224, L_SET = 61440, L_DTB = 2 * L_SET;
typedef short s16x4 __attribute__((ext_vector_type(4)));
__device__ __forceinline__ bf16x8 tr8(const LAS unsigned char* p0, const LAS unsigned char* p1) {
    const s16x4 a = __builtin_amdgcn_ds_read_tr16_b64_v4i16((LAS s16x4*)p0), b = __builtin_amdgcn_ds_read_tr16_b64_v4i16((LAS s16x4*)p1);
    return (bf16x8){a[0], a[1], a[2], a[3], b[0], b[1], b[2], b[3]};
}
template <bool DUMMY> __device__ __forceinline__ void ssd_phase(const Args& a, LAS unsigned char* lds) {
    const int tid = threadIdx.x, lane = tid & 63, wave = __builtin_amdgcn_readfirstlane(tid >> 6), fr = lane & 15, fq = lane >> 4;
    bf16_t* zx = (bf16_t*)(a.ws + WS_BIG);
    const float* dtraw = (const float*)(a.ws + WS_DT);
    const bool loader = wave >= 4;
    const int NUNITS = 256 + 2048;
    for (int unit = blockIdx.x; unit < NUNITS; unit += gridDim.x) {
        const bool samp = unit >= 256; int b, g, hp;
        if (!samp) { b = unit >> 4; g = (unit >> 2) & 3; hp = unit & 3; } else { const int u2 = unit - 256; b = u2 >> 4; g = (u2 >> 2) & 3; hp = u2 & 3; }
        const int row0 = samp ? TP + b * 8 : b * LP, L = samp ? 8 : LP, nch = samp ? 1 : 65, h0 = g * 8 + hp * 2;
        const int ltid = tid & 255, t1 = ltid >> 4, ch1 = ltid & 15;
        const int xcol = 2048 + h0 * 64 + 8 * ch1, bcol = 2048 + 2048 + g * 128 + 8 * ch1, ccol = 2048 + 2560 + g * 128 + 8 * ch1, zcol1 = h0 * 64 + 8 * ch1;
        const int dth = lane >> 5;
        const float dtbias = (wave == 7) ? a.in[I_DTB][h0 + dth] : 0.f, negA = (wave == 7) ? -__expf(a.in[I_ALOG][h0 + dth]) : 0.f;
        const int hh = (wave >> 1) & 1, ph = wave & 1, h = h0 + hh, pcol = hh * 64 + ph * 32;
        const float dskip = a.in[I_DSKIP][h];
        f32x4 st[2][8];
#pragma unroll
        for (int pt = 0; pt < 2; ++pt)
#pragma unroll
            for (int nt = 0; nt < 8; ++nt) st[pt][nt] = (f32x4){0.f, 0.f, 0.f, 0.f};
        if (samp && !loader) {
#pragma unroll
            for (int pt = 0; pt < 2; ++pt) { const float* sp = a.in[I_SSSM] + ((size_t)(b * NH + h) * 64 + ph * 32 + pt * 16 + fr) * 128 + 4 * fq;
#pragma unroll
                for (int nt = 0; nt < 8; ++nt) st[pt][nt] = *(const f32x4*)(sp + 16 * nt); } }
        u32x4 xg[2], bg[2], cg[2], zg[2];
        float dtr = 0.f;
#define SSD_FETCH(c) do { if (loader) { int t_o = t1; asm volatile("" : "+v"(t_o)); _Pragma("unroll") for (int q = 0; q < 2; ++q) { int tg = 32 * (c) + t_o + 16 * q; tg = tg >= L ? L - 1 : tg; const bf16_t* rp = zx + (size_t)(row0 + tg) * ZXW; \
            xg[q] = *(const u32x4*)(rp + xcol); bg[q] = *(const u32x4*)(rp + bcol); cg[q] = *(const u32x4*)(rp + ccol); zg[q] = *(const u32x4*)(rp + zcol1); } } } while (0)
#define SSD_DTLOAD(c) do { if (wave == 7) { int tg = 32 * (c) + (lane & 31); tg = tg >= L ? L - 1 : tg; dtr = dtraw[(size_t)(row0 + tg) * 32 + h0 + dth]; } } while (0)
#define SSD_DT(c) do { if (wave == 7) { const int tg = 32 * (c) + (lane & 31); float dt = 0.f; \
            if (tg < L) { const float x = dtr + dtbias; dt = fmaxf(x, 0.f) + __logf(1.0f + __expf(-fabsf(x))); } \
            float cs = dt * negA; \
            _Pragma("unroll") for (int o = 1; o < 32; o <<= 1) { const float up = __shfl_up(cs, o); if ((lane & 31) >= o) cs += up; } \
            const float cl = __shfl(cs, (lane & 32) | 31); \
            LAS float* d = (LAS float*)(lds + L_DTB) + (((c) % 3) * 2 + dth) * 96; d[lane & 31] = cs; d[32 + (lane & 31)] = dt; d[64 + (lane & 31)] = __expf(cl - cs); } } while (0)
#define SSD_STAGE1(cc) do { if (loader) { LAS unsigned char* ts1 = lds + ((cc) & 1) * L_SET; \
            const LAS float* dtb = (const LAS float*)(lds + L_DTB) + (((cc) % 3) * 2 + (ch1 >> 3)) * 96; \
            _Pragma("unroll") for (int q = 0; q < 2; ++q) { const int tq = t1 + 16 * q; \
                const bool valid = 32 * (cc) + tq < L; \
                const float dt = dtb[32 + tq], dw = dt * dtb[64 + tq]; \
                const u32x4 z4 = {0u, 0u, 0u, 0u}; \
                const u32x4 xv = valid ? xg[q] : z4; \
                const unsigned xw4[4] = {xv.x, xv.y, xv.z, xv.w}; \
                unsigned od[4], ow[4]; \
                _Pragma("unroll") for (int e = 0; e < 4; ++e) { const float lo = bf_lo(xw4[e]), hi = bf_hi(xw4[e]); od[e] = cvt_pk_bf16(lo * dt, hi * dt); ow[e] = cvt_pk_bf16(lo * dw, hi * dw); } \
                const int lo_ = tq * 272 + ch1 * 16; \
                *(LAS u32x4*)(ts1 + L_CM + lo_) = valid ? cg[q] : z4; \
                *(LAS u32x4*)(ts1 + L_BM + lo_) = valid ? bg[q] : z4; \
                *(LAS u32x4*)(ts1 + L_XN + lo_) = xv; \
                *(LAS u32x4*)(ts1 + L_XD + lo_) = (u32x4){od[0], od[1], od[2], od[3]}; \
                *(LAS u32x4*)(ts1 + L_XW + lo_) = (u32x4){ow[0], ow[1], ow[2], ow[3]}; \
                *(LAS u32x4*)(ts1 + L_ZN + lo_) = zg[q]; } } } while (0)
#define SSD_USTORE(cc) do { if (loader && !DUMMY) { _Pragma("unroll") for (int q = 0; q < 2; ++q) { const int tg = 32 * (cc) + t1 + 16 * q; \
            if (tg < L) *(u32x4*)(zx + (size_t)(row0 + tg) * ZXW + zcol1) = *(const LAS u32x4*)(lds + ((cc) & 1) * L_SET + L_UN + (t1 + 16 * q) * 272 + ch1 * 16); } } } while (0)
        SSD_FETCH(0); SSD_DTLOAD(0);
        __syncthreads();
        SSD_DT(0); if (nch > 1) SSD_DTLOAD(1);
        WG_BAR();
        SSD_STAGE1(0);
        if (nch > 1) { SSD_FETCH(1); SSD_DT(1); if (nch > 2) SSD_DTLOAD(2); }
        WG_BAR();
        for (int c = 0; c < nch; ++c) {
            if (loader) {
                if (c > 0) SSD_USTORE(c - 1);
                if (c + 1 < nch) {
                    SSD_STAGE1(c + 1);
                    if (c + 2 < nch) { SSD_FETCH(c + 2); SSD_DT(c + 2); if (c + 3 < nch) SSD_DTLOAD(c + 3); }
                }
            } else {
                LAS unsigned char* tsm = lds + (c & 1) * L_SET;
                const LAS float* dcs = (const LAS float*)(lds + L_DTB) + ((c % 3) * 2 + hh) * 96;
                f32x4 g00 = {0.f, 0.f, 0.f, 0.f}, g01 = g00, g11 = g00;
#pragma unroll
                for (int sl = 0; sl < 4; ++sl) {
                    const bf16x8 b0 = *(const LAS bf16x8*)(tsm + L_BM + fr * 272 + sl * 64 + fq * 16), b1 = *(const LAS bf16x8*)(tsm + L_BM + (16 + fr) * 272 + sl * 64 + fq * 16);
                    const bf16x8 c0 = *(const LAS bf16x8*)(tsm + L_CM + fr * 272 + sl * 64 + fq * 16), c1 = *(const LAS bf16x8*)(tsm + L_CM + (16 + fr) * 272 + sl * 64 + fq * 16);
                    g00 = __builtin_amdgcn_mfma_f32_16x16x32_bf16(b0, c0, g00, 0, 0, 0);
                    g01 = __builtin_amdgcn_mfma_f32_16x16x32_bf16(b0, c1, g01, 0, 0, 0);
                    g11 = __builtin_amdgcn_mfma_f32_16x16x32_bf16(b1, c1, g11, 0, 0, 0);
                }
                f32x4 yo[2][2];
#pragma unroll
                for (int pt = 0; pt < 2; ++pt) { yo[pt][0] = (f32x4){0.f, 0.f, 0.f, 0.f}; yo[pt][1] = yo[pt][0]; }
#pragma unroll
                for (int sl = 0; sl < 4; ++sl) {
                    bf16x8 av[2];
#pragma unroll
                    for (int tt = 0; tt < 2; ++tt) { const LAS unsigned char* cp = tsm + L_CM + (16 * tt + fr) * 272 + sl * 64 + fq * 8;
                        const u32x2 lo = *(const LAS u32x2*)cp, hi = *(const LAS u32x2*)(cp + 32); av[tt] = __builtin_bit_cast(bf16x8, ((u32x4){lo.x, lo.y, hi.x, hi.y})); }
#pragma unroll
                    for (int pt = 0; pt < 2; ++pt) {
                        u32x4 sb; sb.x = cvt_pk_bf16(st[pt][2 * sl][0], st[pt][2 * sl][1]); sb.y = cvt_pk_bf16(st[pt][2 * sl][2], st[pt][2 * sl][3]); sb.z = cvt_pk_bf16(st[pt][2 * sl + 1][0], st[pt][2 * sl + 1][1]); sb.w = cvt_pk_bf16(st[pt][2 * sl + 1][2], st[pt][2 * sl + 1][3]);
                        const bf16x8 sbv = __builtin_bit_cast(bf16x8, sb);
                        yo[pt][0] = __builtin_amdgcn_mfma_f32_16x16x32_bf16(av[0], sbv, yo[pt][0], 0, 0, 0);
                        yo[pt][1] = __builtin_amdgcn_mfma_f32_16x16x32_bf16(av[1], sbv, yo[pt][1], 0, 0, 0);
                    }
                }
                const f32x4 cslo = *(const LAS f32x4*)(dcs + 4 * fq), cshi = *(const LAS f32x4*)(dcs + 16 + 4 * fq);
                const float cst0 = dcs[fr], cst1 = dcs[16 + fr];
                float m0[4], m1a[4], m1b[4];
#pragma unroll
                for (int j = 0; j < 4; ++j) {
                    const int s = 4 * fq + j;
                    m0[j] = (s <= fr) ? g00[j] * __expf(cst0 - cslo[j]) : 0.f;
                    m1a[j] = g01[j] * __expf(cst1 - cslo[j]);
                    m1b[j] = (s <= fr) ? g11[j] * __expf(cst1 - cshi[j]) : 0.f;
                }
                const bf16x8 md0 = __builtin_bit_cast(bf16x8, ((u32x4){cvt_pk_bf16(m0[0], m0[1]), cvt_pk_bf16(m0[2], m0[3]), 0u, 0u}));
                const bf16x8 md1 = __builtin_bit_cast(bf16x8, ((u32x4){cvt_pk_bf16(m1a[0], m1a[1]), cvt_pk_bf16(m1a[2], m1a[3]), cvt_pk_bf16(m1b[0], m1b[1]), cvt_pk_bf16(m1b[2], m1b[3])}));
                const float dch = __expf(dcs[31]);
                const int btoff = (8 * fq + (fr >> 2)) * 272 + (4 * (fr & 3)) * 2;
#pragma unroll
                for (int pt = 0; pt < 2; ++pt) {
                    const int troff = (fr >> 2) * 272 + (pcol + 16 * pt + 4 * (fr & 3)) * 2;
                    const bf16x8 xdv = tr8(tsm + L_XD + (4 * fq) * 272 + troff, tsm + L_XD + (16 + 4 * fq) * 272 + troff);
                    f32x4 yd[2];
                    yd[0] = __builtin_amdgcn_mfma_f32_16x16x32_bf16(md0, xdv, ((f32x4){0.f, 0.f, 0.f, 0.f}), 0, 0, 0);
                    yd[1] = __builtin_amdgcn_mfma_f32_16x16x32_bf16(md1, xdv, ((f32x4){0.f, 0.f, 0.f, 0.f}), 0, 0, 0);
#pragma unroll
                    for (int tt = 0; tt < 2; ++tt) {
                        const f32x4 cst = *(const LAS f32x4*)(dcs + 16 * tt + 4 * fq);
                        const s16x4 xs4 = __builtin_amdgcn_ds_read_tr16_b64_v4i16((LAS s16x4*)(tsm + L_XN + (16 * tt + 4 * fq) * 272 + troff));
                        const s16x4 zs4 = __builtin_amdgcn_ds_read_tr16_b64_v4i16((LAS s16x4*)(tsm + L_ZN + (16 * tt + 4 * fq) * 272 + troff));
#pragma unroll
                        for (int j = 0; j < 4; ++j) {
                            const float y = __expf(cst[j]) * yo[pt][tt][j] + yd[tt][j] + dskip * bf1((unsigned short)xs4[j]);
                            const float z = bf1((unsigned short)zs4[j]);
                            *(LAS unsigned short*)(tsm + L_UN + (16 * tt + 4 * fq + j) * 272 + (pcol + 16 * pt + fr) * 2) = (unsigned short)(cvt_pk_bf16(y * silu_f(z), 0.f) & 0xffffu);
                        }
                    }
                }
                bf16x8 xwv[2];
#pragma unroll
                for (int pt = 0; pt < 2; ++pt) { const int troff = (fr >> 2) * 272 + (pcol + 16 * pt + 4 * (fr & 3)) * 2; xwv[pt] = tr8(tsm + L_XW + (8 * fq) * 272 + troff, tsm + L_XW + (8 * fq + 4) * 272 + troff); }
#pragma unroll
                for (int nt = 0; nt < 8; ++nt) {
                    const bf16x8 btv = tr8(tsm + L_BM + btoff + nt * 32, tsm + L_BM + btoff + 4 * 272 + nt * 32);
                    st[0][nt] = __builtin_amdgcn_mfma_f32_16x16x32_bf16(btv, xwv[0], st[0][nt] * dch, 0, 0, 0);
                    st[1][nt] = __builtin_amdgcn_mfma_f32_16x16x32_bf16(btv, xwv[1], st[1][nt] * dch, 0, 0, 0);
                }
            }
            WG_BAR();
        }
        SSD_USTORE(nch - 1);
        if (!loader) {
#pragma unroll
            for (int pt = 0; pt < 2; ++pt) { float* sp = a.out + (samp ? O_SSMS : O_SSMP) + ((size_t)(b * NH + h) * 64 + ph * 32 + pt * 16 + fr) * 128 + 4 * fq;
#pragma unroll
                for (int nt = 0; nt < 8; ++nt) *(f32x4*)(sp + 16 * nt) = st[pt][nt]; } }
#undef SSD_FETCH
#undef SSD_DT
#undef SSD_DTLOAD
#undef SSD_STAGE1
#undef SSD_USTORE
    }
}

__device__ __forceinline__ void gatenorm_phase(const Args& a) {
    const int lane = threadIdx.x & 63, wave = threadIdx.x >> 6; const int gw = blockIdx.x * 8 + wave, NGW = gridDim.x * 8;
    bf16_t* zx = (bf16_t*)(a.ws + WS_BIG);
    for (int m0 = gw; m0 < T; m0 += 2 * NGW) {
        const int m1 = m0 + NGW < T ? m0 + NGW : m0;
        u32x4* p[2] = {(u32x4*)(zx + (size_t)m0 * ZXW) + lane, (u32x4*)(zx + (size_t)m1 * ZXW) + lane}; u32x4 v[2][4];
#pragma unroll
        for (int q = 0; q < 2; ++q)
#pragma unroll
            for (int i = 0; i < 4; ++i) v[q][i] = __builtin_nontemporal_load(p[q] + 64 * i);
#pragma unroll
        for (int q = 0; q < 2; ++q)
#pragma unroll
            for (int i = 0; i < 4; ++i) {
                float f[8] = {bf_lo(v[q][i].x), bf_hi(v[q][i].x), bf_lo(v[q][i].y), bf_hi(v[q][i].y), bf_lo(v[q][i].z), bf_hi(v[q][i].z), bf_lo(v[q][i].w), bf_hi(v[q][i].w)};
                float s = 0.f;
#pragma unroll
                for (int e = 0; e < 8; ++e) s += f[e] * f[e];
                s = wave_sum(s); const float r = rsqrtf(s * (1.0f / 512.0f) + EPS);
                u32x4 o; o.x = cvt_pk_bf16(f[0] * r, f[1] * r); o.y = cvt_pk_bf16(f[2] * r, f[3] * r); o.z = cvt_pk_bf16(f[4] * r, f[5] * r); o.w = cvt_pk_bf16(f[6] * r, f[7] * r);
                if (q == 0 || m1 != m0) p[q][64 * i] = o;
            }
    }
}

constexpr int A_KS = 0, A_VS = 39168;
__device__ __forceinline__ void attn_phase(const Args& a, LAS unsigned char* lds) {
    const int tid = threadIdx.x, lane = tid & 63, wave = __builtin_amdgcn_readfirstlane(tid >> 6), fr = lane & 15, fq = lane >> 4;
    const bf16_t* qb = (const bf16_t*)(a.ws + WS_Q); const bf16_t* kb = (const bf16_t*)(a.ws + WS_K); const bf16_t* vb = (const bf16_t*)(a.ws + WS_V);
    bf16_t* ob = (bf16_t*)(a.ws + WS_O);
    const int NPU = NBATCH * 17 * 4, NUNITS = NPU + DECB * 4;
    for (int unit = blockIdx.x; unit < NUNITS; unit += gridDim.x) {
        const bool samp = unit >= NPU; int b, nblk, g;
        if (!samp) { b = unit / 68; const int r = unit - b * 68; nblk = r >> 2; g = r & 3; } else { const int u2 = unit - NPU; b = u2 >> 2; g = u2 & 3; nblk = 0; }
        const int q0 = samp ? 16384 : 128 * nblk;
        const int seqrow = samp ? TP + b * 8 : b * LP;
        const int nrows = samp ? 8 : (LP - 128 * nblk < 128 ? LP - 128 * nblk : 128);
        __syncthreads();
        for (int idx = tid; idx < 272 * 8; idx += 512) {
            const int kl = idx >> 3, ch = idx & 7; const int kpos = q0 - 144 + kl;
            u32x4 kw = {0u, 0u, 0u, 0u}, vw = kw;
            if (!samp) { if (kpos >= 0 && kpos < LP) { const size_t r = (size_t)(seqrow + kpos) * 256 + g * 64 + 8 * ch; kw = *(const u32x4*)(kb + r); vw = *(const u32x4*)(vb + r); } }
            else if (kpos >= 16384) { if (kpos < 16384 + 8) { const size_t r = (size_t)(seqrow + kpos - 16384) * 256 + g * 64 + 8 * ch; kw = *(const u32x4*)(kb + r); vw = *(const u32x4*)(vb + r); } }
            else if (kpos >= 16256) { const int w = kpos - 16256; const size_t r = ((size_t)(b * 128 + w) * 4 + g) * 64 + 8 * ch;
                const f32x4 k0 = *(const f32x4*)(a.in[I_SK] + r), k1 = *(const f32x4*)(a.in[I_SK] + r + 4), v0 = *(const f32x4*)(a.in[I_SV] + r), v1 = *(const f32x4*)(a.in[I_SV] + r + 4);
                kw = pack8(k0, k1); vw = pack8(v0, v1);
                if (w >= 8) { const size_t d = ((size_t)(b * 128 + w - 8) * 4 + g) * 64 + 8 * ch; float* ko = a.out + O_KS + d; float* vo = a.out + O_VS + d;
                    *(f32x4*)ko = k0; *(f32x4*)(ko + 4) = k1; *(f32x4*)vo = v0; *(f32x4*)(vo + 4) = v1; } }
            *(LAS u32x4*)(lds + A_KS + kl * 144 + ch * 16) = kw;
            *(LAS u32x4*)(lds + A_VS + kl * 144 + ch * 16) = vw;
        }
        const int qt = wave;
        const bool qvalid = 16 * qt + fr < nrows;
        const size_t qrow = (size_t)(seqrow + (samp ? 0 : 128 * nblk) + 16 * qt + fr);
        u32x4 qall[4][2];
#pragma unroll
        for (int hq = 0; hq < 4; ++hq)
#pragma unroll
            for (int sl = 0; sl < 2; ++sl) { qall[hq][sl] = (u32x4){0u, 0u, 0u, 0u}; if (qvalid) qall[hq][sl] = *(const u32x4*)(qb + qrow * DM + (4 * g + hq) * 64 + 32 * sl + 8 * fq); }
        __syncthreads();
        if (16 * qt < nrows) {
            const int qpos = q0 + 16 * qt + fr;
#pragma unroll
            for (int hq = 0; hq < 4; ++hq) {
                const int head = 4 * g + hq;
                bf16x8 qf[2];
#pragma unroll
                for (int sl = 0; sl < 2; ++sl) qf[sl] = __builtin_bit_cast(bf16x8, qall[hq][sl]);
                f32x4 s[10];
                s[0] = (f32x4){-1e30f, -1e30f, -1e30f, -1e30f};
#pragma unroll
                for (int kt = 1; kt < 10; ++kt) {
                    s[kt] = (f32x4){0.f, 0.f, 0.f, 0.f};
#pragma unroll
                    for (int sl = 0; sl < 2; ++sl) { const bf16x8 kf = *(const LAS bf16x8*)(lds + A_KS + (16 * qt + 16 * kt + fr) * 144 + sl * 64 + fq * 16);
                        s[kt] = __builtin_amdgcn_mfma_f32_16x16x32_bf16(kf, qf[sl], s[kt], 0, 0, 0); }
                }
                const float sink = a.in[I_SINKS][head];
                float mx = sink;
                const bool near_start = q0 < 144;
#pragma unroll
                for (int kt = 1; kt < 10; ++kt)
#pragma unroll
                    for (int j = 0; j < 4; ++j) { const int dist = 144 + fr - (16 * kt + 4 * fq + j);
                        if (kt == 1 || kt == 9 || near_start) { const int kpos = qpos - dist; const bool ok = dist >= 0 && dist < 128 && kpos >= 0; s[kt][j] = ok ? s[kt][j] : -1e30f; }
                        mx = fmaxf(mx, s[kt][j]); }
                mx = fmaxf(mx, __shfl_xor(mx, 16)); mx = fmaxf(mx, __shfl_xor(mx, 32));
                float l = 0.f;
#pragma unroll
                for (int kt = 0; kt < 10; ++kt)
#pragma unroll
                    for (int j = 0; j < 4; ++j) { const float p = __expf(s[kt][j] - mx); s[kt][j] = p; l += p; }
                l += __shfl_xor(l, 16); l += __shfl_xor(l, 32);
                l += __expf(sink - mx);
                const float rl = 1.0f / l;
                f32x4 o[4] = {{0.f, 0.f, 0.f, 0.f}, {0.f, 0.f, 0.f, 0.f}, {0.f, 0.f, 0.f, 0.f}, {0.f, 0.f, 0.f, 0.f}};
#pragma unroll
                for (int ks = 0; ks < 5; ++ks) {
                    const bf16x8 pv = __builtin_bit_cast(bf16x8, ((u32x4){cvt_pk_bf16(s[2 * ks][0], s[2 * ks][1]), cvt_pk_bf16(s[2 * ks][2], s[2 * ks][3]), cvt_pk_bf16(s[2 * ks + 1][0], s[2 * ks + 1][1]), cvt_pk_bf16(s[2 * ks + 1][2], s[2 * ks + 1][3])}));
#pragma unroll
                    for (int dt = 0; dt < 4; ++dt) {
                        const LAS unsigned char* vp = lds + A_VS + (16 * qt + 32 * ks + 4 * fq + (fr >> 2)) * 144 + (16 * dt + 4 * (fr & 3)) * 2;
                        const bf16x8 vf = tr8(vp, vp + 16 * 144);
                        o[dt] = __builtin_amdgcn_mfma_f32_16x16x32_bf16(vf, pv, o[dt], 0, 0, 0);
                    }
                }
                if (qvalid) {
#pragma unroll
                    for (int dt = 0; dt < 4; ++dt) { u32x2 w; w.x = cvt_pk_bf16(o[dt][0] * rl, o[dt][1] * rl); w.y = cvt_pk_bf16(o[dt][2] * rl, o[dt][3] * rl);
                        *(u32x2*)(ob + qrow * DM + head * 64 + 16 * dt + 4 * fq) = w; }
                }
            }
        }
    }
}

__device__ __forceinline__ void final_phase(const Args& a) {
    const int lane = threadIdx.x & 63, wave = threadIdx.x >> 6; const int gw = blockIdx.x * 8 + wave, NGW = gridDim.x * 8;
    const float* ss4 = (const float*)(a.ws + WS_SS) + 4 * (size_t)T;
    const f32x4* gp = (const f32x4*)a.in[I_FING] + lane;
    f32x4 gv[4];
#pragma unroll
    for (int j = 0; j < 4; ++j) gv[j] = gp[64 * j];
    const bf16_t* hb = (const bf16_t*)(a.ws + WS_HB);
    for (int m0 = gw; m0 < T; m0 += 2 * NGW) {
        f32x4* p[2]; float r[2]; u32x2 v[2][4];
#pragma unroll
        for (int q = 0; q < 2; ++q) { const int m = m0 + q * NGW; p[q] = nullptr; r[q] = 0.f;
            if (m < T) { float* yrow = nullptr;
                if (m < TP) { const int b = m / LP, t = m - b * LP; if (t >= 16) yrow = a.out + O_YP + ((size_t)(b * 2048 + t - 16)) * DM; } else yrow = a.out + O_YS + (size_t)(m - TP) * DM;
                if (yrow) { p[q] = (f32x4*)yrow + lane; r[q] = rs_row(ss4, m);
#pragma unroll
                    for (int j = 0; j < 4; ++j) v[q][j] = ((const u32x2*)(hb + (size_t)m * DM) + lane)[64 * j]; } } }
#pragma unroll
        for (int q = 0; q < 2; ++q) if (p[q]) {
#pragma unroll
            for (int j = 0; j < 4; ++j) __builtin_nontemporal_store(((f32x4){bf_lo(v[q][j].x), bf_hi(v[q][j].x), bf_lo(v[q][j].y), bf_hi(v[q][j].y)} * r[q] * gv[j]), p[q] + 64 * j); }
    }
}

constexpr int NPHASE = 13;
__global__ void __launch_bounds__(512) yoco_fwd(Args a) {
    extern __shared__ __attribute__((aligned(16))) unsigned char lds_raw[];
    LAS unsigned char* lds = (LAS unsigned char*)lds_raw;
    cg::grid_group grid = cg::this_grid();
    unsigned char* ws = a.ws;
    float* ss = (float*)(ws + WS_SS);
    bf16_t* hb = (bf16_t*)(ws + WS_HB);
    bf16_t* big = (bf16_t*)(ws + WS_BIG);
    const int lo = a.lo, hi = a.hi, G = gridDim.x;
#ifndef PROBE_MASK
#define PROBE_MASK 0
#endif
    unsigned long long pr_acc = 0ull, pr_t0 = 0ull;
#define PR_BEGIN(k) do { if ((PROBE_MASK >> (k)) & 1) pr_t0 = __builtin_amdgcn_s_memrealtime(); } while (0)
#define PR_END(k) do { if ((PROBE_MASK >> (k)) & 1) pr_acc += __builtin_amdgcn_s_memrealtime() - pr_t0; } while (0)
#define IN(k) (lo <= (k) && (k) < hi)
    volatile LAS unsigned* misc = (volatile LAS unsigned*)(lds + LDS_MISC);
    if (threadIdx.x < 2) misc[threadIdx.x] = 0u;
    __syncthreads();
    const XcdBarrier xbar = xcd_barrier_post((unsigned*)(ws + WS_BAR), misc);
    if (lo < 0) grid.sync();
#define GSYNC() xcd_barrier(xbar)
#define SEAM(k) do { if ((k) + 1 < hi) GSYNC(); } while (0)
    if (IN(0)) { PR_BEGIN(0); if (REP & 1) { p0_prologue(a, lds); GSYNC(); } p0_prologue(a, lds); SEAM(0); PR_END(0); }
    if (IN(1)) { PR_BEGIN(1); pg8::Gemm g{hb, (const bf16_t*)(ws + WS_WIN), T, NIN, 1024, 1024, 1024}; pg8::StaticOrder S; S.init(T, NIN, G, blockIdx.x);
        EpiInProj E{big, (float*)(ws + WS_DT), ss}; if (REP & 2) { pg8::gemm_phase(lds, g, S, E); GSYNC(); } pg8::gemm_phase(lds, g, S, E); SEAM(1); PR_END(1); }
    if (IN(2)) { PR_BEGIN(2); PR_BEGIN(13); conv_phase(a, lds); GSYNC(); PR_END(13); PR_BEGIN(14); if (REP & 4) { ssd_phase<true>(a, lds); GSYNC(); } ssd_phase<false>(a, lds); SEAM(2); PR_END(14); PR_END(2); }
    if (IN(3)) { PR_BEGIN(3); gatenorm_phase(a); SEAM(3); PR_END(3); }
    if (IN(4)) { PR_BEGIN(4); { pg8::Gemm g{big, (const bf16_t*)(ws + WS_WOUT), TAIL_ROW0, 1024, 2048, ZXW, 2048}; pg8::StaticOrder S; S.init(TAIL_ROW0, 1024, G, blockIdx.x);
            EpiResid<false> E{hb, ss + T, nullptr}; pg8::gemm_phase(lds, g, S, E); }
        { pg8::Gemm g{big, (const bf16_t*)(ws + WS_WOUT), T, 1024, 2048, ZXW, 256}; pg8::TailOrder S{8, G, (int)blockIdx.x, TAIL_ROW0 / 256, 4, TAIL_ROWS / 256};
            EpiPartial E{(float*)(ws + WS_END)}; pg8::gemm_phase(lds, g, S, E); }
        GSYNC(); tail_fixup(hb, ss + T, (const float*)(ws + WS_END), 8); SEAM(4); PR_END(4); }
    if (IN(5)) { PR_BEGIN(5); pg8::Gemm g{hb, (const bf16_t*)(ws + WS_WGU0), T, 2 * DFF, 1024, 1024, 1024}; pg8::StaticOrder S; S.init(T, 2 * DFF, G, blockIdx.x);
        EpiSwiglu E{big, ss + T}; pg8::gemm_phase(lds, g, S, E); SEAM(5); PR_END(5); }
    if (IN(6)) { PR_BEGIN(6); { pg8::Gemm g{big, (const bf16_t*)(ws + WS_WD0), TAIL_ROW0, 1024, DFF, DFF, DFF}; pg8::StaticOrder S; S.init(TAIL_ROW0, 1024, G, blockIdx.x);
            EpiResid<false> E{hb, ss + 2 * T, nullptr}; pg8::gemm_phase(lds, g, S, E); }
        { pg8::Gemm g{big, (const bf16_t*)(ws + WS_WD0), T, 1024, DFF, DFF, 256}; pg8::TailOrder S{11, G, (int)blockIdx.x, TAIL_ROW0 / 256, 4, TAIL_ROWS / 256};
            EpiPartial E{(float*)(ws + WS_BIG + 200 * MiB)}; pg8::gemm_phase(lds, g, S, E); }
        GSYNC(); tail_fixup(hb, ss + 2 * T, (const float*)(ws + WS_BIG + 200 * MiB), 11); SEAM(6); PR_END(6); }
    if (IN(7)) { PR_BEGIN(7); pg8::Gemm g{hb, (const bf16_t*)(ws + WS_WKVQ), T, NKVQ, 1024, 1024, 1024}; pg8::StaticOrder S; S.init(T, NKVQ, G, blockIdx.x);
        EpiKVQ E{(bf16_t*)(ws + WS_K), (bf16_t*)(ws + WS_V), (bf16_t*)(ws + WS_Q), ss + 2 * T, (const float*)(ws + WS_ROPE), a.out}; pg8::gemm_phase(lds, g, S, E); SEAM(7); PR_END(7); }
    if (IN(8)) { PR_BEGIN(8); if (REP & 256) { attn_phase(a, lds); GSYNC(); } attn_phase(a, lds); SEAM(8); PR_END(8); }
    if (IN(9)) { PR_BEGIN(9); { pg8::Gemm g{(const bf16_t*)(ws + WS_O), (const bf16_t*)(ws + WS_WO), TAIL_ROW0, 1024, 1024, 1024, 1024}; pg8::StaticOrder S; S.init(TAIL_ROW0, 1024, G, blockIdx.x);
            EpiResid<false> E{hb, ss + 3 * T, nullptr}; pg8::gemm_phase(lds, g, S, E); }
        { pg8::Gemm g{(const bf16_t*)(ws + WS_O), (const bf16_t*)(ws + WS_WO), T, 1024, 1024, 1024, 256}; pg8::TailOrder S{4, G, (int)blockIdx.x, TAIL_ROW0 / 256, 4, TAIL_ROWS / 256};
            EpiPartial E{(float*)(ws + WS_END)}; pg8::gemm_phase(lds, g, S, E); }
        GSYNC(); tail_fixup(hb, ss + 3 * T, (const float*)(ws + WS_END), 4); SEAM(9); PR_END(9); }
    if (IN(10)) { PR_BEGIN(10); pg8::Gemm g{hb, (const bf16_t*)(ws + WS_WGU1), T, 2 * DFF, 1024, 1024, 1024}; pg8::StaticOrder S; S.init(T, 2 * DFF, G, blockIdx.x);
        EpiSwiglu E{big, ss + 3 * T}; pg8::gemm_phase(lds, g, S, E); SEAM(10); PR_END(10); }
    if (IN(11)) { PR_BEGIN(11); { pg8::Gemm g{big, (const bf16_t*)(ws + WS_WD1), TAIL_ROW0, 1024, DFF, DFF, DFF}; pg8::StaticOrder S; S.init(TAIL_ROW0, 1024, G, blockIdx.x);
            EpiResid<false> E{hb, ss + 4 * T, nullptr}; pg8::gemm_phase(lds, g, S, E); }
        { pg8::Gemm g{big, (const bf16_t*)(ws + WS_WD1), T, 1024, DFF, DFF, 256}; pg8::TailOrder S{11, G, (int)blockIdx.x, TAIL_ROW0 / 256, 4, TAIL_ROWS / 256};
            EpiPartial E{(float*)(ws + WS_BIG + 200 * MiB)}; pg8::gemm_phase(lds, g, S, E); }
        GSYNC(); tail_fixup(hb, ss + 4 * T, (const float*)(ws + WS_BIG + 200 * MiB), 11); SEAM(11); PR_END(11); }
    if (IN(12)) { PR_BEGIN(12); final_phase(a); if (PROBE_MASK & (1 << 12)) { grid.sync(); PR_END(12); } }
    if (PROBE_MASK && blockIdx.x == 0 && threadIdx.x == 0) { const unsigned long long t0 = __builtin_amdgcn_s_memrealtime(); while (__builtin_amdgcn_s_memrealtime() - t0 < 4ull * pr_acc) __builtin_amdgcn_s_sleep(8); }
#undef IN
#undef SEAM
}

extern "C" void kernel_launch(void* const* d_in, const int* in_sizes, int n_in, void* d_out, int out_size, void* d_ws, size_t ws_size, hipStream_t stream) {
    static int grid = 0;
    if (grid == 0) {
        if (n_in != 28 || ws_size < WS_END + 42 * MiB) { fprintf(stderr, "kernel_launch: unexpected n_in %d / ws %zu (need %zu)\n", n_in, ws_size, (size_t)WS_END); grid = -1; return; }
        int dev = 0, cus = 0, per_cu = 0;
        hipGetDevice(&dev); hipDeviceGetAttribute(&cus, hipDeviceAttributeMultiprocessorCount, dev);
        hipFuncSetAttribute((const void*)yoco_fwd, hipFuncAttributeMaxDynamicSharedMemorySize, LDS_BYTES);
        hipOccupancyMaxActiveBlocksPerMultiprocessor(&per_cu, (const void*)yoco_fwd, 512, LDS_BYTES);
        if (per_cu < 1) { fprintf(stderr, "kernel_launch: occupancy query says %d blocks/CU\n", per_cu); per_cu = 1; }
        (void)hipGetLastError();
        grid = cus * per_cu;
    }
    if (grid < 0) return;
    Args a{};
    for (int i = 0; i < 28; ++i) a.in[i] = (const float*)d_in[i];
    a.out = (float*)d_out; a.ws = (unsigned char*)d_ws;
#if MK_MULTI
    for (int ph = 0; ph < NPHASE; ++ph) { a.lo = ph; a.hi = ph + 1; hipLaunchKernelGGL(yoco_fwd, dim3(grid), dim3(512), LDS_BYTES, stream, a); }
#else
    a.lo = 0; a.hi = NPHASE;
    (void)hipMemsetAsync((unsigned char*)d_ws + WS_BAR, 0, 16384, stream);
    void* args[] = {&a};
    hipError_t e = hipLaunchCooperativeKernel((const void*)yoco_fwd, dim3(grid), dim3(512), args, LDS_BYTES, stream);
    if (e != hipSuccess) fprintf(stderr, "cooperative launch failed: %s (grid %d)\n", hipGetErrorString(e), grid);
#endif
}
```

```cpp
#include <hip/hip_runtime.h>
#include <hip/hip_cooperative_groups.h>
#include <cstdio>
#include <cstdint>
namespace cg = cooperative_groups;

#ifndef MK_MULTI
#define MK_MULTI 0
#endif

#ifndef REP
#define REP 0
#endif
#define PROBE_MASK 0
#define LAS __attribute__((address_space(3)))
typedef unsigned short bf16_t;
typedef short bf16x8 __attribute__((ext_vector_type(8)));
typedef float f32x4 __attribute__((ext_vector_type(4)));
typedef float f32x2 __attribute__((ext_vector_type(2)));
typedef unsigned u32x4 __attribute__((ext_vector_type(4)));
typedef unsigned u32x2 __attribute__((ext_vector_type(2)));

constexpr int DM = 1024, NBATCH = 16, LP = 2064, DECB = 128, DECS = 8;
constexpr int TP = NBATCH * LP;
constexpr int TS = DECB * DECS;
constexpr int T = TP + TS;
constexpr int DI = 2048, CONVD = 3072, NH = 32, DFF = 2816;
constexpr int ZXW = 5120;
constexpr int NIN = 5376;
constexpr int NKVQ = 1536;
constexpr float EPS = 1e-5f;

constexpr size_t O_YP = 0, O_YS = 33554432, O_SSMP = 34603008, O_CONVP = 38797312, O_KP = 38944768, O_VP = 39469056,
                 O_SSMS = 39993344, O_CONVS = 73547776, O_KS = 74727424, O_VS = 78921728;

constexpr size_t MiB = 1u << 20;
constexpr size_t WS_SS = 0;
constexpr size_t WS_ROPE = 1 * MiB;
constexpr size_t WS_BAR = 1 * MiB + 512 * 1024;
constexpr size_t WS_DT = 2 * MiB;
constexpr size_t WS_WIN = 8 * MiB, WS_WOUT = 19 * MiB, WS_WGU0 = 23 * MiB, WS_WGU1 = 34 * MiB, WS_WD0 = 45 * MiB, WS_WD1 = 51 * MiB,
                 WS_WKVQ = 57 * MiB, WS_WO = 60 * MiB;
constexpr size_t WS_HB = 64 * MiB;
constexpr size_t WS_BIG = 132 * MiB;
constexpr size_t WS_Q = WS_BIG, WS_K = WS_BIG + 67 * MiB, WS_V = WS_BIG + 84 * MiB, WS_O = WS_BIG + 101 * MiB;
constexpr size_t WS_END = WS_BIG + (size_t)T * ZXW * 2;

constexpr int LDS_BYTES = 135168, LDS_MISC = 133120;

__device__ __forceinline__ unsigned cvt_pk_bf16(float lo, float hi) { unsigned r; asm volatile("v_cvt_pk_bf16_f32 %0, %1, %2" : "=v"(r) : "v"(lo), "v"(hi)); return r; }
__device__ __forceinline__ float bf_lo(unsigned w) { return __uint_as_float(w << 16); }
__device__ __forceinline__ float bf_hi(unsigned w) { return __uint_as_float(w & 0xffff0000u); }
__device__ __forceinline__ float bf1(unsigned short h) { return __uint_as_float(((unsigned)h) << 16); }
__device__ __forceinline__ float silu_f(float x) { return x * __builtin_amdgcn_rcpf(1.0f + __expf(-x)); }
__device__ __forceinline__ float wave_sum(float v) {
#pragma unroll
    for (int o = 1; o < 64; o <<= 1) v += __shfl_xor(v, o);
    return v;
}
__device__ __forceinline__ float rs_row(const float* ss, int row) { return rsqrtf(ss[row] * (1.0f / 1024.0f) + EPS); }

namespace pg8 {
constexpr int BM = 256, BK = 64, HALF = 128, HTB = HALF * BK * 2, STAGE_BYTES = 8 * HTB, NXCD = 8, WGM = 8;
__host__ __device__ __forceinline__ int lds_byte(int r, int c) { const int st = (r >> 4) * 2 + (c >> 5), rr = r & 15, cc = c & 31, ob = rr * 64 + cc * 2; return st * 1024 + (ob ^ (((ob >> 9) & 1) << 5)); }
__host__ __device__ __forceinline__ void stage_rc(int b, int& R, int& C) { const int st = b / 1024, sb = b % 1024, swz = sb ^ (((sb >> 9) & 1) << 5); R = (st >> 1) * 16 + swz / 64; C = (st & 1) * 32 + (swz % 64) / 2; }
__host__ __device__ __forceinline__ int perm32(int rho) { const int n = rho >> 4, i = rho & 15; return 8 * (i >> 2) + 4 * n + (i & 3); }
struct Unit { int pm, pn, ks; };
struct Gemm { const bf16_t* A; const bf16_t* Bt; int M, N, K, lda, klen; };
struct StaticOrder {
    int nM, nN, nwg, G, c;
    __device__ __forceinline__ void init(int M, int N, int G_, int c_) { nM = M / BM; nN = N / BM; nwg = nM * nN; G = G_; c = c_; }
    __device__ __forceinline__ bool next(int i, Unit& u) const {
        const long L = (long)i * G + c; if (L >= nwg) return false;
        int wgid = (int)L; { const int q = nwg / NXCD, r = nwg % NXCD, xcd = wgid % NXCD, off = wgid / NXCD; wgid = (xcd < r ? xcd * (q + 1) : r * (q + 1) + (xcd - r) * q) + off; }
        const int nig = WGM * nN, gid = wgid / nig, fm = gid * WGM, gsz = (nM - fm) < WGM ? (nM - fm) : WGM;
        u.pm = fm + ((wgid % nig) % gsz); u.pn = (wgid % nig) / gsz; u.ks = 0; return true;
    }
};
struct TailOrder {
    int S, G, c, pm0, nN, npan;
    __device__ __forceinline__ bool next(int i, Unit& u) const {
        const int L = i * G + c; if (L >= npan * nN * S) return false;
        u.ks = L % S; const int t = L / S; u.pn = t % nN; u.pm = pm0 + t / nN; return true;
    }
};
#ifndef PG8_SP2
#define PG8_SP2 true
#endif
#ifndef PG8_ALIGN
#define PG8_ALIGN true
#endif
template <class Epi, class Order, bool ALIGN_EPI = PG8_ALIGN, bool SP2 = PG8_SP2>
__device__ __forceinline__ void gemm_phase(LAS unsigned char* lds, const Gemm g, const Order& S, const Epi& E) {
    const int tid = threadIdx.x, wid = __builtin_amdgcn_readfirstlane(tid >> 6), lane = tid & 63, wr = wid >> 2, wc = wid & 3, fr = lane & 15, fq = lane >> 4;
    const int K = g.K, nt = g.klen / BK, lda = g.lda; const size_t ksplit = (size_t)g.klen * 2;
    unsigned voffA[2], voffB[2];
#pragma unroll
    for (int i = 0; i < 2; ++i) { int R, C; stage_rc(tid * 16 + i * 8192, R, C); const int Rb = (R & ~31) + perm32(R & 31);
        voffA[i] = (unsigned)(R * lda + C) * 2u; voffB[i] = (unsigned)(Rb * K + C) * 2u; }
    const size_t kstep = (size_t)(BK * 2);
    const size_t hstepA = (size_t)HALF * lda * 2, tstepA = 2 * hstepA;
    const size_t hstepB = (size_t)HALF * K * 2, tstepB = 2 * hstepB;
    const unsigned ldsw = (unsigned)wid * 1024u;
    const int aoff = lds_byte(wr * 64 + fr, fq * 8), boff = lds_byte(wc * 32 + fr, fq * 8);
#define PG8_SA(b, h) (((b) * 2 + (h)) * HTB)
#define PG8_SB(b, h) ((4 + (b) * 2 + (h)) * HTB)
#define PG8_STAGE(bufoff, gbase, voff) do { _Pragma("unroll") for (int _i = 0; _i < 2; ++_i) \
        __builtin_amdgcn_global_load_lds((const unsigned*)((const char*)(gbase) + (voff)[_i]), (LAS unsigned*)(lds + (bufoff) + ldsw + _i * 8192), 16, 0, 0); } while (0)
#define PG8_LDA(dst, b, h) do { _Pragma("unroll") for (int m = 0; m < 4; ++m) _Pragma("unroll") for (int k = 0; k < 2; ++k) dst[m][k] = *(const LAS bf16x8*)(lds + PG8_SA(b, h) + aoff + m * 2048 + k * 1024); } while (0)
#define PG8_LDB(dst, b, h) do { _Pragma("unroll") for (int n = 0; n < 2; ++n) _Pragma("unroll") for (int k = 0; k < 2; ++k) dst[n][k] = *(const LAS bf16x8*)(lds + PG8_SB(b, h) + boff + n * 2048 + k * 1024); } while (0)
#define PG8_MMA(ai, bj, At, Bt) do { __builtin_amdgcn_s_setprio(1); _Pragma("unroll") for (int m = 0; m < 4; ++m) _Pragma("unroll") for (int n = 0; n < 2; ++n) _Pragma("unroll") for (int k = 0; k < 2; ++k) \
        acc[ai][bj][m][n] = __builtin_amdgcn_mfma_f32_16x16x32_bf16(Bt[n][k], At[m][k], acc[ai][bj][m][n], 0, 0, 0); __builtin_amdgcn_s_setprio(0); } while (0)
#define PG8_WAIT_V(n) asm volatile("s_waitcnt vmcnt(" #n ")" ::: "memory")
#define PG8_WAIT_L(n) asm volatile("s_waitcnt lgkmcnt(" #n ")" ::: "memory")
#define PG8_BAR __builtin_amdgcn_s_barrier()
#define PG8_SCHED __builtin_amdgcn_sched_barrier(0)
    Unit cur, nxt; int ui = 0;
    if (!S.next(0, cur)) return;
    f32x4 acc[2][2][4][2];
#pragma unroll
    for (int a = 0; a < 2; ++a)
#pragma unroll
        for (int b = 0; b < 2; ++b)
#pragma unroll
            for (int m = 0; m < 4; ++m)
#pragma unroll
                for (int n = 0; n < 2; ++n) acc[a][b][m][n] = (f32x4){0.f, 0.f, 0.f, 0.f};
    bf16x8 At[4][2], B0[2][2], B1[2][2];
    float pre[8];
    if constexpr (Epi::NPRE > 0) E.preload(cur, wr, fr, pre);
    const char* cA = (const char*)g.A + (size_t)cur.pm * tstepA + cur.ks * ksplit; const char* cB = (const char*)g.Bt + (size_t)cur.pn * tstepB + cur.ks * ksplit;
    if constexpr (SP2) {
        PG8_STAGE(PG8_SB(0, 0), cB, voffB); PG8_STAGE(PG8_SB(0, 1), cB + hstepB, voffB); PG8_STAGE(PG8_SA(0, 0), cA, voffA); PG8_STAGE(PG8_SA(0, 1), cA + hstepA, voffA);
        if (wr == 1) PG8_BAR;
        PG8_WAIT_V(2); PG8_BAR;
        PG8_STAGE(PG8_SB(1, 0), cB + kstep, voffB); PG8_STAGE(PG8_SA(1, 0), cA + kstep, voffA); PG8_STAGE(PG8_SB(1, 1), cB + hstepB + kstep, voffB);
        PG8_WAIT_V(6); PG8_BAR;
    } else {
        PG8_STAGE(PG8_SB(0, 0), cB, voffB); PG8_STAGE(PG8_SA(0, 0), cA, voffA); PG8_STAGE(PG8_SB(0, 1), cB + hstepB, voffB); PG8_STAGE(PG8_SA(0, 1), cA + hstepA, voffA);
        if (wr == 1) PG8_BAR;
        PG8_WAIT_V(4); PG8_BAR;
        PG8_STAGE(PG8_SB(1, 0), cB + kstep, voffB); PG8_STAGE(PG8_SA(1, 0), cA + kstep, voffA); PG8_STAGE(PG8_SB(1, 1), cB + hstepB + kstep, voffB);
        PG8_WAIT_V(6); PG8_BAR;
    }
    for (;;) {
        const bool has_next = S.next(ui + 1, nxt);
        const char* nA = has_next ? (const char*)g.A + (size_t)nxt.pm * tstepA + nxt.ks * ksplit : cA; const char* nB = has_next ? (const char*)g.Bt + (size_t)nxt.pn * tstepB + nxt.ks * ksplit : cB;
        for (int t = 0; t < nt; t += 2) {
            const bool last = (t == nt - 2);
            const char* a1 = cA + (size_t)(t + 1) * kstep;
            const char* a2 = last ? nA : cA + (size_t)(t + 2) * kstep; const char* b2 = last ? nB : cB + (size_t)(t + 2) * kstep;
            const char* a3 = a2 + kstep; const char* b3 = b2 + kstep;
            if constexpr (SP2) {
            PG8_LDB(B0, 0, 0); PG8_LDB(B1, 0, 1); PG8_SCHED; PG8_LDA(At, 0, 0); PG8_STAGE(PG8_SA(1, 1), a1 + hstepA, voffA);
            PG8_WAIT_V(8); PG8_WAIT_L(0); PG8_BAR; PG8_MMA(0, 0, At, B0); PG8_MMA(0, 1, At, B1); PG8_BAR; PG8_SCHED;
            PG8_LDA(At, 0, 1); PG8_STAGE(PG8_SB(0, 0), b2, voffB); PG8_STAGE(PG8_SB(0, 1), b2 + hstepB, voffB); PG8_STAGE(PG8_SA(0, 0), a2, voffA);
            PG8_WAIT_V(8); PG8_WAIT_L(0); PG8_BAR; PG8_MMA(1, 0, At, B0); PG8_MMA(1, 1, At, B1); PG8_BAR; PG8_SCHED;
            PG8_LDB(B0, 1, 0); PG8_LDB(B1, 1, 1); PG8_SCHED; PG8_LDA(At, 1, 0); PG8_STAGE(PG8_SA(0, 1), a2 + hstepA, voffA);
            PG8_WAIT_V(8); PG8_WAIT_L(0); PG8_BAR; PG8_MMA(0, 0, At, B0); PG8_MMA(0, 1, At, B1); PG8_BAR; PG8_SCHED;
            PG8_LDA(At, 1, 1); PG8_STAGE(PG8_SB(1, 0), b3, voffB); PG8_STAGE(PG8_SB(1, 1), b3 + hstepB, voffB); PG8_STAGE(PG8_SA(1, 0), a3, voffA);
            PG8_WAIT_V(8); PG8_WAIT_L(0); PG8_BAR; PG8_MMA(1, 0, At, B0); PG8_MMA(1, 1, At, B1); PG8_BAR; PG8_SCHED;
            } else {
            PG8_LDB(B0, 0, 0); PG8_SCHED; PG8_LDA(At, 0, 0); PG8_STAGE(PG8_SA(1, 1), a1 + hstepA, voffA);
            PG8_WAIT_L(8); PG8_BAR; PG8_WAIT_L(0); PG8_MMA(0, 0, At, B0); PG8_BAR; PG8_SCHED;
            PG8_LDB(B1, 0, 1); PG8_STAGE(PG8_SB(0, 0), b2, voffB);
            PG8_BAR; PG8_WAIT_L(0); PG8_MMA(0, 1, At, B1); PG8_BAR;
            PG8_LDA(At, 0, 1); PG8_STAGE(PG8_SA(0, 0), a2, voffA);
            PG8_BAR; PG8_WAIT_L(0); PG8_MMA(1, 0, At, B0); PG8_BAR; PG8_SCHED;
            PG8_STAGE(PG8_SB(0, 1), b2 + hstepB, voffB);
            PG8_WAIT_V(6); PG8_BAR; PG8_MMA(1, 1, At, B1); PG8_BAR;
            PG8_LDB(B0, 1, 0); PG8_SCHED; PG8_LDA(At, 1, 0); PG8_STAGE(PG8_SA(0, 1), a2 + hstepA, voffA);
            PG8_WAIT_L(8); PG8_BAR; PG8_WAIT_L(0); PG8_MMA(0, 0, At, B0); PG8_BAR; PG8_SCHED;
            PG8_LDB(B1, 1, 1); PG8_STAGE(PG8_SB(1, 0), b3, voffB);
            PG8_BAR; PG8_WAIT_L(0); PG8_MMA(0, 1, At, B1); PG8_BAR;
            PG8_LDA(At, 1, 1); PG8_STAGE(PG8_SA(1, 0), a3, voffA);
            PG8_BAR; PG8_WAIT_L(0); PG8_MMA(1, 0, At, B0); PG8_BAR; PG8_SCHED;
            PG8_STAGE(PG8_SB(1, 1), b3 + hstepB, voffB);
            PG8_WAIT_V(6); PG8_BAR; PG8_MMA(1, 1, At, B1); PG8_BAR;
            }
        }
        if constexpr (ALIGN_EPI) { if (wr == 0) PG8_BAR; }
        E(acc, cur, wr, wc, fr, fq, pre);
        if (!has_next) break;
#pragma unroll
        for (int a = 0; a < 2; ++a)
#pragma unroll
            for (int b = 0; b < 2; ++b)
#pragma unroll
                for (int m = 0; m < 4; ++m)
#pragma unroll
                    for (int n = 0; n < 2; ++n) acc[a][b][m][n] = (f32x4){0.f, 0.f, 0.f, 0.f};
        cur = nxt; cA = nA; cB = nB; ++ui;
        if constexpr (Epi::NPRE > 0) E.preload(cur, wr, fr, pre);
        if constexpr (ALIGN_EPI) { if (wr == 1) PG8_BAR; }
    }
    PG8_WAIT_V(0);
    if constexpr (!ALIGN_EPI) { if (wr == 0) PG8_BAR; }
    PG8_BAR;
#undef PG8_SA
#undef PG8_SB
#undef PG8_STAGE
#undef PG8_LDA
#undef PG8_LDB
#undef PG8_MMA
#undef PG8_WAIT_V
#undef PG8_WAIT_L
#undef PG8_BAR
#undef PG8_SCHED
}
}
using pg8::Unit;

__device__ __forceinline__ u32x4 pack8(const f32x4 v0, const f32x4 v1) {
    u32x4 w; w.x = cvt_pk_bf16(v0[0], v0[1]); w.y = cvt_pk_bf16(v0[2], v0[3]); w.z = cvt_pk_bf16(v1[0], v1[1]); w.w = cvt_pk_bf16(v1[2], v1[3]); return w;
}
struct EpiInProj {
    bf16_t* zx; float* dtraw; const float* ss;
    static constexpr int NPRE = 8;
    __device__ __forceinline__ void preload(const Unit& u, int wr, int fr, float (&pre)[8]) const {
        const float* p = ss + u.pm * 256 + wr * 64 + fr;
#pragma unroll
        for (int i = 0; i < 8; ++i) asm volatile("global_load_dword %0, %1, off" : "=v"(pre[i]) : "v"(p + (i >> 2) * 128 + (i & 3) * 16) : "memory");
    }
    __device__ __forceinline__ void operator()(const f32x4 (&acc)[2][2][4][2], const Unit& u, int wr, int wc, int fr, int fq, const float (&pre)[8]) const {
        const int row0 = u.pm * 256 + wr * 64 + fr;
        float rsv[8];
#pragma unroll
        for (int i = 0; i < 8; ++i) rsv[i] = rsqrtf(pre[i] * (1.0f / 1024.0f) + EPS);
#pragma unroll
        for (int ai = 0; ai < 2; ++ai)
#pragma unroll
            for (int m = 0; m < 4; ++m) {
                const int row = row0 + ai * 128 + m * 16; const float r = rsv[ai * 4 + m];
                if (u.pn < 20) {
#pragma unroll
                    for (int bj = 0; bj < 2; ++bj) { const int col = u.pn * 256 + bj * 128 + wc * 32 + 8 * fq;
                        __builtin_nontemporal_store(pack8(acc[ai][bj][m][0] * r, acc[ai][bj][m][1] * r), (u32x4*)(zx + (size_t)row * ZXW + col)); }
                } else if (wc == 0) {
                    float* d = dtraw + (size_t)row * 32 + 8 * fq;
                    *(f32x4*)d = acc[ai][0][m][0] * r; *(f32x4*)(d + 4) = acc[ai][0][m][1] * r;
                }
            }
    }
};
template <bool FINAL> struct EpiResid {
    bf16_t* hb; float* ssn; float* out;
    static constexpr int NPRE = 0;
    __device__ __forceinline__ void operator()(const f32x4 (&acc)[2][2][4][2], const Unit& u, int wr, int wc, int fr, int fq, const float (&pre)[8]) const {
        const int row0 = u.pm * 256 + wr * 64 + fr;
#pragma unroll
        for (int ai = 0; ai < 2; ++ai)
#pragma unroll
            for (int m = 0; m < 4; ++m) {
                const int row = row0 + ai * 128 + m * 16; float s = 0.f;
                float* yrow = nullptr;
                if (FINAL) { if (row < TP) { const int b = row / LP, t = row - b * LP; if (t >= 16) yrow = out + O_YP + ((size_t)(b * 2048 + t - 16)) * DM; } else yrow = out + O_YS + (size_t)(row - TP) * DM; }
#pragma unroll
                for (int bj = 0; bj < 2; ++bj) { const int col = u.pn * 256 + bj * 128 + wc * 32 + 8 * fq;
                    bf16_t* p = hb + (size_t)row * DM + col; const u32x4 o = *(const u32x4*)p;
                    f32x4 v0 = acc[ai][bj][m][0], v1 = acc[ai][bj][m][1];
                    v0[0] += bf_lo(o.x); v0[1] += bf_hi(o.x); v0[2] += bf_lo(o.y); v0[3] += bf_hi(o.y);
                    v1[0] += bf_lo(o.z); v1[1] += bf_hi(o.z); v1[2] += bf_lo(o.w); v1[3] += bf_hi(o.w);
                    s += (v0[0] * v0[0] + v0[1] * v0[1]) + (v0[2] * v0[2] + v0[3] * v0[3]) + (v1[0] * v1[0] + v1[1] * v1[1]) + (v1[2] * v1[2] + v1[3] * v1[3]);
                    if (FINAL) { if (yrow) { *(f32x4*)(yrow + col) = v0; *(f32x4*)(yrow + col + 4) = v1; } }
                    else *(u32x4*)p = pack8(v0, v1); }
                s += __shfl_xor(s, 16); s += __shfl_xor(s, 32);
                if (fq == 0) atomicAdd(ssn + row, s);
            }
    }
};
constexpr int TAIL_ROW0 = 32768, TAIL_ROWS = T - TAIL_ROW0;
struct EpiPartial {
    float* P;
    static constexpr int NPRE = 0;
    __device__ __forceinline__ void operator()(const f32x4 (&acc)[2][2][4][2], const Unit& u, int wr, int wc, int fr, int fq, const float (&pre)[8]) const {
        const int row0 = u.pm * 256 + wr * 64 + fr - TAIL_ROW0;
#pragma unroll
        for (int ai = 0; ai < 2; ++ai)
#pragma unroll
            for (int m = 0; m < 4; ++m) {
                float* rp = P + ((size_t)u.ks * TAIL_ROWS + row0 + ai * 128 + m * 16) * DM + u.pn * 256 + wc * 32 + 8 * fq;
#pragma unroll
                for (int bj = 0; bj < 2; ++bj) { *(f32x4*)(rp + bj * 128) = acc[ai][bj][m][0]; *(f32x4*)(rp + bj * 128 + 4) = acc[ai][bj][m][1]; }
            }
    }
};
__device__ __forceinline__ void tail_fixup(bf16_t* hb, float* ssn, const float* P, int S) {
    const int lane = threadIdx.x & 63, wave = threadIdx.x >> 6; const int gw = blockIdx.x * 8 + wave, NGW = gridDim.x * 8;
    for (int r = gw; r < TAIL_ROWS; r += NGW) {
        const int row = TAIL_ROW0 + r; f32x4 v[4];
        u32x2* hp = (u32x2*)(hb + (size_t)row * DM) + lane;
#pragma unroll
        for (int j = 0; j < 4; ++j) { const u32x2 o = hp[64 * j]; v[j] = (f32x4){bf_lo(o.x), bf_hi(o.x), bf_lo(o.y), bf_hi(o.y)}; }
        for (int s = 0; s < S; ++s) { const f32x4* pp = (const f32x4*)(P + ((size_t)s * TAIL_ROWS + r) * DM) + lane;
#pragma unroll
            for (int j = 0; j < 4; ++j) v[j] += pp[64 * j]; }
        float q = 0.f;
#pragma unroll
        for (int j = 0; j < 4; ++j) { q += (v[j][0] * v[j][0] + v[j][1] * v[j][1]) + (v[j][2] * v[j][2] + v[j][3] * v[j][3]); u32x2 w; w.x = cvt_pk_bf16(v[j][0], v[j][1]); w.y = cvt_pk_bf16(v[j][2], v[j][3]); hp[64 * j] = w; }
        q = wave_sum(q);
        if (lane == 0) ssn[row] = q;
    }
}
struct EpiSwiglu {
    bf16_t* act; const float* ss;
    static constexpr int NPRE = 8;
    __device__ __forceinline__ void preload(const Unit& u, int wr, int fr, float (&pre)[8]) const {
        const float* p = ss + u.pm * 256 + wr * 64 + fr;
#pragma unroll
        for (int i = 0; i < 8; ++i) asm volatile("global_load_dword %0, %1, off" : "=v"(pre[i]) : "v"(p + (i >> 2) * 128 + (i & 3) * 16) : "memory");
    }
    __device__ __forceinline__ void operator()(const f32x4 (&acc)[2][2][4][2], const Unit& u, int wr, int wc, int fr, int fq, const float (&pre)[8]) const {
        const int row0 = u.pm * 256 + wr * 64 + fr, col = u.pn * 128 + wc * 32 + 8 * fq;
        float rsv[8];
#pragma unroll
        for (int i = 0; i < 8; ++i) rsv[i] = rsqrtf(pre[i] * (1.0f / 1024.0f) + EPS);
#pragma unroll
        for (int ai = 0; ai < 2; ++ai)
#pragma unroll
            for (int m = 0; m < 4; ++m) {
                const int row = row0 + ai * 128 + m * 16; const float r = rsv[ai * 4 + m];
                f32x4 o[2];
#pragma unroll
                for (int n = 0; n < 2; ++n)
#pragma unroll
                    for (int j = 0; j < 4; ++j) { const float g = acc[ai][0][m][n][j] * r, uu = acc[ai][1][m][n][j] * r; o[n][j] = silu_f(g) * uu; }
                __builtin_nontemporal_store(pack8(o[0], o[1]), (u32x4*)(act + (size_t)row * DFF + col));
            }
    }
};
struct EpiKVQ {
    bf16_t *kb, *vb, *qb; const float* ss; const float* rope; float* out;
    static constexpr int NPRE = 8;
    __device__ __forceinline__ void preload(const Unit& u, int wr, int fr, float (&pre)[8]) const {
        const float* p = ss + u.pm * 256 + wr * 64 + fr;
#pragma unroll
        for (int i = 0; i < 8; ++i) asm volatile("global_load_dword %0, %1, off" : "=v"(pre[i]) : "v"(p + (i >> 2) * 128 + (i & 3) * 16) : "memory");
    }
    __device__ __forceinline__ void operator()(const f32x4 (&acc)[2][2][4][2], const Unit& u, int wr, int wc, int fr, int fq, const float (&pre)[8]) const {
        const int row0 = u.pm * 256 + wr * 64 + fr;
        const bool do_rope = (u.pn != 1) && ((wc & 1) == 0);
        float rsv[8];
#pragma unroll
        for (int i = 0; i < 8; ++i) rsv[i] = rsqrtf(pre[i] * (1.0f / 1024.0f) + EPS);
#pragma unroll
        for (int ai = 0; ai < 2; ++ai)
#pragma unroll
            for (int m = 0; m < 4; ++m) {
                const int row = row0 + ai * 128 + m * 16; const float r = rsv[ai * 4 + m];
                int b, t, pidx; long kvrow;
                if (row < TP) { b = row / LP; t = row - b * LP; pidx = t; kvrow = (t >= LP - 128) ? (long)b * 128 + (t - (LP - 128)) : -1; }
                else { const int ms = row - TP; b = ms >> 3; t = ms & 7; pidx = LP + t; kvrow = (long)b * 128 + 120 + t; }
                f32x4 cs0 = {1.f, 1.f, 1.f, 1.f}, cs1 = cs0, sn0 = {0.f, 0.f, 0.f, 0.f}, sn1 = sn0;
                if (do_rope && fq < 2) { const float* rp = rope + (size_t)pidx * 16; cs0 = *(const f32x4*)rp; cs1 = *(const f32x4*)(rp + 4); sn0 = *(const f32x4*)(rp + 8); sn1 = *(const f32x4*)(rp + 12);
                    if (fq == 0) { sn0 = -sn0; sn1 = -sn1; } }
#pragma unroll
                for (int bj = 0; bj < 2; ++bj) {
                    const int colt = bj * 128 + wc * 32 + 8 * fq;
                    f32x4 v0 = acc[ai][bj][m][0] * r, v1 = acc[ai][bj][m][1] * r;
                    if (do_rope) {
                        f32x4 p0, p1;
#pragma unroll
                        for (int j = 0; j < 4; ++j) { p0[j] = __shfl_xor(v0[j], 16); p1[j] = __shfl_xor(v1[j], 16); }
                        v0 = v0 * cs0 + p0 * sn0; v1 = v1 * cs1 + p1 * sn1;
                    }
                    const u32x4 w = pack8(v0, v1);
                    if (u.pn == 0) { *(u32x4*)(kb + (size_t)row * 256 + colt) = w;
                        if (kvrow >= 0) { float* d = out + (row < TP ? O_KP : O_KS) + (size_t)kvrow * 256 + colt; *(f32x4*)d = v0; *(f32x4*)(d + 4) = v1; } }
                    else if (u.pn == 1) { *(u32x4*)(vb + (size_t)row * 256 + colt) = w;
                        if (kvrow >= 0) { float* d = out + (row < TP ? O_VP : O_VS) + (size_t)kvrow * 256 + colt; *(f32x4*)d = v0; *(f32x4*)(d + 4) = v1; } }
                    else *(u32x4*)(qb + (size_t)row * DM + (u.pn - 2) * 256 + colt) = w;
                }
            }
    }
};

#define XB_TMO      128
#define XB_XCNT(j)  (256  + 64 * (j))
#define XB_XSUB(j)  (1280 + 64 * (j))
#define XB_XGEN(j)  (2304 + 64 * (j))
#define XB_TOP      3328
#define XB_TOPGEN   3392
#define XCD_BAR_WORDS 3456
#define XB_SPIN_CAP (1u << 18)

__device__ __forceinline__ unsigned xb_ld(unsigned* p)              { return __hip_atomic_load(p, __ATOMIC_RELAXED, __HIP_MEMORY_SCOPE_AGENT); }
__device__ __forceinline__ unsigned xb_add(unsigned* p, unsigned v) { return __hip_atomic_fetch_add(p, v, __ATOMIC_RELAXED, __HIP_MEMORY_SCOPE_AGENT); }
__device__ __forceinline__ unsigned xb_xcc_id() { return (unsigned)__builtin_amdgcn_s_getreg((3 << 11) | 20) & 0xFu; }
#define XB_SPIN(cond, bar) do { unsigned _sp = 0; while (cond) { __builtin_amdgcn_s_sleep(1); \
    if ((++_sp & 255u) == 0u) { if (xb_ld(&(bar)[XB_TMO])) break; if (_sp > XB_SPIN_CAP) { atomicAdd(&(bar)[XB_TMO], 1u); break; } } } } while (0)

struct XcdBarrier {
    unsigned* bar; unsigned x;
    volatile LAS unsigned* st;
};

__device__ __forceinline__ XcdBarrier xcd_barrier_post(unsigned* bar, volatile LAS unsigned* st) {
    XcdBarrier b; b.bar = bar; b.x = xb_xcc_id(); b.st = st;
    if (threadIdx.x == 0) (void)xb_add(&bar[XB_XCNT(b.x)], 1u);
    return b;
}
__device__ __forceinline__ void xcd_barrier_complete(unsigned* bar, unsigned x, unsigned& nloc, unsigned& nx) {
    const unsigned G = gridDim.x * gridDim.y * gridDim.z;
    unsigned sum, cnt, mine, sp = 0u;
    for (;;) {
        sum = 0u; cnt = 0u; mine = 0u;
#pragma unroll
        for (unsigned j = 0; j < 16; ++j) { const unsigned c = xb_ld(&bar[XB_XCNT(j)]); sum += c; cnt += (c > 0u) ? 1u : 0u; mine = (j == x) ? c : mine; }
        if (sum == G) break;
        __builtin_amdgcn_s_sleep(1);
        if ((++sp & 255u) == 0u) { if (xb_ld(&bar[XB_TMO])) break; if (sp > XB_SPIN_CAP) { atomicAdd(&bar[XB_TMO], 1u); break; } }
    }
    nloc = mine > 0u ? mine : 1u; nx = cnt > 0u ? cnt : 1u;
}

__device__ __forceinline__ void xcd_barrier(const XcdBarrier& b) {
    asm volatile("s_waitcnt vmcnt(0)" ::: "memory");
    __syncthreads();
    if (threadIdx.x == 0) {
        unsigned* bar = b.bar;
        __builtin_amdgcn_s_waitcnt(0);
        unsigned nloc = b.st[0], nx = b.st[1];
        if (nloc == 0u) { xcd_barrier_complete(bar, b.x, nloc, nx); b.st[0] = nloc; b.st[1] = nx; }
        const unsigned old = xb_add(&bar[XB_XSUB(b.x)], 1u);
        const unsigned gen = old / nloc;
        if (old + 1u == (gen + 1u) * nloc) {
            __builtin_amdgcn_fence(__ATOMIC_RELEASE, "agent");
            asm volatile("s_waitcnt vmcnt(0)" ::: "memory");
            const unsigned og = xb_add(&bar[XB_TOP], 1u);
            const unsigned tg = og / nx;
            if (og + 1u == (tg + 1u) * nx) xb_add(&bar[XB_TOPGEN], 1u);
            else XB_SPIN(xb_ld(&bar[XB_TOPGEN]) == tg, bar);
            __builtin_amdgcn_fence(__ATOMIC_ACQUIRE, "agent");
            xb_add(&bar[XB_XGEN(b.x)], 1u);
            asm volatile("s_waitcnt vmcnt(0)" ::: "memory");
        } else {
            XB_SPIN(xb_ld(&bar[XB_XGEN(b.x)]) == gen, bar);
            __builtin_amdgcn_fence(__ATOMIC_ACQUIRE, "agent");
            asm volatile("s_waitcnt vmcnt(0)" ::: "memory");
        }
    }
    __syncthreads();
}

struct Args { const float* in[28]; float* out; unsigned char* ws; int lo, hi; };
enum { I_XP = 0, I_XS, I_SSSM, I_SCONV, I_SK, I_SV, I_META, I_SSMG, I_WIN, I_CONVW, I_CONVB, I_DTB, I_ALOG, I_DSKIP, I_GATEG, I_WOUT, I_KVG, I_WK, I_WV,
       I_ATTNG, I_WQ, I_SINKS, I_WOP, I_FFNG, I_WGATE, I_WUP, I_WDOWN, I_FING };

__device__ __forceinline__ void p0_item(const float* W, int ld, int col0, const float* g, float sc, bf16_t* WT, int K, int drow0, int k0, LAS float* scr, int lane) {
    const int kk = lane >> 3, n4 = (lane & 7) * 4;
    f32x4 v[8];
#pragma unroll
    for (int i = 0; i < 8; ++i) { v[i] = (f32x4){0.f, 0.f, 0.f, 0.f};
        if (W) v[i] = __builtin_nontemporal_load((const f32x4*)(W + (size_t)(k0 + 8 * i + kk) * ld + col0 + n4)) * ((g ? g[k0 + 8 * i + kk] : 1.0f) * sc); }
#pragma unroll
    for (int i = 0; i < 8; ++i) { LAS float* d = scr + (8 * i + kk) * 33 + n4; d[0] = v[i][0]; d[1] = v[i][1]; d[2] = v[i][2]; d[3] = v[i][3]; }
    asm volatile("s_waitcnt lgkmcnt(0)" ::: "memory");
    const int c = lane & 7;
#pragma unroll
    for (int j = 0; j < 4; ++j) { const int n = (lane >> 3) + 8 * j; const LAS float* s = scr + (8 * c) * 33 + n;
        u32x4 o; o.x = cvt_pk_bf16(s[0], s[33]); o.y = cvt_pk_bf16(s[66], s[99]); o.z = cvt_pk_bf16(s[132], s[165]); o.w = cvt_pk_bf16(s[198], s[231]);
        *(u32x4*)(WT + (size_t)(drow0 + n) * K + k0 + 8 * c) = o; }
    asm volatile("s_waitcnt lgkmcnt(0)" ::: "memory");
}
__device__ __forceinline__ const float* src_row(const Args& a, int m) {
    if (m < TP) { const int b = m / LP, t = m - b * LP; return t < 16 ? a.in[I_META] + (size_t)t * DM : a.in[I_XP] + ((size_t)b * 2048 + (t - 16)) * DM; }
    return a.in[I_XS] + (size_t)(m - TP) * DM;
}
__device__ __forceinline__ void p0_prologue(const Args& a, LAS unsigned char* lds) {
    const int tid = threadIdx.x, lane = tid & 63, wave = __builtin_amdgcn_readfirstlane(tid >> 6);
    const int gw = blockIdx.x * 8 + wave, NGW = gridDim.x * 8;
    unsigned char* ws = a.ws;
    LAS float* scr = (LAS float*)(lds + wave * 8704);
    constexpr int N0 = (NIN / 32) * 16, N1 = 32 * 32, N2 = 176 * 16, N3 = N2, N4 = 32 * 44, N5 = N4, N6 = 48 * 16, N7 = 32 * 16;
    constexpr int NITEMS = N0 + N1 + N2 + N3 + N4 + N5 + N6 + N7;
    for (int it = gw; it < NITEMS; it += NGW) {
        int r = it;
        if (r < N0) { const int nb = r / 16, kb = r % 16; const bool real = nb * 32 < 5152;
            p0_item(real ? a.in[I_WIN] : nullptr, 5152, nb * 32, a.in[I_SSMG], 1.f, (bf16_t*)(ws + WS_WIN), 1024, nb * 32, kb * 64, scr, lane); continue; } r -= N0;
        if (r < N1) { const int nb = r / 32, kb = r % 32;
            p0_item(a.in[I_WOUT], 1024, nb * 32, a.in[I_GATEG], 1.f, (bf16_t*)(ws + WS_WOUT), 2048, nb * 32, kb * 64, scr, lane); continue; } r -= N1;
        if (r < N2 + N3) { const int layer = r >= N2; if (layer) r -= N2; const int nb = r / 16, kb = r % 16, tile = nb >> 3, w = nb & 7;
            const float* src = (w < 4 ? a.in[I_WGATE] : a.in[I_WUP]) + (size_t)layer * 1024 * DFF;
            p0_item(src, DFF, tile * 128 + (w & 3) * 32, a.in[I_FFNG] + layer * 1024, 1.f, (bf16_t*)(ws + (layer ? WS_WGU1 : WS_WGU0)), 1024, nb * 32, kb * 64, scr, lane); continue; } r -= N2 + N3;
        if (r < N4 + N5) { const int layer = r >= N4; if (layer) r -= N4; const int nb = r / 44, kb = r % 44;
            p0_item(a.in[I_WDOWN] + (size_t)layer * DFF * 1024, 1024, nb * 32, nullptr, 1.f, (bf16_t*)(ws + (layer ? WS_WD1 : WS_WD0)), DFF, nb * 32, kb * 64, scr, lane); continue; } r -= N4 + N5;
        if (r < N6) { const int nb = r / 16, kb = r % 16;
            if (nb < 8) p0_item(a.in[I_WK], 256, nb * 32, a.in[I_KVG], 1.f, (bf16_t*)(ws + WS_WKVQ), 1024, nb * 32, kb * 64, scr, lane);
            else if (nb < 16) p0_item(a.in[I_WV], 256, (nb - 8) * 32, a.in[I_KVG], 1.f, (bf16_t*)(ws + WS_WKVQ), 1024, nb * 32, kb * 64, scr, lane);
            else p0_item(a.in[I_WQ], 1024, (nb - 16) * 32, a.in[I_ATTNG], 0.125f, (bf16_t*)(ws + WS_WKVQ), 1024, nb * 32, kb * 64, scr, lane);
            continue; } r -= N6;
        { const int nb = r / 16, kb = r % 16; p0_item(a.in[I_WOP], 1024, nb * 32, nullptr, 1.f, (bf16_t*)(ws + WS_WO), 1024, nb * 32, kb * 64, scr, lane); }
    }
    float* ss = (float*)(ws + WS_SS);
    bf16_t* hb = (bf16_t*)(ws + WS_HB);
    for (int m0 = gw; m0 < T; m0 += 2 * NGW) {
        const int m1 = m0 + NGW < T ? m0 + NGW : m0;
        const f32x4* xa = (const f32x4*)src_row(a, m0) + lane; const f32x4* xb = (const f32x4*)src_row(a, m1) + lane; f32x4 va[4], vb[4]; float sa = 0.f, sb = 0.f;
#pragma unroll
        for (int j = 0; j < 4; ++j) { va[j] = __builtin_nontemporal_load(xa + 64 * j); vb[j] = __builtin_nontemporal_load(xb + 64 * j); }
#pragma unroll
        for (int j = 0; j < 4; ++j) { sa += (va[j][0] * va[j][0] + va[j][1] * va[j][1]) + (va[j][2] * va[j][2] + va[j][3] * va[j][3]); sb += (vb[j][0] * vb[j][0] + vb[j][1] * vb[j][1]) + (vb[j][2] * vb[j][2] + vb[j][3] * vb[j][3]); }
        sa = wave_sum(sa); sb = wave_sum(sb);
        u32x2* oa = (u32x2*)(hb + (size_t)m0 * DM) + lane; u32x2* ob = (u32x2*)(hb + (size_t)m1 * DM) + lane;
#pragma unroll
        for (int j = 0; j < 4; ++j) { u32x2 w; w.x = cvt_pk_bf16(va[j][0], va[j][1]); w.y = cvt_pk_bf16(va[j][2], va[j][3]); oa[64 * j] = w; w.x = cvt_pk_bf16(vb[j][0], vb[j][1]); w.y = cvt_pk_bf16(vb[j][2], vb[j][3]); ob[64 * j] = w; }
        if (lane == 0) { ss[m0] = sa; ss[T + m0] = 0.f; ss[2 * T + m0] = 0.f; ss[3 * T + m0] = 0.f; ss[4 * T + m0] = 0.f; ss[m1] = sb; ss[T + m1] = 0.f; ss[2 * T + m1] = 0.f; ss[3 * T + m1] = 0.f; ss[4 * T + m1] = 0.f; }
    }
    float* rope = (float*)(ws + WS_ROPE);
    for (int e = blockIdx.x * 512 + tid; e < 2072 * 8; e += gridDim.x * 512) {
        const int pi = e >> 3, i = e & 7; const double pos = (double)(pi < LP ? pi : 16384 + pi - LP);
        const double inv = i == 0 ? 1.0 : i == 1 ? 0.19392274474868576 : i == 2 ? 0.03760603093086393 : i == 3 ? 0.007292664737217109 : i == 4 ? 0.001414213562373095
                         : i == 5 ? 0.0002742481756762073 : i == 6 ? 5.318295896944988e-05 : 1.031338537721246e-05;
        const double rev = pos * inv * 0.15915494309189535; const float fr = (float)(rev - __builtin_rint(rev));
        rope[pi * 16 + i] = __builtin_amdgcn_cosf(fr); rope[pi * 16 + 8 + i] = __builtin_amdgcn_sinf(fr);
    }
}

__device__ __forceinline__ void conv8(const u32x4 (&cur)[4], const float (&w)[4][8], const float (&bias)[8], const bool (&zero)[4], float (&o)[8]) {
#pragma unroll
    for (int e = 0; e < 8; ++e) o[e] = bias[e];
#pragma unroll
    for (int k = 0; k < 4; ++k) {
        const unsigned wd[4] = {cur[k].x, cur[k].y, cur[k].z, cur[k].w};
#pragma unroll
        for (int e = 0; e < 8; ++e) { const float v = (e & 1) ? bf_hi(wd[e >> 1]) : bf_lo(wd[e >> 1]); o[e] += zero[k] ? 0.f : w[k][e] * v; }
    }
#pragma unroll
    for (int e = 0; e < 8; ++e) o[e] = silu_f(o[e]);
}
__device__ __forceinline__ void conv_phase(const Args& a, LAS unsigned char* lds) {
    const int tid = threadIdx.x, r = tid >> 3, ch = tid & 7;
    bf16_t* zx = (bf16_t*)(a.ws + WS_BIG);
    const int NPT = NBATCH * 48, NST = 16 * 48;
    for (int task = blockIdx.x; task < NPT + NST; task += gridDim.x) {
        const bool samp = task >= NPT; const int tt = samp ? task - NPT : task; const int cb = tt % 48, bb = tt / 48;
        const int col = cb * 64 + 8 * ch;
        float w[4][8], bias[8];
#pragma unroll
        for (int k = 0; k < 4; ++k) { const f32x4 w0 = *(const f32x4*)(a.in[I_CONVW] + k * CONVD + col), w1 = *(const f32x4*)(a.in[I_CONVW] + k * CONVD + col + 4);
#pragma unroll
            for (int e = 0; e < 4; ++e) { w[k][e] = w0[e]; w[k][4 + e] = w1[e]; } }
        { const f32x4 b0 = *(const f32x4*)(a.in[I_CONVB] + col), b1 = *(const f32x4*)(a.in[I_CONVB] + col + 4);
#pragma unroll
            for (int e = 0; e < 4; ++e) { bias[e] = b0[e]; bias[4 + e] = b1[e]; } }
        if (!samp) {
            const size_t rowb = (size_t)bb * LP; bf16_t* base = zx + 2048 + col;
            float* ncv = a.out + O_CONVP + (size_t)bb * 3 * CONVD + col;
            u32x4 own[2], halo = {0u, 0u, 0u, 0u};
#define CONV_LOAD(t0) do { _Pragma("unroll") for (int q = 0; q < 2; ++q) { int tg = (t0) + r + 64 * q; tg = tg >= LP ? LP - 1 : tg; own[q] = __builtin_nontemporal_load((const u32x4*)(base + (rowb + tg) * ZXW)); } \
                if (tid < 24) { const int th = (t0) - 3 + (tid >> 3); if (th >= 0) halo = *(const u32x4*)(base + (rowb + th) * ZXW); else halo = (u32x4){0u, 0u, 0u, 0u}; } } while (0)
            CONV_LOAD(2048);
            for (int kt = 0; kt < 17; ++kt) {
                const int t0 = 2048 - 128 * kt;
                LAS unsigned char* tile = lds + (kt & 1) * (131 * 128);
#pragma unroll
                for (int q = 0; q < 2; ++q) *(LAS u32x4*)(tile + (3 + r + 64 * q) * 128 + ch * 16) = own[q];
                if (tid < 24) *(LAS u32x4*)(tile + (tid >> 3) * 128 + ch * 16) = halo;
                const u32x4 raw[2] = {own[0], own[1]};
                if (kt + 1 < 17) CONV_LOAD(t0 - 128);
                asm volatile("s_waitcnt lgkmcnt(0)" ::: "memory"); __builtin_amdgcn_s_barrier(); asm volatile("" ::: "memory");
#pragma unroll
                for (int q = 0; q < 2; ++q) {
                    const int t = t0 + r + 64 * q;
                    u32x4 cur[4];
#pragma unroll
                    for (int k = 0; k < 4; ++k) cur[k] = *(const LAS u32x4*)(tile + (r + 64 * q + k) * 128 + ch * 16);
                    const bool zero[4] = {false, false, false, false};
                    float o[8]; conv8(cur, w, bias, zero, o);
                    if (t < LP) {
                        __builtin_nontemporal_store(((u32x4){cvt_pk_bf16(o[0], o[1]), cvt_pk_bf16(o[2], o[3]), cvt_pk_bf16(o[4], o[5]), cvt_pk_bf16(o[6], o[7])}), (u32x4*)(base + (rowb + t) * ZXW));
                        if (t >= LP - 3) { float* d = ncv + (size_t)(t - (LP - 3)) * CONVD;
                            *(f32x4*)d = (f32x4){bf_lo(raw[q].x), bf_hi(raw[q].x), bf_lo(raw[q].y), bf_hi(raw[q].y)}; *(f32x4*)(d + 4) = (f32x4){bf_lo(raw[q].z), bf_hi(raw[q].z), bf_lo(raw[q].w), bf_hi(raw[q].w)}; }
                    }
                }
            }
#undef CONV_LOAD
        } else {
            const int b = bb * 8 + (r >> 3), t = r & 7; const size_t row = (size_t)TP + b * 8 + t; bf16_t* base = zx + 2048 + col;
            u32x4 cur[4];
#pragma unroll
            for (int k = 0; k < 4; ++k) { const int tk = t - 3 + k;
                if (tk >= 0) cur[k] = *(const u32x4*)(base + (row - 3 + k) * ZXW);
                else { const float* sc = a.in[I_SCONV] + ((size_t)b * 3 + (3 + tk)) * CONVD + col; const f32x4 s0 = *(const f32x4*)sc, s1 = *(const f32x4*)(sc + 4); cur[k] = pack8(s0, s1); } }
            const bool zero[4] = {false, false, false, false};
            float o[8]; conv8(cur, w, bias, zero, o);
            const u32x4 raw = cur[3];
            __syncthreads();
            *(u32x4*)(base + row * ZXW) = (u32x4){cvt_pk_bf16(o[0], o[1]), cvt_pk_bf16(o[2], o[3]), cvt_pk_bf16(o[4], o[5]), cvt_pk_bf16(o[6], o[7])};
            if (t >= 5) { float* d = a.out + O_CONVS + ((size_t)b * 3 + (t - 5)) * CONVD + col;
                *(f32x4*)d = (f32x4){bf_lo(raw.x), bf_hi(raw.x), bf_lo(raw.y), bf_hi(raw.y)}; *(f32x4*)(d + 4) = (f32x4){bf_lo(raw.z), bf_hi(raw.z), bf_lo(raw.w), bf_hi(raw.w)}; }
        }
        __syncthreads();
    }
}

#define WG_BAR() do { asm volatile("s_waitcnt lgkmcnt(0)" ::: "memory"); __builtin_amdgcn_s_barrier(); asm volatile("" ::: "memory"); } while (0)
constexpr int L_CM = 0, L_BM = 8704, L_XN = 17408, L_XD = 26112, L_XW = 34816, L_ZN = 43520, L_UN = 52224, L_SET = 61440, L_DTB = 2 * L_SET;
typedef short s16x4 __attribute__((ext_vector_type(4)));
__device__ __forceinline__ bf16x8 tr8(const LAS unsigned char* p0, const LAS unsigned char* p1) {
    const s16x4 a = __builtin_amdgcn_ds_read_tr16_b64_v4i16((LAS s16x4*)p0), b = __builtin_amdgcn_ds_read_tr16_b64_v4i16((LAS s16x4*)p1);
    return (bf16x8){a[0], a[1], a[2], a[3], b[0], b[1], b[2], b[3]};
}
template <bool DUMMY> __device__ __forceinline__ void ssd_phase(const Args& a, LAS unsigned char* lds) {
    const int tid = threadIdx.x, lane = tid & 63, wave = __builtin_amdgcn_readfirstlane(tid >> 6), fr = lane & 15, fq = lane >> 4;
    bf16_t* zx = (bf16_t*)(a.ws + WS_BIG);
    const float* dtraw = (const float*)(a.ws + WS_DT);
    const bool loader = wave >= 4;
    const int NUNITS = 256 + 2048;
    for (int unit = blockIdx.x; unit < NUNITS; unit += gridDim.x) {
        const bool samp = unit >= 256; int b, g, hp;
        if (!samp) { b = unit >> 4; g = (unit >> 2) & 3; hp = unit & 3; } else { const int u2 = unit - 256; b = u2 >> 4; g = (u2 >> 2) & 3; hp = u2 & 3; }
        const int row0 = samp ? TP + b * 8 : b * LP, L = samp ? 8 : LP, nch = samp ? 1 : 65, h0 = g * 8 + hp * 2;
        const int ltid = tid & 255, t1 = ltid >> 4, ch1 = ltid & 15;
        const int xcol = 2048 + h0 * 64 + 8 * ch1, bcol = 2048 + 2048 + g * 128 + 8 * ch1, ccol = 2048 + 2560 + g * 128 + 8 * ch1, zcol1 = h0 * 64 + 8 * ch1;
        const int dth = lane >> 5;
        const float dtbias = (wave == 7) ? a.in[I_DTB][h0 + dth] : 0.f, negA = (wave == 7) ? -__expf(a.in[I_ALOG][h0 + dth]) : 0.f;
        const int hh = (wave >> 1) & 1, ph = wave & 1, h = h0 + hh, pcol = hh * 64 + ph * 32;
        const float dskip = a.in[I_DSKIP][h];
        f32x4 st[2][8];
#pragma unroll
        for (int pt = 0; pt < 2; ++pt)
#pragma unroll
            for (int nt = 0; nt < 8; ++nt) st[pt][nt] = (f32x4){0.f, 0.f, 0.f, 0.f};
        if (samp && !loader) {
#pragma unroll
            for (int pt = 0; pt < 2; ++pt) { const float* sp = a.in[I_SSSM] + ((size_t)(b * NH + h) * 64 + ph * 32 + pt * 16 + fr) * 128 + 4 * fq;
#pragma unroll
                for (int nt = 0; nt < 8; ++nt) st[pt][nt] = *(const f32x4*)(sp + 16 * nt); } }
        u32x4 xg[2], bg[2], cg[2], zg[2];
        float dtr = 0.f;
#define SSD_FETCH(c) do { if (loader) { int t_o = t1; asm volatile("" : "+v"(t_o)); _Pragma("unroll") for (int q = 0; q < 2; ++q) { int tg = 32 * (c) + t_o + 16 * q; tg = tg >= L ? L - 1 : tg; const bf16_t* rp = zx + (size_t)(row0 + tg) * ZXW; \
            xg[q] = *(const u32x4*)(rp + xcol); bg[q] = *(const u32x4*)(rp + bcol); cg[q] = *(const u32x4*)(rp + ccol); zg[q] = *(const u32x4*)(rp + zcol1); } } } while (0)
#define SSD_DTLOAD(c) do { if (wave == 7) { int tg = 32 * (c) + (lane & 31); tg = tg >= L ? L - 1 : tg; dtr = dtraw[(size_t)(row0 + tg) * 32 + h0 + dth]; } } while (0)
#define SSD_DT(c) do { if (wave == 7) { const int tg = 32 * (c) + (lane & 31); float dt = 0.f; \
            if (tg < L) { const float x = dtr + dtbias; dt = fmaxf(x, 0.f) + __logf(1.0f + __expf(-fabsf(x))); } \
            float cs = dt * negA; \
            _Pragma("unroll") for (int o = 1; o < 32; o <<= 1) { const float up = __shfl_up(cs, o); if ((lane & 31) >= o) cs += up; } \
            const float cl = __shfl(cs, (lane & 32) | 31); \
            LAS float* d = (LAS float*)(lds + L_DTB) + (((c) % 3) * 2 + dth) * 96; d[lane & 31] = cs; d[32 + (lane & 31)] = dt; d[64 + (lane & 31)] = __expf(cl - cs); } } while (0)
#define SSD_STAGE1(cc) do { if (loader) { LAS unsigned char* ts1 = lds + ((cc) & 1) * L_SET; \
            const LAS float* dtb = (const LAS float*)(lds + L_DTB) + (((cc) % 3) * 2 + (ch1 >> 3)) * 96; \
            _Pragma("unroll") for (int q = 0; q < 2; ++q) { const int tq = t1 + 16 * q; \
                const bool valid = 32 * (cc) + tq < L; \
                const float dt = dtb[32 + tq], dw = dt * dtb[64 + tq]; \
                const u32x4 z4 = {0u, 0u, 0u, 0u}; \
                const u32x4 xv = valid ? xg[q] : z4; \
                const unsigned xw4[4] = {xv.x, xv.y, xv.z, xv.w}; \
                unsigned od[4], ow[4]; \
                _Pragma("unroll") for (int e = 0; e < 4; ++e) { const float lo = bf_lo(xw4[e]), hi = bf_hi(xw4[e]); od[e] = cvt_pk_bf16(lo * dt, hi * dt); ow[e] = cvt_pk_bf16(lo * dw, hi * dw); } \
                const int lo_ = tq * 272 + ch1 * 16; \
                *(LAS u32x4*)(ts1 + L_CM + lo_) = valid ? cg[q] : z4; \
                *(LAS u32x4*)(ts1 + L_BM + lo_) = valid ? bg[q] : z4; \
                *(LAS u32x4*)(ts1 + L_XN + lo_) = xv; \
                *(LAS u32x4*)(ts1 + L_XD + lo_) = (u32x4){od[0], od[1], od[2], od[3]}; \
                *(LAS u32x4*)(ts1 + L_XW + lo_) = (u32x4){ow[0], ow[1], ow[2], ow[3]}; \
                *(LAS u32x4*)(ts1 + L_ZN + lo_) = zg[q]; } } } while (0)
#define SSD_USTORE(cc) do { if (loader && !DUMMY) { _Pragma("unroll") for (int q = 0; q < 2; ++q) { const int tg = 32 * (cc) + t1 + 16 * q; \
            if (tg < L) *(u32x4*)(zx + (size_t)(row0 + tg) * ZXW + zcol1) = *(const LAS u32x4*)(lds + ((cc) & 1) * L_SET + L_UN + (t1 + 16 * q) * 272 + ch1 * 16); } } } while (0)
        SSD_FETCH(0); SSD_DTLOAD(0);
        __syncthreads();
        SSD_DT(0); if (nch > 1) SSD_DTLOAD(1);
        WG_BAR();
        SSD_STAGE1(0);
        if (nch > 1) { SSD_FETCH(1); SSD_DT(1); if (nch > 2) SSD_DTLOAD(2); }
        WG_BAR();
        for (int c = 0; c < nch; ++c) {
            if (loader) {
                if (c > 0) SSD_USTORE(c - 1);
                if (c + 1 < nch) {
                    SSD_STAGE1(c + 1);
                    if (c + 2 < nch) { SSD_FETCH(c + 2); SSD_DT(c + 2); if (c + 3 < nch) SSD_DTLOAD(c + 3); }
                }
            } else {
                LAS unsigned char* tsm = lds + (c & 1) * L_SET;
                const LAS float* dcs = (const LAS float*)(lds + L_DTB) + ((c % 3) * 2 + hh) * 96;
                f32x4 g00 = {0.f, 0.f, 0.f, 0.f}, g01 = g00, g11 = g00;
#pragma unroll
                for (int sl = 0; sl < 4; ++sl) {
                    const bf16x8 b0 = *(const LAS bf16x8*)(tsm + L_BM + fr * 272 + sl * 64 + fq * 16), b1 = *(const LAS bf16x8*)(tsm + L_BM + (16 + fr) * 272 + sl * 64 + fq * 16);
                    const bf16x8 c0 = *(const LAS bf16x8*)(tsm + L_CM + fr * 272 + sl * 64 + fq * 16), c1 = *(const LAS bf16x8*)(tsm + L_CM + (16 + fr) * 272 + sl * 64 + fq * 16);
                    g00 = __builtin_amdgcn_mfma_f32_16x16x32_bf16(b0, c0, g00, 0, 0, 0);
                    g01 = __builtin_amdgcn_mfma_f32_16x16x32_bf16(b0, c1, g01, 0, 0, 0);
                    g11 = __builtin_amdgcn_mfma_f32_16x16x32_bf16(b1, c1, g11, 0, 0, 0);
                }
                f32x4 yo[2][2];
#pragma unroll
                for (int pt = 0; pt < 2; ++pt) { yo[pt][0] = (f32x4){0.f, 0.f, 0.f, 0.f}; yo[pt][1] = yo[pt][0]; }
#pragma unroll
                for (int sl = 0; sl < 4; ++sl) {
                    bf16x8 av[2];
#pragma unroll
                    for (int tt = 0; tt < 2; ++tt) { const LAS unsigned char* cp = tsm + L_CM + (16 * tt + fr) * 272 + sl * 64 + fq * 8;
                        const u32x2 lo = *(const LAS u32x2*)cp, hi = *(const LAS u32x2*)(cp + 32); av[tt] = __builtin_bit_cast(bf16x8, ((u32x4){lo.x, lo.y, hi.x, hi.y})); }
#pragma unroll
                    for (int pt = 0; pt < 2; ++pt) {
                        u32x4 sb; sb.x = cvt_pk_bf16(st[pt][2 * sl][0], st[pt][2 * sl][1]); sb.y = cvt_pk_bf16(st[pt][2 * sl][2], st[pt][2 * sl][3]); sb.z = cvt_pk_bf16(st[pt][2 * sl + 1][0], st[pt][2 * sl + 1][1]); sb.w = cvt_pk_bf16(st[pt][2 * sl + 1][2], st[pt][2 * sl + 1][3]);
                        const bf16x8 sbv = __builtin_bit_cast(bf16x8, sb);
                        yo[pt][0] = __builtin_amdgcn_mfma_f32_16x16x32_bf16(av[0], sbv, yo[pt][0], 0, 0, 0);
                        yo[pt][1] = __builtin_amdgcn_mfma_f32_16x16x32_bf16(av[1], sbv, yo[pt][1], 0, 0, 0);
                    }
                }
                const f32x4 cslo = *(const LAS f32x4*)(dcs + 4 * fq), cshi = *(const LAS f32x4*)(dcs + 16 + 4 * fq);
                const float cst0 = dcs[fr], cst1 = dcs[16 + fr];
                float m0[4], m1a[4], m1b[4];
#pragma unroll
                for (int j = 0; j < 4; ++j) {
                    const int s = 4 * fq + j;
                    m0[j] = (s <= fr) ? g00[j] * __expf(cst0 - cslo[j]) : 0.f;
                    m1a[j] = g01[j] * __expf(cst1 - cslo[j]);
                    m1b[j] = (s <= fr) ? g11[j] * __expf(cst1 - cshi[j]) : 0.f;
                }
                const bf16x8 md0 = __builtin_bit_cast(bf16x8, ((u32x4){cvt_pk_bf16(m0[0], m0[1]), cvt_pk_bf16(m0[2], m0[3]), 0u, 0u}));
                const bf16x8 md1 = __builtin_bit_cast(bf16x8, ((u32x4){cvt_pk_bf16(m1a[0], m1a[1]), cvt_pk_bf16(m1a[2], m1a[3]), cvt_pk_bf16(m1b[0], m1b[1]), cvt_pk_bf16(m1b[2], m1b[3])}));
                const float dch = __expf(dcs[31]);
                const int btoff = (8 * fq + (fr >> 2)) * 272 + (4 * (fr & 3)) * 2;
#pragma unroll
                for (int pt = 0; pt < 2; ++pt) {
                    const int troff = (fr >> 2) * 272 + (pcol + 16 * pt + 4 * (fr & 3)) * 2;
                    const bf16x8 xdv = tr8(tsm + L_XD + (4 * fq) * 272 + troff, tsm + L_XD + (16 + 4 * fq) * 272 + troff);
                    f32x4 yd[2];
                    yd[0] = __builtin_amdgcn_mfma_f32_16x16x32_bf16(md0, xdv, ((f32x4){0.f, 0.f, 0.f, 0.f}), 0, 0, 0);
                    yd[1] = __builtin_amdgcn_mfma_f32_16x16x32_bf16(md1, xdv, ((f32x4){0.f, 0.f, 0.f, 0.f}), 0, 0, 0);
#pragma unroll
                    for (int tt = 0; tt < 2; ++tt) {
                        const f32x4 cst = *(const LAS f32x4*)(dcs + 16 * tt + 4 * fq);
                        const s16x4 xs4 = __builtin_amdgcn_ds_read_tr16_b64_v4i16((LAS s16x4*)(tsm + L_XN + (16 * tt + 4 * fq) * 272 + troff));
                        const s16x4 zs4 = __builtin_amdgcn_ds_read_tr16_b64_v4i16((LAS s16x4*)(tsm + L_ZN + (16 * tt + 4 * fq) * 272 + troff));
#pragma unroll
                        for (int j = 0; j < 4; ++j) {
                            const float y = __expf(cst[j]) * yo[pt][tt][j] + yd[tt][j] + dskip * bf1((unsigned short)xs4[j]);
                            const float z = bf1((unsigned short)zs4[j]);
                            *(LAS unsigned short*)(tsm + L_UN + (16 * tt + 4 * fq + j) * 272 + (pcol + 16 * pt + fr) * 2) = (unsigned short)(cvt_pk_bf16(y * silu_f(z), 0.f) & 0xffffu);
                        }
                    }
                }
                bf16x8 xwv[2];
#pragma unroll
                for (int pt = 0; pt < 2; ++pt) { const int troff = (fr >> 2) * 272 + (pcol + 16 * pt + 4 * (fr & 3)) * 2; xwv[pt] = tr8(tsm + L_XW + (8 * fq) * 272 + troff, tsm + L_XW + (8 * fq + 4) * 272 + troff); }
#pragma unroll
                for (int nt = 0; nt < 8; ++nt) {
                    const bf16x8 btv = tr8(tsm + L_BM + btoff + nt * 32, tsm + L_BM + btoff + 4 * 272 + nt * 32);
                    st[0][nt] = __builtin_amdgcn_mfma_f32_16x16x32_bf16(btv, xwv[0], st[0][nt] * dch, 0, 0, 0);
                    st[1][nt] = __builtin_amdgcn_mfma_f32_16x16x32_bf16(btv, xwv[1], st[1][nt] * dch, 0, 0, 0);
                }
            }
            WG_BAR();
        }
        SSD_USTORE(nch - 1);
        if (!loader) {
#pragma unroll
            for (int pt = 0; pt < 2; ++pt) { float* sp = a.out + (samp ? O_SSMS : O_SSMP) + ((size_t)(b * NH + h) * 64 + ph * 32 + pt * 16 + fr) * 128 + 4 * fq;
#pragma unroll
                for (int nt = 0; nt < 8; ++nt) *(f32x4*)(sp + 16 * nt) = st[pt][nt]; } }
#undef SSD_FETCH
#undef SSD_DT
#undef SSD_DTLOAD
#undef SSD_STAGE1
#undef SSD_USTORE
    }
}

__device__ __forceinline__ void gatenorm_phase(const Args& a) {
    const int lane = threadIdx.x & 63, wave = threadIdx.x >> 6; const int gw = blockIdx.x * 8 + wave, NGW = gridDim.x * 8;
    bf16_t* zx = (bf16_t*)(a.ws + WS_BIG);
    for (int m0 = gw; m0 < T; m0 += 2 * NGW) {
        const int m1 = m0 + NGW < T ? m0 + NGW : m0;
        u32x4* p[2] = {(u32x4*)(zx + (size_t)m0 * ZXW) + lane, (u32x4*)(zx + (size_t)m1 * ZXW) + lane}; u32x4 v[2][4];
#pragma unroll
        for (int q = 0; q < 2; ++q)
#pragma unroll
            for (int i = 0; i < 4; ++i) v[q][i] = __builtin_nontemporal_load(p[q] + 64 * i);
#pragma unroll
        for (int q = 0; q < 2; ++q)
#pragma unroll
            for (int i = 0; i < 4; ++i) {
                float f[8] = {bf_lo(v[q][i].x), bf_hi(v[q][i].x), bf_lo(v[q][i].y), bf_hi(v[q][i].y), bf_lo(v[q][i].z), bf_hi(v[q][i].z), bf_lo(v[q][i].w), bf_hi(v[q][i].w)};
                float s = 0.f;
#pragma unroll
                for (int e = 0; e < 8; ++e) s += f[e] * f[e];
                s = wave_sum(s); const float r = rsqrtf(s * (1.0f / 512.0f) + EPS);
                u32x4 o; o.x = cvt_pk_bf16(f[0] * r, f[1] * r); o.y = cvt_pk_bf16(f[2] * r, f[3] * r); o.z = cvt_pk_bf16(f[4] * r, f[5] * r); o.w = cvt_pk_bf16(f[6] * r, f[7] * r);
                if (q == 0 || m1 != m0) p[q][64 * i] = o;
            }
    }
}

constexpr int A_KS = 0, A_VS = 39168;
__device__ __forceinline__ void attn_phase(const Args& a, LAS unsigned char* lds) {
    const int tid = threadIdx.x, lane = tid & 63, wave = __builtin_amdgcn_readfirstlane(tid >> 6), fr = lane & 15, fq = lane >> 4;
    const bf16_t* qb = (const bf16_t*)(a.ws + WS_Q); const bf16_t* kb = (const bf16_t*)(a.ws + WS_K); const bf16_t* vb = (const bf16_t*)(a.ws + WS_V);
    bf16_t* ob = (bf16_t*)(a.ws + WS_O);
    const int NPU = NBATCH * 17 * 4, NUNITS = NPU + DECB * 4;
    for (int unit = blockIdx.x; unit < NUNITS; unit += gridDim.x) {
        const bool samp = unit >= NPU; int b, nblk, g;
        if (!samp) { b = unit / 68; const int r = unit - b * 68; nblk = r >> 2; g = r & 3; } else { const int u2 = unit - NPU; b = u2 >> 2; g = u2 & 3; nblk = 0; }
        const int q0 = samp ? 16384 : 128 * nblk;
        const int seqrow = samp ? TP + b * 8 : b * LP;
        const int nrows = samp ? 8 : (LP - 128 * nblk < 128 ? LP - 128 * nblk : 128);
        __syncthreads();
        for (int idx = tid; idx < 272 * 8; idx += 512) {
            const int kl = idx >> 3, ch = idx & 7; const int kpos = q0 - 144 + kl;
            u32x4 kw = {0u, 0u, 0u, 0u}, vw = kw;
            if (!samp) { if (kpos >= 0 && kpos < LP) { const size_t r = (size_t)(seqrow + kpos) * 256 + g * 64 + 8 * ch; kw = *(const u32x4*)(kb + r); vw = *(const u32x4*)(vb + r); } }
            else if (kpos >= 16384) { if (kpos < 16384 + 8) { const size_t r = (size_t)(seqrow + kpos - 16384) * 256 + g * 64 + 8 * ch; kw = *(const u32x4*)(kb + r); vw = *(const u32x4*)(vb + r); } }
            else if (kpos >= 16256) { const int w = kpos - 16256; const size_t r = ((size_t)(b * 128 + w) * 4 + g) * 64 + 8 * ch;
                const f32x4 k0 = *(const f32x4*)(a.in[I_SK] + r), k1 = *(const f32x4*)(a.in[I_SK] + r + 4), v0 = *(const f32x4*)(a.in[I_SV] + r), v1 = *(const f32x4*)(a.in[I_SV] + r + 4);
                kw = pack8(k0, k1); vw = pack8(v0, v1);
                if (w >= 8) { const size_t d = ((size_t)(b * 128 + w - 8) * 4 + g) * 64 + 8 * ch; float* ko = a.out + O_KS + d; float* vo = a.out + O_VS + d;
                    *(f32x4*)ko = k0; *(f32x4*)(ko + 4) = k1; *(f32x4*)vo = v0; *(f32x4*)(vo + 4) = v1; } }
            *(LAS u32x4*)(lds + A_KS + kl * 144 + ch * 16) = kw;
            *(LAS u32x4*)(lds + A_VS + kl * 144 + ch * 16) = vw;
        }
        const int qt = wave;
        const bool qvalid = 16 * qt + fr < nrows;
        const size_t qrow = (size_t)(seqrow + (samp ? 0 : 128 * nblk) + 16 * qt + fr);
        u32x4 qall[4][2];
#pragma unroll
        for (int hq = 0; hq < 4; ++hq)
#pragma unroll
            for (int sl = 0; sl < 2; ++sl) { qall[hq][sl] = (u32x4){0u, 0u, 0u, 0u}; if (qvalid) qall[hq][sl] = *(const u32x4*)(qb + qrow * DM + (4 * g + hq) * 64 + 32 * sl + 8 * fq); }
        __syncthreads();
        if (16 * qt < nrows) {
            const int qpos = q0 + 16 * qt + fr;
#pragma unroll
            for (int hq = 0; hq < 4; ++hq) {
                const int head = 4 * g + hq;
                bf16x8 qf[2];
#pragma unroll
                for (int sl = 0; sl < 2; ++sl) qf[sl] = __builtin_bit_cast(bf16x8, qall[hq][sl]);
                f32x4 s[10];
                s[0] = (f32x4){-1e30f, -1e30f, -1e30f, -1e30f};
#pragma unroll
                for (int kt = 1; kt < 10; ++kt) {
                    s[kt] = (f32x4){0.f, 0.f, 0.f, 0.f};
#pragma unroll
                    for (int sl = 0; sl < 2; ++sl) { const bf16x8 kf = *(const LAS bf16x8*)(lds + A_KS + (16 * qt + 16 * kt + fr) * 144 + sl * 64 + fq * 16);
                        s[kt] = __builtin_amdgcn_mfma_f32_16x16x32_bf16(kf, qf[sl], s[kt], 0, 0, 0); }
                }
                const float sink = a.in[I_SINKS][head];
                float mx = sink;
                const bool near_start = q0 < 144;
#pragma unroll
                for (int kt = 1; kt < 10; ++kt)
#pragma unroll
                    for (int j = 0; j < 4; ++j) { const int dist = 144 + fr - (16 * kt + 4 * fq + j);
                        if (kt == 1 || kt == 9 || near_start) { const int kpos = qpos - dist; const bool ok = dist >= 0 && dist < 128 && kpos >= 0; s[kt][j] = ok ? s[kt][j] : -1e30f; }
                        mx = fmaxf(mx, s[kt][j]); }
                mx = fmaxf(mx, __shfl_xor(mx, 16)); mx = fmaxf(mx, __shfl_xor(mx, 32));
                float l = 0.f;
#pragma unroll
                for (int kt = 0; kt < 10; ++kt)
#pragma unroll
                    for (int j = 0; j < 4; ++j) { const float p = __expf(s[kt][j] - mx); s[kt][j] = p; l += p; }
                l += __shfl_xor(l, 16); l += __shfl_xor(l, 32);
                l += __expf(sink - mx);
                const float rl = 1.0f / l;
                f32x4 o[4] = {{0.f, 0.f, 0.f, 0.f}, {0.f, 0.f, 0.f, 0.f}, {0.f, 0.f, 0.f, 0.f}, {0.f, 0.f, 0.f, 0.f}};
#pragma unroll
                for (int ks = 0; ks < 5; ++ks) {
                    const bf16x8 pv = __builtin_bit_cast(bf16x8, ((u32x4){cvt_pk_bf16(s[2 * ks][0], s[2 * ks][1]), cvt_pk_bf16(s[2 * ks][2], s[2 * ks][3]), cvt_pk_bf16(s[2 * ks + 1][0], s[2 * ks + 1][1]), cvt_pk_bf16(s[2 * ks + 1][2], s[2 * ks + 1][3])}));
#pragma unroll
                    for (int dt = 0; dt < 4; ++dt) {
                        const LAS unsigned char* vp = lds + A_VS + (16 * qt + 32 * ks + 4 * fq + (fr >> 2)) * 144 + (16 * dt + 4 * (fr & 3)) * 2;
                        const bf16x8 vf = tr8(vp, vp + 16 * 144);
                        o[dt] = __builtin_amdgcn_mfma_f32_16x16x32_bf16(vf, pv, o[dt], 0, 0, 0);
                    }
                }
                if (qvalid) {
#pragma unroll
                    for (int dt = 0; dt < 4; ++dt) { u32x2 w; w.x = cvt_pk_bf16(o[dt][0] * rl, o[dt][1] * rl); w.y = cvt_pk_bf16(o[dt][2] * rl, o[dt][3] * rl);
                        *(u32x2*)(ob + qrow * DM + head * 64 + 16 * dt + 4 * fq) = w; }
                }
            }
        }
    }
}

__device__ __forceinline__ void final_phase(const Args& a) {
    const int lane = threadIdx.x & 63, wave = threadIdx.x >> 6; const int gw = blockIdx.x * 8 + wave, NGW = gridDim.x * 8;
    const float* ss4 = (const float*)(a.ws + WS_SS) + 4 * (size_t)T;
    const f32x4* gp = (const f32x4*)a.in[I_FING] + lane;
    f32x4 gv[4];
#pragma unroll
    for (int j = 0; j < 4; ++j) gv[j] = gp[64 * j];
    const bf16_t* hb = (const bf16_t*)(a.ws + WS_HB);
    for (int m0 = gw; m0 < T; m0 += 2 * NGW) {
        f32x4* p[2]; float r[2]; u32x2 v[2][4];
#pragma unroll
        for (int q = 0; q < 2; ++q) { const int m = m0 + q * NGW; p[q] = nullptr; r[q] = 0.f;
            if (m < T) { float* yrow = nullptr;
                if (m < TP) { const int b = m / LP, t = m - b * LP; if (t >= 16) yrow = a.out + O_YP + ((size_t)(b * 2048 + t - 16)) * DM; } else yrow = a.out + O_YS + (size_t)(m - TP) * DM;
                if (yrow) { p[q] = (f32x4*)yrow + lane; r[q] = rs_row(ss4, m);
#pragma unroll
                    for (int j = 0; j < 4; ++j) v[q][j] = ((const u32x2*)(hb + (size_t)m * DM) + lane)[64 * j]; } } }
#pragma unroll
        for (int q = 0; q < 2; ++q) if (p[q]) {
#pragma unroll
            for (int j = 0; j < 4; ++j) __builtin_nontemporal_store(((f32x4){bf_lo(v[q][j].x), bf_hi(v[q][j].x), bf_lo(v[q][j].y), bf_hi(v[q][j].y)} * r[q] * gv[j]), p[q] + 64 * j); }
    }
}

constexpr int NPHASE = 13;
__global__ void __launch_bounds__(512) yoco_fwd(Args a) {
    extern __shared__ __attribute__((aligned(16))) unsigned char lds_raw[];
    LAS unsigned char* lds = (LAS unsigned char*)lds_raw;
    cg::grid_group grid = cg::this_grid();
    unsigned char* ws = a.ws;
    float* ss = (float*)(ws + WS_SS);
    bf16_t* hb = (bf16_t*)(ws + WS_HB);
    bf16_t* big = (bf16_t*)(ws + WS_BIG);
    const int lo = a.lo, hi = a.hi, G = gridDim.x;
#ifndef PROBE_MASK
#define PROBE_MASK 0
#endif
    unsigned long long pr_acc = 0ull, pr_t0 = 0ull;
#define PR_BEGIN(k) do { if ((PROBE_MASK >> (k)) & 1) pr_t0 = __builtin_amdgcn_s_memrealtime(); } while (0)
#define PR_END(k) do { if ((PROBE_MASK >> (k)) & 1) pr_acc += __builtin_amdgcn_s_memrealtime() - pr_t0; } while (0)
#define IN(k) (lo <= (k) && (k) < hi)
    volatile LAS unsigned* misc = (volatile LAS unsigned*)(lds + LDS_MISC);
    if (threadIdx.x < 2) misc[threadIdx.x] = 0u;
    __syncthreads();
    const XcdBarrier xbar = xcd_barrier_post((unsigned*)(ws + WS_BAR), misc);
    if (lo < 0) grid.sync();
#define GSYNC() xcd_barrier(xbar)
#define SEAM(k) do { if ((k) + 1 < hi) GSYNC(); } while (0)
    if (IN(0)) { PR_BEGIN(0); if (REP & 1) { p0_prologue(a, lds); GSYNC(); } p0_prologue(a, lds); SEAM(0); PR_END(0); }
    if (IN(1)) { PR_BEGIN(1); pg8::Gemm g{hb, (const bf16_t*)(ws + WS_WIN), T, NIN, 1024, 1024, 1024}; pg8::StaticOrder S; S.init(T, NIN, G, blockIdx.x);
        EpiInProj E{big, (float*)(ws + WS_DT), ss}; if (REP & 2) { pg8::gemm_phase(lds, g, S, E); GSYNC(); } pg8::gemm_phase(lds, g, S, E); SEAM(1); PR_END(1); }
    if (IN(2)) { PR_BEGIN(2); PR_BEGIN(13); conv_phase(a, lds); GSYNC(); PR_END(13); PR_BEGIN(14); if (REP & 4) { ssd_phase<true>(a, lds); GSYNC(); } ssd_phase<false>(a, lds); SEAM(2); PR_END(14); PR_END(2); }
    if (IN(3)) { PR_BEGIN(3); gatenorm_phase(a); SEAM(3); PR_END(3); }
    if (IN(4)) { PR_BEGIN(4); { pg8::Gemm g{big, (const bf16_t*)(ws + WS_WOUT), TAIL_ROW0, 1024, 2048, ZXW, 2048}; pg8::StaticOrder S; S.init(TAIL_ROW0, 1024, G, blockIdx.x);
            EpiResid<false> E{hb, ss + T, nullptr}; pg8::gemm_phase(lds, g, S, E); }
        { pg8::Gemm g{big, (const bf16_t*)(ws + WS_WOUT), T, 1024, 2048, ZXW, 256}; pg8::TailOrder S{8, G, (int)blockIdx.x, TAIL_ROW0 / 256, 4, TAIL_ROWS / 256};
            EpiPartial E{(float*)(ws + WS_END)}; pg8::gemm_phase(lds, g, S, E); }
        GSYNC(); tail_fixup(hb, ss + T, (const float*)(ws + WS_END), 8); SEAM(4); PR_END(4); }
    if (IN(5)) { PR_BEGIN(5); pg8::Gemm g{hb, (const bf16_t*)(ws + WS_WGU0), T, 2 * DFF, 1024, 1024, 1024}; pg8::StaticOrder S; S.init(T, 2 * DFF, G, blockIdx.x);
        EpiSwiglu E{big, ss + T}; pg8::gemm_phase(lds, g, S, E); SEAM(5); PR_END(5); }
    if (IN(6)) { PR_BEGIN(6); { pg8::Gemm g{big, (const bf16_t*)(ws + WS_WD0), TAIL_ROW0, 1024, DFF, DFF, DFF}; pg8::StaticOrder S; S.init(TAIL_ROW0, 1024, G, blockIdx.x);
            EpiResid<false> E{hb, ss + 2 * T, nullptr}; pg8::gemm_phase(lds, g, S, E); }
        { pg8::Gemm g{big, (const bf16_t*)(ws + WS_WD0), T, 1024, DFF, DFF, 256}; pg8::TailOrder S{11, G, (int)blockIdx.x, TAIL_ROW0 / 256, 4, TAIL_ROWS / 256};
            EpiPartial E{(float*)(ws + WS_BIG + 200 * MiB)}; pg8::gemm_phase(lds, g, S, E); }
        GSYNC(); tail_fixup(hb, ss + 2 * T, (const float*)(ws + WS_BIG + 200 * MiB), 11); SEAM(6); PR_END(6); }
    if (IN(7)) { PR_BEGIN(7); pg8::Gemm g{hb, (const bf16_t*)(ws + WS_WKVQ), T, NKVQ, 1024, 1024, 1024}; pg8::StaticOrder S; S.init(T, NKVQ, G, blockIdx.x);
        EpiKVQ E{(bf16_t*)(ws + WS_K), (bf16_t*)(ws + WS_V), (bf16_t*)(ws + WS_Q), ss + 2 * T, (const float*)(ws + WS_ROPE), a.out}; pg8::gemm_phase(lds, g, S, E); SEAM(7); PR_END(7); }
    if (IN(8)) { PR_BEGIN(8); if (REP & 256) { attn_phase(a, lds); GSYNC(); } attn_phase(a, lds); SEAM(8); PR_END(8); }
    if (IN(9)) { PR_BEGIN(9); { pg8::Gemm g{(const bf16_t*)(ws + WS_O), (const bf16_t*)(ws + WS_WO), TAIL_ROW0, 1024, 1024, 1024, 1024}; pg8::StaticOrder S; S.init(TAIL_ROW0, 1024, G, blockIdx.x);
            EpiResid<false> E{hb, ss + 3 * T, nullptr}; pg8::gemm_phase(lds, g, S, E); }
        { pg8::Gemm g{(const bf16_t*)(ws + WS_O), (const bf16_t*)(ws + WS_WO), T, 1024, 1024, 1024, 256}; pg8::TailOrder S{4, G, (int)blockIdx.x, TAIL_ROW0 / 256, 4, TAIL_ROWS / 256};
            EpiPartial E{(float*)(ws + WS_END)}; pg8::gemm_phase(lds, g, S, E); }
        GSYNC(); tail_fixup(hb, ss + 3 * T, (const float*)(ws + WS_END), 4); SEAM(9); PR_END(9); }
    if (IN(10)) { PR_BEGIN(10); pg8::Gemm g{hb, (const bf16_t*)(ws + WS_WGU1), T, 2 * DFF, 1024, 1024, 1024}; pg8::StaticOrder S; S.init(T, 2 * DFF, G, blockIdx.x);
        EpiSwiglu E{big, ss + 3 * T}; pg8::gemm_phase(lds, g, S, E); SEAM(10); PR_END(10); }
    if (IN(11)) { PR_BEGIN(11); { pg8::Gemm g{big, (const bf16_t*)(ws + WS_WD1), TAIL_ROW0, 1024, DFF, DFF, DFF}; pg8::StaticOrder S; S.init(TAIL_ROW0, 1024, G, blockIdx.x);
            EpiResid<false> E{hb, ss + 4 * T, nullptr}; pg8::gemm_phase(lds, g, S, E); }
        { pg8::Gemm g{big, (const bf16_t*)(ws + WS_WD1), T, 1024, DFF, DFF, 256}; pg8::TailOrder S{11, G, (int)blockIdx.x, TAIL_ROW0 / 256, 4, TAIL_ROWS / 256};
            EpiPartial E{(float*)(ws + WS_BIG + 200 * MiB)}; pg8::gemm_phase(lds, g, S, E); }
        GSYNC(); tail_fixup(hb, ss + 4 * T, (const float*)(ws + WS_BIG + 200 * MiB), 11); SEAM(11); PR_END(11); }
    if (IN(12)) { PR_BEGIN(12); final_phase(a); if (PROBE_MASK & (1 << 12)) { grid.sync(); PR_END(12); } }
    if (PROBE_MASK && blockIdx.x == 0 && threadIdx.x == 0) { const unsigned long long t0 = __builtin_amdgcn_s_memrealtime(); while (__builtin_amdgcn_s_memrealtime() - t0 < 4ull * pr_acc) __builtin_amdgcn_s_sleep(8); }
#undef IN
#undef SEAM
}

extern "C" void kernel_launch(void* const* d_in, const int* in_sizes, int n_in, void* d_out, int out_size, void* d_ws, size_t ws_size, hipStream_t stream) {
    static int grid = 0;
    if (grid == 0) {
        if (n_in != 28 || ws_size < WS_END + 42 * MiB) { fprintf(stderr, "kernel_launch: unexpected n_in %d / ws %zu (need %zu)\n", n_in, ws_size, (size_t)WS_END); grid = -1; return; }
        int dev = 0, cus = 0, per_cu = 0;
        hipGetDevice(&dev); hipDeviceGetAttribute(&cus, hipDeviceAttributeMultiprocessorCount, dev);
        hipFuncSetAttribute((const void*)yoco_fwd, hipFuncAttributeMaxDynamicSharedMemorySize, LDS_BYTES);
        hipOccupancyMaxActiveBlocksPerMultiprocessor(&per_cu, (const void*)yoco_fwd, 512, LDS_BYTES);
        if (per_cu < 1) { fprintf(stderr, "kernel_launch: occupancy query says %d blocks/CU\n", per_cu); per_cu = 1; }
        (void)hipGetLastError();
        grid = cus * per_cu;
    }
    if (grid < 0) return;
    Args a{};
    for (int i = 0; i < 28; ++i) a.in[i] = (const float*)d_in[i];
    a.out = (float*)d_out; a.ws = (unsigned char*)d_ws;
#if MK_MULTI
    for (int ph = 0; ph < NPHASE; ++ph) { a.lo = ph; a.hi = ph + 1; hipLaunchKernelGGL(yoco_fwd, dim3(grid), dim3(512), LDS_BYTES, stream, a); }
#else
    a.lo = 0; a.hi = NPHASE;
    (void)hipMemsetAsync((unsigned char*)d_ws + WS_BAR, 0, 16384, stream);
    void* args[] = {&a};
    hipError_t e = hipLaunchCooperativeKernel((const void*)yoco_fwd, dim3(grid), dim3(512), args, LDS_BYTES, stream);
    if (e != hipSuccess) fprintf(stderr, "cooperative launch failed: %s (grid %d)\n", hipGetErrorString(e), grid);
#endif
}
```
